# Optimizing an MI355X kernel written in HIP

```python
import math
import jax, jax.numpy as jnp
from jax import lax
import numpy as np

D_MODEL = 1024
BATCH = 8
SEQ = 2048
DEPTH = 1
DEC_BATCH = 128
DEC_SEQ = 1
PAST_LEN = 16384
PAGE_SIZE = 128

N_META = 16
D_MIX = D_MODEL
S5_DIM = D_MIX // 2
S5_GROUP = 16
S5_GROUPS = S5_DIM // S5_GROUP
S5_STATE = 64
HG_DIM = D_MIX - S5_DIM
HG_HEAD_DIM = 128
HG_HEADS = HG_DIM // HG_HEAD_DIM
HG_CHUNK = 64
D_FF = ((8 * D_MODEL // 3 + 127) // 128) * 128
CONV_W = 3
IN_COLS = S5_DIM + 4 * HG_DIM
EPS = 1e-6

kernel_name = "hymba_s5_hgrn2_convffn_step"


def rms_norm(x, g):
    xf = x.astype(jnp.float32)
    y = xf * lax.rsqrt(jnp.mean(xf * xf, axis=-1, keepdims=True) + EPS)
    return (y * g.astype(jnp.float32)).astype(x.dtype)


def s5_discretize(lam_re, lam_im, log_dt, b_re, b_im):
    lam_re = lam_re.astype(jnp.float32)
    lam_im = lam_im.astype(jnp.float32)
    dt = jnp.exp(log_dt.astype(jnp.float32))[:, None]
    mag = jnp.exp(lam_re * dt)
    ar = mag * jnp.cos(lam_im * dt)
    ai = mag * jnp.sin(lam_im * dt)
    nr = ar - 1.0
    den = lam_re * lam_re + lam_im * lam_im
    cr = (nr * lam_re + ai * lam_im) / den
    ci = (ai * lam_re - nr * lam_im) / den
    b_re = b_re.astype(jnp.float32)
    b_im = b_im.astype(jnp.float32)
    bb_re = cr[..., None] * b_re - ci[..., None] * b_im
    bb_im = cr[..., None] * b_im + ci[..., None] * b_re
    return ar, ai, bb_re, bb_im


def _complex_scan_op(e1, e2):
    a1r, a1i, b1r, b1i = e1
    a2r, a2i, b2r, b2i = e2
    return (a2r * a1r - a2i * a1i,
            a2r * a1i + a2i * a1r,
            a2r * b1r - a2i * b1i + b2r,
            a2r * b1i + a2i * b1r + b2i)


def s5_mix(u, h0_re, h0_im, lam_re, lam_im, log_dt, b_re, b_im, c_re, c_im, d, w_glu, b_glu):
    n, l, _ = u.shape
    uf = u.astype(jnp.float32)
    ug = uf.reshape(n, l, S5_GROUPS, S5_GROUP)
    ar, ai, bbr, bbi = s5_discretize(lam_re, lam_im, log_dt, b_re, b_im)
    xr = jnp.einsum('nlgc,gpc->nlgp', ug, bbr)
    xi = jnp.einsum('nlgc,gpc->nlgp', ug, bbi)
    h0r = h0_re.astype(jnp.float32)
    h0i = h0_im.astype(jnp.float32)
    xr = xr.at[:, 0].add(ar * h0r - ai * h0i)
    xi = xi.at[:, 0].add(ar * h0i + ai * h0r)
    a_r = jnp.broadcast_to(ar, xr.shape)
    a_i = jnp.broadcast_to(ai, xi.shape)
    _, _, hr, hi = lax.associative_scan(_complex_scan_op, (a_r, a_i, xr, xi), axis=1)
    y = (jnp.einsum('nlgp,gcp->nlgc', hr, c_re.astype(jnp.float32))
         - jnp.einsum('nlgp,gcp->nlgc', hi, c_im.astype(jnp.float32)))
    y = y.reshape(n, l, S5_DIM) + d.astype(jnp.float32) * uf
    y = jax.nn.gelu(y)
    y = y * jax.nn.sigmoid(y @ w_glu.astype(jnp.float32) + b_glu.astype(jnp.float32))
    return y.astype(u.dtype), hr[:, -1], hi[:, -1]


def hgrn_chunks(q, k, logf, v, s0, chunk):
    n, l, h, _ = q.shape
    nc = l // chunk

    def blk(t):
        return t.reshape(n, nc, chunk, h, t.shape[-1]).transpose(1, 0, 3, 2, 4)

    mask = jnp.tril(jnp.ones((chunk, chunk), dtype=bool))

    def step(S, inp):
        qc, kc, lc, vc = inp
        b = jnp.cumsum(lc, axis=2)
        qd = qc * jnp.exp(b)
        kd = kc * jnp.exp(-b)
        att = jnp.where(mask, jnp.einsum('nhck,nhsk->nhcs', qd, kd), 0.0)
        o = jnp.einsum('nhck,nhkv->nhcv', qd, S) + jnp.einsum('nhcs,nhsv->nhcv', att, vc)
        bl = b[:, :, -1:, :]
        S = (jnp.exp(bl[:, :, 0, :])[..., None] * S
             + jnp.einsum('nhsk,nhsv->nhkv', kc * jnp.exp(bl - b), vc))
        return S, o

    S, o = lax.scan(step, s0, (blk(q), blk(k), blk(logf), blk(v)))
    o = o.transpose(1, 0, 3, 2, 4).reshape(n, l, h, v.shape[-1])
    return o, S


def hgrn_mix(q, f_logit, i_in, g, lb, norm_g, s0, n_lead):
    n, l, _ = q.shape
    heads = lambda t: t.astype(jnp.float32).reshape(n, l, HG_HEADS, HG_HEAD_DIM)
    f = lb + (1.0 - lb) * jax.nn.sigmoid(f_logit.astype(jnp.float32))
    logf = heads(jnp.log(f))
    k = heads(1.0 - f)
    qh = heads(q)
    vh = heads(i_in)
    S = s0.astype(jnp.float32)
    if n_lead > 0:
        o1, S = hgrn_chunks(qh[:, :n_lead], k[:, :n_lead], logf[:, :n_lead], vh[:, :n_lead], S, n_lead)
        rest = l - n_lead
        o2, S = hgrn_chunks(qh[:, n_lead:], k[:, n_lead:], logf[:, n_lead:], vh[:, n_lead:], S,
                            math.gcd(rest, HG_CHUNK))
        o = jnp.concatenate([o1, o2], axis=1)
    else:
        o, S = hgrn_chunks(qh, k, logf, vh, S, math.gcd(l, HG_CHUNK))
    o = o * lax.rsqrt(jnp.mean(o * o, axis=-1, keepdims=True) + EPS)
    o = o.reshape(n, l, HG_DIM) * norm_g.astype(jnp.float32) * jax.nn.silu(g.astype(jnp.float32))
    return o.astype(q.dtype), S


def conv_ffn(x, w_up, conv_w, conv_b, w_down, buf):
    l = x.shape[1]
    hid = x @ w_up
    a, v = hid[..., :D_FF], hid[..., D_FF:]
    ext = jnp.concatenate([buf.astype(a.dtype), a], axis=1)
    c = conv_b + sum(ext[:, j:j + l] * conv_w[j] for j in range(CONV_W))
    y = (jax.nn.silu(c) * v) @ w_down
    return y, ext[:, -(CONV_W - 1):]


def block(h, n_lead, s5r0, s5i0, hg0, conv0, lb,
          norm_mix_g, w_in, s5_lambda_re, s5_lambda_im, s5_log_dt, s5_b_re, s5_b_im,
          s5_c_re, s5_c_im, s5_d, s5_w_glu, s5_b_glu, hg_norm_g, w_out,
          norm_ffn_g, ffn_w_up, ffn_conv_w, ffn_conv_b, ffn_w_down):
    hn = rms_norm(h, norm_mix_g)
    z = hn @ w_in
    o = S5_DIM
    u = z[..., :o]
    q = z[..., o:o + HG_DIM]
    fl = z[..., o + HG_DIM:o + 2 * HG_DIM]
    iv = z[..., o + 2 * HG_DIM:o + 3 * HG_DIM]
    g = z[..., o + 3 * HG_DIM:]
    y5, s5r, s5i = s5_mix(u, s5r0, s5i0, s5_lambda_re, s5_lambda_im, s5_log_dt, s5_b_re, s5_b_im,
                          s5_c_re, s5_c_im, s5_d, s5_w_glu, s5_b_glu)
    yh, hg = hgrn_mix(q, fl, iv, g, lb, hg_norm_g, hg0, n_lead)
    h = h + jnp.concatenate([y5, yh], axis=-1) @ w_out
    yf, conv = conv_ffn(rms_norm(h, norm_ffn_g), ffn_w_up, ffn_conv_w, ffn_conv_b, ffn_w_down, conv0)
    return h + yf, s5r, s5i, hg, conv


def setup_inputs(seed: int = 0) -> dict:
    key = jax.random.key(seed)
    ks = jax.random.split(key, 32)
    f32 = jnp.float32
    nrm = lambda k, shape, s: jax.random.normal(k, shape, f32) * s
    n_arange = jnp.arange(S5_STATE, dtype=f32)
    return {
        "x_prompt": nrm(ks[0], (BATCH, SEQ, D_MODEL), 1.0),
        "x_sample": nrm(ks[1], (DEC_BATCH, DEC_SEQ, D_MODEL), 1.0),
        "state_s5_re": nrm(ks[2], (DEPTH, DEC_BATCH, S5_GROUPS, S5_STATE), 0.1),
        "state_s5_im": nrm(ks[3], (DEPTH, DEC_BATCH, S5_GROUPS, S5_STATE), 0.1),
        "state_hgrn": nrm(ks[4], (DEPTH, DEC_BATCH, HG_HEADS, HG_HEAD_DIM, HG_HEAD_DIM), 0.5),
        "state_ffn_conv": nrm(ks[5], (DEPTH, DEC_BATCH, CONV_W - 1, D_FF), 1.0),
        "meta_tokens": nrm(ks[6], (N_META, D_MODEL), 1.0),
        "norm_mix_g": 1.0 + nrm(ks[7], (DEPTH, D_MODEL), 0.02),
        "w_in": nrm(ks[8], (DEPTH, D_MODEL, IN_COLS), D_MODEL ** -0.5),
        "s5_lambda_re": -0.5 + nrm(ks[9], (DEPTH, S5_GROUPS, S5_STATE), 0.01),
        "s5_lambda_im": jnp.pi * n_arange + nrm(ks[10], (DEPTH, S5_GROUPS, S5_STATE), 0.01),
        "s5_log_dt": jax.random.uniform(ks[11], (DEPTH, S5_GROUPS), f32,
                                        minval=math.log(1e-3), maxval=math.log(1e-1)),
        "s5_b_re": nrm(ks[12], (DEPTH, S5_GROUPS, S5_STATE, S5_GROUP), (2 * S5_GROUP) ** -0.5),
        "s5_b_im": nrm(ks[13], (DEPTH, S5_GROUPS, S5_STATE, S5_GROUP), (2 * S5_GROUP) ** -0.5),
        "s5_c_re": nrm(ks[14], (DEPTH, S5_GROUPS, S5_GROUP, S5_STATE), S5_STATE ** -0.5),
        "s5_c_im": nrm(ks[15], (DEPTH, S5_GROUPS, S5_GROUP, S5_STATE), S5_STATE ** -0.5),
        "s5_d": nrm(ks[16], (DEPTH, S5_DIM), 1.0),
        "s5_w_glu": nrm(ks[17], (DEPTH, S5_DIM, S5_DIM), S5_DIM ** -0.5),
        "s5_b_glu": nrm(ks[18], (DEPTH, S5_DIM), 0.01),
        "hg_lower_bounds": nrm(ks[19], (DEPTH + 1, HG_DIM), 0.1),
        "hg_norm_g": 1.0 + nrm(ks[20], (DEPTH, HG_DIM), 0.02),
        "w_out": nrm(ks[21], (DEPTH, D_MIX, D_MODEL), D_MIX ** -0.5),
        "norm_ffn_g": 1.0 + nrm(ks[22], (DEPTH, D_MODEL), 0.02),
        "ffn_w_up": nrm(ks[23], (DEPTH, D_MODEL, 2 * D_FF), D_MODEL ** -0.5),
        "ffn_conv_w": nrm(ks[24], (DEPTH, CONV_W, D_FF), CONV_W ** -0.5),
        "ffn_conv_b": nrm(ks[25], (DEPTH, D_FF), 0.01),
        "ffn_w_down": nrm(ks[26], (DEPTH, D_FF, D_MODEL), D_FF ** -0.5),
        "final_norm_g": 1.0 + nrm(ks[27], (D_MODEL,), 0.02),
    }


def reference(x_prompt, x_sample, state_s5_re, state_s5_im, state_hgrn, state_ffn_conv,
              meta_tokens, norm_mix_g, w_in, s5_lambda_re, s5_lambda_im, s5_log_dt,
              s5_b_re, s5_b_im, s5_c_re, s5_c_im, s5_d, s5_w_glu, s5_b_glu,
              hg_lower_bounds, hg_norm_g, w_out, norm_ffn_g, ffn_w_up, ffn_conv_w,
              ffn_conv_b, ffn_w_down, final_norm_g):
    nb = x_prompt.shape[0]
    meta = jnp.broadcast_to(meta_tokens[None].astype(x_prompt.dtype), (nb, N_META, D_MODEL))
    hp = jnp.concatenate([meta, x_prompt], axis=1)
    hs = x_sample
    lbs = jnp.cumsum(jax.nn.softmax(hg_lower_bounds.astype(jnp.float32), axis=0), axis=0)
    p_s5r, p_s5i, p_hg, p_cv = [], [], [], []
    s_s5r, s_s5i, s_hg, s_cv = [], [], [], []
    for li in range(DEPTH):
        wts = (norm_mix_g[li], w_in[li], s5_lambda_re[li], s5_lambda_im[li], s5_log_dt[li],
               s5_b_re[li], s5_b_im[li], s5_c_re[li], s5_c_im[li], s5_d[li], s5_w_glu[li],
               s5_b_glu[li], hg_norm_g[li], w_out[li], norm_ffn_g[li], ffn_w_up[li],
               ffn_conv_w[li], ffn_conv_b[li], ffn_w_down[li])
        z5 = jnp.zeros((nb, S5_GROUPS, S5_STATE), jnp.float32)
        zh = jnp.zeros((nb, HG_HEADS, HG_HEAD_DIM, HG_HEAD_DIM), jnp.float32)
        zc = jnp.zeros((nb, CONV_W - 1, D_FF), hp.dtype)
        hp, a, b, c, d = block(hp, N_META, z5, z5, zh, zc, lbs[li], *wts)
        p_s5r.append(a); p_s5i.append(b); p_hg.append(c); p_cv.append(d)
        hs, a, b, c, d = block(hs, 0, state_s5_re[li], state_s5_im[li], state_hgrn[li],
                               state_ffn_conv[li], lbs[li], *wts)
        s_s5r.append(a); s_s5i.append(b); s_hg.append(c); s_cv.append(d)
    y_prompt = rms_norm(hp, final_norm_g)[:, N_META:]
    y_sample = rms_norm(hs, final_norm_g)
    return (y_prompt, y_sample,
            jnp.stack(p_s5r), jnp.stack(p_s5i), jnp.stack(p_hg), jnp.stack(p_cv),
            jnp.stack(s_s5r), jnp.stack(s_s5i), jnp.stack(s_hg), jnp.stack(s_cv))
```

```cpp
#include <hip/hip_runtime.h>
#include <cstdio>
#include <cstdint>
#define MK_N_LAUNCHES 1
namespace pg8 {
#define PG8_LAS __attribute__((address_space(3)))
typedef unsigned short bf16_t;
typedef short bf16x8 __attribute__((ext_vector_type(8)));
typedef float f32x4 __attribute__((ext_vector_type(4)));
typedef unsigned u32x4 __attribute__((ext_vector_type(4)));
typedef unsigned u32x2 __attribute__((ext_vector_type(2)));
constexpr int BM = 256, BK = 64, HALF = 128, HTB = HALF * BK * 2  , STAGE_BYTES = 8 * HTB, NXCD = 8, WGM = 8;

__host__ __device__ __forceinline__ int lds_byte(int r, int c) { const int st = (r >> 4) * 2 + (c >> 5), rr = r & 15, cc = c & 31, ob = rr * 64 + cc * 2; return st * 1024 + (ob ^ (((ob >> 9) & 1) << 5)); }
__host__ __device__ __forceinline__ void stage_rc(int b, int& R, int& C) { const int st = b / 1024, sb = b % 1024, swz = sb ^ (((sb >> 9) & 1) << 5); R = (st >> 1) * 16 + swz / 64; C = (st & 1) * 32 + (swz % 64) / 2; }
__host__ __device__ __forceinline__ int perm32(int rho) { const int n = rho >> 4, i = rho & 15; return 8 * (i >> 2) + 4 * n + (i & 3); }

struct Unit { int pm, pn; };
struct Gemm { const bf16_t* A; const bf16_t* Bt; int M, N, K, lda; };

struct StaticOrder {
    int nM, nN, nwg, G, c;
    __host__ __device__ void init(int M, int N, int G_, int c_) { nM = M / BM; nN = N / BM; nwg = nM * nN; G = G_; c = c_; }
    __host__ __device__ bool next(int i, Unit& u) const {
        const long L = (long)i * G + c; if (L >= nwg) return false;
        int wgid = (int)L; { const int q = nwg / NXCD, r = nwg % NXCD, xcd = wgid % NXCD, off = wgid / NXCD; wgid = (xcd < r ? xcd * (q + 1) : r * (q + 1) + (xcd - r) * q) + off; }
        const int nig = WGM * nN, gid = wgid / nig, fm = gid * WGM, gsz = (nM - fm) < WGM ? (nM - fm) : WGM;
        u.pm = fm + ((wgid % nig) % gsz); u.pn = (wgid % nig) / gsz; return true;
    }
};

__device__ __forceinline__ unsigned cvt_pk_bf16(float lo, float hi) { unsigned r; asm volatile("v_cvt_pk_bf16_f32 %0, %1, %2" : "=v"(r) : "v"(lo), "v"(hi)); return r; }

template <class Epi, bool ALIGN_EPI>
__device__ __forceinline__ void gemm_phase(PG8_LAS unsigned char* lds, const Gemm g, const StaticOrder& S, const Epi& E) {
    const int tid = threadIdx.x, wid = __builtin_amdgcn_readfirstlane(tid >> 6), lane = tid & 63, wr = wid >> 2, wc = wid & 3, fr = lane & 15, fq = lane >> 4;
    const int K = g.K, nt = K / BK, lda = g.lda;
    unsigned voffA[2], voffB[2];
#pragma unroll
    for (int i = 0; i < 2; ++i) { int R, C; stage_rc(tid * 16 + i * 8192, R, C); const int Rb = (R & ~31) + perm32(R & 31);
        voffA[i] = (unsigned)(R * lda + C) * 2u; voffB[i] = (unsigned)(Rb * K + C) * 2u; }
    const size_t kstep = (size_t)(BK * 2);
    const size_t hstepA = (size_t)HALF * lda * 2, hstepB = (size_t)HALF * K * 2;
    const size_t tstepA = 2 * hstepA, tstepB = 2 * hstepB;
    const unsigned ldsw = (unsigned)wid * 1024u;
    const int aoff = lds_byte(wr * 64 + fr, fq * 8), boff = lds_byte(wc * 32 + fr, fq * 8);
#define PG8_SA(b, h) (((b) * 2 + (h)) * HTB)
#define PG8_SB(b, h) ((4 + (b) * 2 + (h)) * HTB)
#define PG8_STAGE(bufoff, gbase, voff) do { _Pragma("unroll") for (int _i = 0; _i < 2; ++_i) \
        __builtin_amdgcn_global_load_lds((const unsigned*)((const char*)(gbase) + (voff)[_i]), (PG8_LAS unsigned*)(lds + (bufoff) + ldsw + _i * 8192), 16, 0, 0); } while (0)
#define PG8_LDA(dst, b, h) do { _Pragma("unroll") for (int m = 0; m < 4; ++m) _Pragma("unroll") for (int k = 0; k < 2; ++k) dst[m][k] = *(const PG8_LAS bf16x8*)(lds + PG8_SA(b, h) + aoff + m * 2048 + k * 1024); } while (0)
#define PG8_LDB(dst, b, h) do { _Pragma("unroll") for (int n = 0; n < 2; ++n) _Pragma("unroll") for (int k = 0; k < 2; ++k) dst[n][k] = *(const PG8_LAS bf16x8*)(lds + PG8_SB(b, h) + boff + n * 2048 + k * 1024); } while (0)
#define PG8_MMA(ai, bj, At, Bt) do { __builtin_amdgcn_s_setprio(1); _Pragma("unroll") for (int m = 0; m < 4; ++m) _Pragma("unroll") for (int n = 0; n < 2; ++n) _Pragma("unroll") for (int k = 0; k < 2; ++k) \
        acc[ai][bj][m][n] = __builtin_amdgcn_mfma_f32_16x16x32_bf16(Bt[n][k], At[m][k], acc[ai][bj][m][n], 0, 0, 0); __builtin_amdgcn_s_setprio(0); } while (0)
#define PG8_WAIT_V(n) asm volatile("s_waitcnt vmcnt(" #n ")" ::: "memory")
#define PG8_WAIT_L(n) asm volatile("s_waitcnt lgkmcnt(" #n ")" ::: "memory")
#define PG8_BAR __builtin_amdgcn_s_barrier()
#define PG8_SCHED __builtin_amdgcn_sched_barrier(0)
    Unit cur, nxt; int ui = 0;
    if (!S.next(0, cur)) return;
    f32x4 acc[2][2][4][2];
#pragma unroll
    for (int a = 0; a < 2; ++a)
#pragma unroll
        for (int b = 0; b < 2; ++b)
#pragma unroll
            for (int m = 0; m < 4; ++m)
#pragma unroll
                for (int n = 0; n < 2; ++n) acc[a][b][m][n] = (f32x4){0.f, 0.f, 0.f, 0.f};
    bf16x8 At[4][2], B0[2][2], B1[2][2];
    const char* cA = (const char*)g.A + (size_t)cur.pm * tstepA; const char* cB = (const char*)g.Bt + (size_t)cur.pn * tstepB;
    PG8_STAGE(PG8_SB(0, 0), cB, voffB); PG8_STAGE(PG8_SB(0, 1), cB + hstepB, voffB); PG8_STAGE(PG8_SA(0, 0), cA, voffA); PG8_STAGE(PG8_SA(0, 1), cA + hstepA, voffA);
    if (wr == 1) PG8_BAR;
    PG8_WAIT_V(2); PG8_BAR;
    PG8_STAGE(PG8_SB(1, 0), cB + kstep, voffB); PG8_STAGE(PG8_SA(1, 0), cA + kstep, voffA); PG8_STAGE(PG8_SB(1, 1), cB + hstepB + kstep, voffB);
    PG8_WAIT_V(6); PG8_BAR;
    for (;;) {
        const bool has_next = S.next(ui + 1, nxt);
        const char* nA = has_next ? (const char*)g.A + (size_t)nxt.pm * tstepA : cA; const char* nB = has_next ? (const char*)g.Bt + (size_t)nxt.pn * tstepB : cB;
        for (int t = 0; t < nt; t += 2) {
            const bool last = (t == nt - 2);
            const char* a1 = cA + (size_t)(t + 1) * kstep;
            const char* a2 = last ? nA : cA + (size_t)(t + 2) * kstep; const char* b2 = last ? nB : cB + (size_t)(t + 2) * kstep;
            const char* a3 = a2 + kstep; const char* b3 = b2 + kstep;
            PG8_LDB(B0, 0, 0); PG8_LDB(B1, 0, 1); PG8_SCHED; PG8_LDA(At, 0, 0); PG8_STAGE(PG8_SA(1, 1), a1 + hstepA, voffA);
            PG8_WAIT_V(8); PG8_WAIT_L(0); PG8_BAR; PG8_MMA(0, 0, At, B0); PG8_MMA(0, 1, At, B1); PG8_BAR; PG8_SCHED;
            PG8_LDA(At, 0, 1); PG8_STAGE(PG8_SB(0, 0), b2, voffB); PG8_STAGE(PG8_SB(0, 1), b2 + hstepB, voffB); PG8_STAGE(PG8_SA(0, 0), a2, voffA);
            PG8_WAIT_V(8); PG8_WAIT_L(0); PG8_BAR; PG8_MMA(1, 0, At, B0); PG8_MMA(1, 1, At, B1); PG8_BAR; PG8_SCHED;
            PG8_LDB(B0, 1, 0); PG8_LDB(B1, 1, 1); PG8_SCHED; PG8_LDA(At, 1, 0); PG8_STAGE(PG8_SA(0, 1), a2 + hstepA, voffA);
            PG8_WAIT_V(8); PG8_WAIT_L(0); PG8_BAR; PG8_MMA(0, 0, At, B0); PG8_MMA(0, 1, At, B1); PG8_BAR; PG8_SCHED;
            PG8_LDA(At, 1, 1); PG8_STAGE(PG8_SB(1, 0), b3, voffB); PG8_STAGE(PG8_SB(1, 1), b3 + hstepB, voffB); PG8_STAGE(PG8_SA(1, 0), a3, voffA);
            PG8_WAIT_V(8); PG8_WAIT_L(0); PG8_BAR; PG8_MMA(1, 0, At, B0); PG8_MMA(1, 1, At, B1); PG8_BAR; PG8_SCHED;
        }
        if constexpr (ALIGN_EPI) { if (wr == 0) PG8_BAR; }
        E(acc, cur, wr, wc, fr, fq);
        if (!has_next) break;
#pragma unroll
        for (int a = 0; a < 2; ++a)
#pragma unroll
            for (int b = 0; b < 2; ++b)
#pragma unroll
                for (int m = 0; m < 4; ++m)
#pragma unroll
                    for (int n = 0; n < 2; ++n) acc[a][b][m][n] = (f32x4){0.f, 0.f, 0.f, 0.f};
        cur = nxt; cA = nA; cB = nB; ++ui;
        if constexpr (ALIGN_EPI) { if (wr == 1) PG8_BAR; }
    }
    PG8_WAIT_V(0);
    if constexpr (!ALIGN_EPI) { if (wr == 0) PG8_BAR; }
    PG8_BAR;
#undef PG8_SA
#undef PG8_SB
#undef PG8_STAGE
#undef PG8_LDA
#undef PG8_LDB
#undef PG8_MMA
#undef PG8_WAIT_V
#undef PG8_WAIT_L
#undef PG8_BAR
#undef PG8_SCHED
}
}
using pg8::bf16x8;
constexpr int NWAVES = 8;
constexpr int D = 1024, NB = 8, SEQ = 2048, NMETA = 16, NS = 128;
constexpr int RT = 16640;
constexpr int R_META = 16384, R_SAMP = 16512;
constexpr int HD = 512;
constexpr int INC = 2560, DFF = 2816, UPC = 5632;
constexpr float EPS = 1e-6f;
constexpr size_t OFF_YP = 0, OFF_YS = 16777216, OFF_S5RP = 16908288, OFF_S5IP = 16924672, OFF_HGP = 16941056, OFF_CVP = 17465344,
                 OFF_S5RS = 17510400, OFF_S5IS = 17772544, OFF_HGS = 18034688, OFF_CVS = 26423296, OUT_TOTAL = 27144192;
constexpr size_t KiB = 1024, MiB = 1u << 20;
constexpr size_t WS_CTL = 0, CTL_ZERO_BYTES = 1 * MiB;
constexpr int CW_BAR = 4096;
constexpr size_t CB_SS2 = 64 * KiB, CB_SS3 = 192 * KiB, CB_HSS = 512 * KiB;
constexpr size_t WS_WIN = 2 * MiB, WS_WGLU = 7 * MiB, WS_WOUT = 7 * MiB + 512 * KiB, WS_WUP = 9 * MiB + 512 * KiB, WS_WDN = 20 * MiB + 512 * KiB;
constexpr size_t WS_S5W1 = 26 * MiB, WS_S5W2 = 32 * MiB, WS_S5F = 34 * MiB;
constexpr size_t S5F_A1 = 0, S5F_A16 = 16 * KiB, S5F_BB = 64 * KiB, S5F_LB = 384 * KiB;
constexpr size_t WS_H1META = 35 * MiB;
constexpr size_t WS_XN = 36 * MiB;
constexpr size_t ROWS512_BF16 = (size_t)RT * 512 * 2;
constexpr size_t WS_U = 68 * MiB + 512 * KiB, WS_Q = WS_U + ROWS512_BF16, WS_V = WS_Q + ROWS512_BF16, WS_G = WS_V + ROWS512_BF16, WS_LF = WS_G + ROWS512_BF16,
                 WS_Y5 = WS_LF + 2 * ROWS512_BF16, WS_OH = WS_Y5 + ROWS512_BF16, WS_MIX = WS_OH + ROWS512_BF16, WS_ZEND = WS_MIX + 2 * ROWS512_BF16;
constexpr size_t WS_HID = WS_U;
constexpr size_t WS_END = 256 * MiB;
static_assert(WS_ZEND <= WS_END && WS_HID + (size_t)RT * UPC * 2 <= WS_END && WS_XN + (size_t)RT * D * 2 <= WS_U, "d_ws map");
static_assert(CB_HSS + (size_t)RT * 4 * 4 <= CTL_ZERO_BYTES && CB_SS3 + RT * 4 <= CB_HSS && CB_SS2 + RT * 4 <= CB_SS3 && (CW_BAR + 3456) * 4 <= (int)CB_SS2, "ctl map");

constexpr int LDS_BYTES = 163840;
constexpr int RING_OFF = 0, MISC_OFF = 163840 - 256;

#define GAS __attribute__((address_space(1)))
#define LAS __attribute__((address_space(3)))
typedef unsigned short bf16;
typedef unsigned v4u __attribute__((ext_vector_type(4)));
typedef unsigned v2u __attribute__((ext_vector_type(2)));
typedef float f32x4 __attribute__((ext_vector_type(4)));
typedef short bf16x8 __attribute__((ext_vector_type(8)));
typedef GAS unsigned gu32;
#define RLX_AGENT __ATOMIC_RELAXED, __HIP_MEMORY_SCOPE_AGENT
#define LDS_WAIT() asm volatile("s_waitcnt lgkmcnt(0)" ::: "memory")
#define VM_WAIT() asm volatile("s_waitcnt vmcnt(0)" ::: "memory")
__device__ __forceinline__ unsigned f2bf(float f) { unsigned u = __builtin_bit_cast(unsigned, f); return (u + 0x7fffu + ((u >> 16) & 1u)) >> 16; }
__device__ __forceinline__ unsigned pk2(float lo, float hi) { return f2bf(lo) | (f2bf(hi) << 16); }
__device__ __forceinline__ float bf2f(unsigned short b) { return __builtin_bit_cast(float, (unsigned)b << 16); }
__device__ __forceinline__ float bflo(unsigned w) { return __builtin_bit_cast(float, w << 16); }
__device__ __forceinline__ float bfhi(unsigned w) { return __builtin_bit_cast(float, w & 0xffff0000u); }
__device__ __forceinline__ float sigmoidf_(float x) { return __builtin_amdgcn_rcpf(1.0f + __expf(-x)); }
__device__ __forceinline__ float siluf_(float x) { return x * sigmoidf_(x); }
__device__ __forceinline__ float gelu_tanh(float y) { const float uu = 1.5957691216057308f * (y + 0.044715f * y * y * y); return y * sigmoidf_(uu); }
__device__ __forceinline__ float ld_agent(const float* p) { return __builtin_bit_cast(float, __hip_atomic_load((const unsigned*)p, RLX_AGENT)); }
__device__ __forceinline__ void atomic_addf(float* p, float v) { (void)__hip_atomic_fetch_add(p, v, RLX_AGENT); }
__device__ __forceinline__ f32x4 mfma16(bf16x8 a, bf16x8 b, f32x4 c) { return __builtin_amdgcn_mfma_f32_16x16x32_bf16(a, b, c, 0, 0, 0); }
__device__ __forceinline__ float wave_sum(float v) {
#pragma unroll
    for (int o = 1; o < 64; o <<= 1) v += __shfl_xor(v, o);
    return v;
}

#define XB_TMO      128
#define XB_XCNT(j)  (256  + 64 * (j))
#define XB_XSUB(j)  (1280 + 64 * (j))
#define XB_XGEN(j)  (2304 + 64 * (j))
#define XB_TOP      3328
#define XB_TOPGEN   3392
#define XCD_BAR_WORDS 3456
#define XB_SPIN_CAP (1u << 18)
__device__ __forceinline__ unsigned xb_ld(unsigned* p)              { return __hip_atomic_load(p, __ATOMIC_RELAXED, __HIP_MEMORY_SCOPE_AGENT); }
__device__ __forceinline__ unsigned xb_add(unsigned* p, unsigned v) { return __hip_atomic_fetch_add(p, v, __ATOMIC_RELAXED, __HIP_MEMORY_SCOPE_AGENT); }
__device__ __forceinline__ unsigned xb_xcc_id() { return (unsigned)__builtin_amdgcn_s_getreg((3 << 11) | 20) & 0xFu; }
#define XB_SPIN(cond, bar) do { unsigned _sp = 0; while (cond) { __builtin_amdgcn_s_sleep(1); \
    if ((++_sp & 255u) == 0u) { if (xb_ld(&(bar)[XB_TMO])) break; if (_sp > XB_SPIN_CAP) { atomicAdd(&(bar)[XB_TMO], 1u); break; } } } } while (0)
struct XcdBarrier { unsigned* bar; unsigned x; volatile LAS unsigned* st; };
__device__ __forceinline__ XcdBarrier xcd_barrier_post(unsigned* bar, volatile LAS unsigned* st) {
    XcdBarrier b; b.bar = bar; b.x = xb_xcc_id(); b.st = st;
    if (threadIdx.x == 0) (void)xb_add(&bar[XB_XCNT(b.x)], 1u);
    return b;
}
__device__ __forceinline__ void xcd_barrier_complete(unsigned* bar, unsigned x, unsigned& nloc, unsigned& nx) {
    const unsigned G = gridDim.x * gridDim.y * gridDim.z;
    unsigned sum, cnt, mine, sp = 0u;
    for (;;) {
        sum = 0u; cnt = 0u; mine = 0u;
#pragma unroll
        for (unsigned j = 0; j < 16; ++j) { const unsigned c = xb_ld(&bar[XB_XCNT(j)]); sum += c; cnt += (c > 0u) ? 1u : 0u; mine = (j == x) ? c : mine; }
        if (sum == G) break;
        __builtin_amdgcn_s_sleep(1);
        if ((++sp & 255u) == 0u) { if (xb_ld(&bar[XB_TMO])) break; if (sp > XB_SPIN_CAP) { atomicAdd(&bar[XB_TMO], 1u); break; } }
    }
    nloc = mine > 0u ? mine : 1u; nx = cnt > 0u ? cnt : 1u;
}
__device__ __forceinline__ void xcd_barrier(const XcdBarrier& b) {
    asm volatile("s_waitcnt vmcnt(0)" ::: "memory");
    __syncthreads();
    if (threadIdx.x == 0) {
        unsigned* bar = b.bar;
        __builtin_amdgcn_s_waitcnt(0);
        unsigned nloc = b.st[0], nx = b.st[1];
        if (nloc == 0u) { xcd_barrier_complete(bar, b.x, nloc, nx); b.st[0] = nloc; b.st[1] = nx; }
        const unsigned old = xb_add(&bar[XB_XSUB(b.x)], 1u);
        const unsigned gen = old / nloc;
        if (old + 1u == (gen + 1u) * nloc) {
            __builtin_amdgcn_fence(__ATOMIC_RELEASE, "agent");
            asm volatile("s_waitcnt vmcnt(0)" ::: "memory");
            const unsigned og = xb_add(&bar[XB_TOP], 1u);
            const unsigned tg = og / nx;
            if (og + 1u == (tg + 1u) * nx) xb_add(&bar[XB_TOPGEN], 1u);
            else XB_SPIN(xb_ld(&bar[XB_TOPGEN]) == tg, bar);
            __builtin_amdgcn_fence(__ATOMIC_ACQUIRE, "agent");
            xb_add(&bar[XB_XGEN(b.x)], 1u);
            asm volatile("s_waitcnt vmcnt(0)" ::: "memory");
        } else {
            XB_SPIN(xb_ld(&bar[XB_XGEN(b.x)]) == gen, bar);
            __builtin_amdgcn_fence(__ATOMIC_ACQUIRE, "agent");
            asm volatile("s_waitcnt vmcnt(0)" ::: "memory");
        }
    }
    __syncthreads();
}

struct Frame {
    LAS unsigned char* lds;
    volatile LAS unsigned* MISC;
    gu32* ctl;
    int tid, lane, wave;
    int vcu, G;
    unsigned char* ws; float* out;
    const float *x_prompt, *x_sample, *st_s5r, *st_s5i, *st_hg, *st_cv, *meta, *g_mix, *w_in, *lam_re, *lam_im, *log_dt, *b_re, *b_im, *c_re, *c_im, *s5_d,
                *w_glu, *b_glu, *hg_lb, *hg_ng, *w_out, *g_ffn, *w_up, *conv_w, *conv_b, *w_down, *g_final;
};
#define EPI_ARGS const f32x4 (&acc)[2][2][4][2], const pg8::Unit& u, int wr, int wc, int fr, int fq

struct EpiIn {
    bf16 *U, *Q, *V, *G; float* LF; const float* lb;
    __device__ __forceinline__ void operator()(EPI_ARGS) const {
        const int seg = u.pn >> 1, cb = (u.pn & 1) * 256 + wc * 32 + 8 * fq, row0 = u.pm * 256 + wr * 64 + fr;
        bf16* dstb = seg == 0 ? U : (seg == 1 ? Q : (seg == 3 ? V : G));
#pragma unroll
        for (int ai = 0; ai < 2; ++ai)
#pragma unroll
            for (int m = 0; m < 4; ++m) { const size_t row = (size_t)(row0 + ai * 128 + m * 16);
#pragma unroll
                for (int bj = 0; bj < 2; ++bj) { const int col = cb + bj * 128; f32x4 v0 = acc[ai][bj][m][0], v1 = acc[ai][bj][m][1];
                    if (seg == 2) {
                        const f32x4 l0 = *(const f32x4*)(lb + col), l1 = *(const f32x4*)(lb + col + 4); f32x4 o0, o1;
#pragma unroll
                        for (int j = 0; j < 4; ++j) { o0[j] = __logf(l0[j] + (1.f - l0[j]) * sigmoidf_(v0[j])); o1[j] = __logf(l1[j] + (1.f - l1[j]) * sigmoidf_(v1[j])); }
                        *(f32x4*)(LF + row * HD + col) = o0; *(f32x4*)(LF + row * HD + col + 4) = o1;
                    } else {
                        if (seg == 4) {
#pragma unroll
                            for (int j = 0; j < 4; ++j) { v0[j] = siluf_(v0[j]); v1[j] = siluf_(v1[j]); } }
                        v4u w; w.x = pk2(v0[0], v0[1]); w.y = pk2(v0[2], v0[3]); w.z = pk2(v1[0], v1[1]); w.w = pk2(v1[2], v1[3]);
                        *(v4u*)(dstb + row * HD + col) = w;
                    } } }
    }
};
struct EpiGlu {
    const bf16* Y5; const float* bias; bf16* MIX;
    __device__ __forceinline__ void operator()(EPI_ARGS) const {
        const int col0 = u.pn * 256 + wc * 32 + 8 * fq, row0 = u.pm * 256 + wr * 64 + fr;
#pragma unroll
        for (int ai = 0; ai < 2; ++ai)
#pragma unroll
            for (int m = 0; m < 4; ++m) { const size_t row = (size_t)(row0 + ai * 128 + m * 16);
#pragma unroll
                for (int bj = 0; bj < 2; ++bj) { const int col = col0 + bj * 128; const f32x4 v0 = acc[ai][bj][m][0], v1 = acc[ai][bj][m][1];
                    const f32x4 b0 = *(const f32x4*)(bias + col), b1 = *(const f32x4*)(bias + col + 4);
                    const v4u y = *(const v4u*)(Y5 + row * HD + col);
                    v4u w;
                    w.x = pk2(bflo(y.x) * sigmoidf_(v0[0] + b0[0]), bfhi(y.x) * sigmoidf_(v0[1] + b0[1]));
                    w.y = pk2(bflo(y.y) * sigmoidf_(v0[2] + b0[2]), bfhi(y.y) * sigmoidf_(v0[3] + b0[3]));
                    w.z = pk2(bflo(y.z) * sigmoidf_(v1[0] + b1[0]), bfhi(y.z) * sigmoidf_(v1[1] + b1[1]));
                    w.w = pk2(bflo(y.w) * sigmoidf_(v1[2] + b1[2]), bfhi(y.w) * sigmoidf_(v1[3] + b1[3]));
                    *(v4u*)(MIX + row * D + col) = w; } }
    }
};
struct EpiOut {
    const float *xp, *meta, *xs; float *out, *h1meta; bf16* H1B; float* ss;
    __device__ __forceinline__ void operator()(EPI_ARGS) const {
        const int col0 = u.pn * 256 + wc * 32 + 8 * fq, row0 = u.pm * 256 + wr * 64 + fr;
#pragma unroll
        for (int ai = 0; ai < 2; ++ai)
#pragma unroll
            for (int m = 0; m < 4; ++m) { const int row = row0 + ai * 128 + m * 16;
                const float* src = row < R_META ? xp + (size_t)row * D : (row < R_SAMP ? meta + (size_t)((row - R_META) & 15) * D : xs + (size_t)(row - R_SAMP) * D);
                float* dst = row < R_META ? out + (size_t)row * D : (row < R_SAMP ? h1meta + (size_t)(row - R_META) * D : out + OFF_YS + (size_t)(row - R_SAMP) * D);
                float s = 0.f;
#pragma unroll
                for (int bj = 0; bj < 2; ++bj) { const int col = col0 + bj * 128;
                    const f32x4 h0 = *(const f32x4*)(src + col) + acc[ai][bj][m][0], h1 = *(const f32x4*)(src + col + 4) + acc[ai][bj][m][1];
                    *(f32x4*)(dst + col) = h0; *(f32x4*)(dst + col + 4) = h1;
                    v4u w; w.x = pk2(h0[0], h0[1]); w.y = pk2(h0[2], h0[3]); w.z = pk2(h1[0], h1[1]); w.w = pk2(h1[2], h1[3]);
                    *(v4u*)(H1B + (size_t)row * D + col) = w;
                    s += (h0[0] * h0[0] + h0[1] * h0[1]) + (h0[2] * h0[2] + h0[3] * h0[3]) + (h1[0] * h1[0] + h1[1] * h1[1]) + (h1[2] * h1[2] + h1[3] * h1[3]); }
                s += __shfl_xor(s, 16); s += __shfl_xor(s, 32);
                if (fq == 0) atomic_addf(ss + row, s); }
    }
};
struct EpiUp {
    const float* ss; bf16* HID; float* out;
    __device__ __forceinline__ void operator()(EPI_ARGS) const {
        const int col0 = u.pn * 256 + wc * 32 + 8 * fq, row0 = u.pm * 256 + wr * 64 + fr;
#pragma unroll
        for (int ai = 0; ai < 2; ++ai)
#pragma unroll
            for (int m = 0; m < 4; ++m) { const int row = row0 + ai * 128 + m * 16;
                const float rstd = __builtin_amdgcn_rsqf(ld_agent(ss + row) * (1.0f / D) + EPS);
                float* cv = nullptr;
                if (u.pn < 11) {
                    if (row < R_META) { const int t = row & 2047; if (t >= 2046) cv = out + OFF_CVP + (size_t)((row >> 11) * 2 + (t - 2046)) * DFF; }
                    else if (row >= R_SAMP) cv = out + OFF_CVS + (size_t)((row - R_SAMP) * 2 + 1) * DFF;
                }
#pragma unroll
                for (int bj = 0; bj < 2; ++bj) { const int col = col0 + bj * 128; const f32x4 v0 = acc[ai][bj][m][0] * rstd, v1 = acc[ai][bj][m][1] * rstd;
                    v4u w; w.x = pk2(v0[0], v0[1]); w.y = pk2(v0[2], v0[3]); w.z = pk2(v1[0], v1[1]); w.w = pk2(v1[2], v1[3]);
                    *(v4u*)(HID + (size_t)row * UPC + col) = w;
                    if (cv) { *(f32x4*)(cv + col) = v0; *(f32x4*)(cv + col + 4) = v1; } } }
    }
};
struct EpiDown {
    float *out, *h1meta; float* ss;
    __device__ __forceinline__ void operator()(EPI_ARGS) const {
        const int col0 = u.pn * 256 + wc * 32 + 8 * fq, row0 = u.pm * 256 + wr * 64 + fr;
#pragma unroll
        for (int ai = 0; ai < 2; ++ai)
#pragma unroll
            for (int m = 0; m < 4; ++m) { const int row = row0 + ai * 128 + m * 16;
                float* dst = row < R_META ? out + (size_t)row * D : (row < R_SAMP ? h1meta + (size_t)(row - R_META) * D : out + OFF_YS + (size_t)(row - R_SAMP) * D);
                float s = 0.f;
#pragma unroll
                for (int bj = 0; bj < 2; ++bj) { const int col = col0 + bj * 128;
                    const f32x4 h0 = *(const f32x4*)(dst + col) + acc[ai][bj][m][0], h1 = *(const f32x4*)(dst + col + 4) + acc[ai][bj][m][1];
                    *(f32x4*)(dst + col) = h0; *(f32x4*)(dst + col + 4) = h1;
                    s += (h0[0] * h0[0] + h0[1] * h0[1]) + (h0[2] * h0[2] + h0[3] * h0[3]) + (h1[0] * h1[0] + h1[1] * h1[1]) + (h1[2] * h1[2] + h1[3] * h1[3]); }
                s += __shfl_xor(s, 16); s += __shfl_xor(s, 32);
                if (fq == 0) atomic_addf(ss + row, s); }
    }
};
__device__ __forceinline__ void p0_transpose_item(const float* W, int K, int N, bf16* WT, const float* ksc, LAS float* scr, int item, int lane) {
    const int nblk = N / 32, kb = item / nblk, nb = item % nblk, k0 = 64 * kb, n0 = 32 * nb;
#pragma unroll 8
    for (int i = 0; i < 32; ++i) { const int kk = 2 * i + (lane >> 5); const float sc = ksc ? ksc[k0 + kk] : 1.0f; scr[kk * 33 + (lane & 31)] = W[(size_t)(k0 + kk) * N + n0 + (lane & 31)] * sc; }
    LDS_WAIT(); asm volatile("" ::: "memory");
    const int c = lane & 7;
#pragma unroll
    for (int j = 0; j < 4; ++j) { const int n = (lane >> 3) + 8 * j; const LAS float* s = scr + (8 * c) * 33 + n;
        v4u o; o.x = pk2(s[0 * 33], s[1 * 33]); o.y = pk2(s[2 * 33], s[3 * 33]); o.z = pk2(s[4 * 33], s[5 * 33]); o.w = pk2(s[6 * 33], s[7 * 33]);
        *(GAS v4u*)(WT + (size_t)(n0 + n) * K + k0 + 8 * c) = o; }
    LDS_WAIT(); asm volatile("" ::: "memory");
}
__device__ __forceinline__ void rms_row_to_bf16(int lane, const float* xrow, bf16* orow) {
    const GAS f32x4* xr = (const GAS f32x4*)xrow + lane;
    f32x4 v[4]; float s = 0.f;
#pragma unroll
    for (int j = 0; j < 4; ++j) { v[j] = xr[64 * j]; s += (v[j].x * v[j].x + v[j].y * v[j].y) + (v[j].z * v[j].z + v[j].w * v[j].w); }
    const float rstd = 1.0f / sqrtf(wave_sum(s) * (1.f / D) + EPS);
    GAS unsigned long long* o8 = (GAS unsigned long long*)orow + lane;
#pragma unroll
    for (int j = 0; j < 4; ++j) o8[64 * j] = (unsigned long long)pk2(v[j].x * rstd, v[j].y * rstd) | ((unsigned long long)pk2(v[j].z * rstd, v[j].w * rstd) << 32);
}
__device__ __forceinline__ void s5_precompute_group(Frame& F, int g) {
    LAS float* Ap = (LAS float*)F.lds;
    LAS float* Bb = Ap + 2176;
    LAS float* Cc = Bb + 2048;
    LAS float* Kt = Cc + 2048;
    const int tid = F.tid;
    float* A1 = (float*)(F.ws + WS_S5F + S5F_A1); float* A16 = (float*)(F.ws + WS_S5F + S5F_A16); float* BBf = (float*)(F.ws + WS_S5F + S5F_BB);
    if (tid < 64) {
        const int p = tid; const float dt = expf(F.log_dt[g]); const float lr = F.lam_re[g * 64 + p], li = F.lam_im[g * 64 + p];
        const double TWO_PI = 6.283185307179586476925286766559;
        for (int j = 0; j <= 16; ++j) {
            const float mag = expf(lr * dt * (float)j);
            double rev = ((double)li * (double)dt * (double)j) / TWO_PI; rev -= rint(rev);
            const float ang = (float)(rev * TWO_PI);
            Ap[(j * 64 + p) * 2] = mag * cosf(ang); Ap[(j * 64 + p) * 2 + 1] = mag * sinf(ang);
        }
        const float ar = Ap[(64 + p) * 2], ai = Ap[(64 + p) * 2 + 1];
        const float nr = ar - 1.0f, den = lr * lr + li * li, cr = (nr * lr + ai * li) / den, ci = (ai * lr - nr * li) / den;
        for (int c = 0; c < 16; ++c) { const float bre = F.b_re[(g * 64 + p) * 16 + c], bim = F.b_im[(g * 64 + p) * 16 + c];
            const float xr = cr * bre - ci * bim, xi = cr * bim + ci * bre;
            Bb[(p * 16 + c) * 2] = xr; Bb[(p * 16 + c) * 2 + 1] = xi; BBf[((g * 64 + p) * 16 + c) * 2] = xr; BBf[((g * 64 + p) * 16 + c) * 2 + 1] = xi; }
        A1[(g * 64 + p) * 2] = ar; A1[(g * 64 + p) * 2 + 1] = ai;
        A16[(g * 64 + p) * 2] = Ap[(16 * 64 + p) * 2]; A16[(g * 64 + p) * 2 + 1] = Ap[(16 * 64 + p) * 2 + 1];
    }
    for (int idx = tid; idx < 1024; idx += 512) { const int co = idx >> 6, p = idx & 63; Cc[idx * 2] = F.c_re[(g * 16 + co) * 64 + p]; Cc[idx * 2 + 1] = F.c_im[(g * 16 + co) * 64 + p]; }
    __syncthreads();
    for (int idx = tid; idx < 4096; idx += 512) { const int j = idx >> 8, co = (idx >> 4) & 15, ci = idx & 15; float kv = 0.f;
        for (int p = 0; p < 64; ++p) { const float cr = Cc[(co * 64 + p) * 2], cim = Cc[(co * 64 + p) * 2 + 1], ar = Ap[(j * 64 + p) * 2], ai = Ap[(j * 64 + p) * 2 + 1];
            const float car = cr * ar - cim * ai, cai = cr * ai + cim * ar; kv += car * Bb[(p * 16 + ci) * 2] - cai * Bb[(p * 16 + ci) * 2 + 1]; }
        if (j == 0 && co == ci) kv += F.s5_d[g * 16 + co];
        Kt[idx] = kv; }
    __syncthreads();
    bf16* W1 = (bf16*)(F.ws + WS_S5W1) + (size_t)g * 384 * 256; bf16* W2 = (bf16*)(F.ws + WS_S5W2) + (size_t)g * 256 * 128;
    for (int idx = tid; idx < 256 * 128; idx += 512) { const int n = idx >> 7, k = (idx & 127) * 2, s = k >> 4, ci = k & 15, t = n >> 4, co = n & 15;
        float v0 = 0.f, v1 = 0.f; if (t >= s) { v0 = Kt[(t - s) * 256 + co * 16 + ci]; v1 = Kt[(t - s) * 256 + co * 16 + ci + 1]; }
        *(unsigned*)(W1 + (size_t)n * 256 + k) = pk2(v0, v1); }
    for (int idx = tid; idx < 128 * 128; idx += 512) { const int pp = idx >> 7, k = (idx & 127) * 2, s = k >> 4, ci = k & 15, p = pp & 63;
        const float ar = Ap[((15 - s) * 64 + p) * 2], ai = Ap[((15 - s) * 64 + p) * 2 + 1];
        const float b0r = Bb[(p * 16 + ci) * 2], b0i = Bb[(p * 16 + ci) * 2 + 1], b1r = Bb[(p * 16 + ci + 1) * 2], b1i = Bb[(p * 16 + ci + 1) * 2 + 1];
        const float v0 = pp < 64 ? ar * b0r - ai * b0i : ar * b0i + ai * b0r, v1 = pp < 64 ? ar * b1r - ai * b1i : ar * b1i + ai * b1r;
        *(unsigned*)(W1 + (size_t)(256 + pp) * 256 + k) = pk2(v0, v1); }
    for (int idx = tid; idx < 256 * 64; idx += 512) { const int n = idx >> 6, kq = (idx & 63) * 2, t = n >> 4, co = n & 15; float v[2];
#pragma unroll
        for (int e = 0; e < 2; ++e) { const int pp = kq + e, p = pp & 63; const float cr = Cc[(co * 64 + p) * 2], cim = Cc[(co * 64 + p) * 2 + 1], ar = Ap[((t + 1) * 64 + p) * 2], ai = Ap[((t + 1) * 64 + p) * 2 + 1];
            v[e] = pp < 64 ? (cr * ar - cim * ai) : -(cr * ai + cim * ar); }
        *(unsigned*)(W2 + (size_t)n * 128 + kq) = pk2(v[0], v[1]); }
    __syncthreads();
}
__device__ __forceinline__ void p0_prologue(Frame& F) {
    if (F.vcu < 32) s5_precompute_group(F, F.vcu);
    if (F.vcu == 32 && F.tid < 512) {
        float* LB = (float*)(F.ws + WS_S5F + S5F_LB); const float a0 = F.hg_lb[F.tid], a1 = F.hg_lb[512 + F.tid], mx = fmaxf(a0, a1), e0 = expf(a0 - mx), e1 = expf(a1 - mx); LB[F.tid] = e0 / (e0 + e1); }
    LAS float* scr = (LAS float*)(F.lds + RING_OFF + F.wave * 16384);
    const int gw = F.vcu * NWAVES + F.wave, NGW = F.G * NWAVES;
    constexpr int I_IN = (D / 64) * (INC / 32), I_GLU = (HD / 64) * (HD / 32), I_OUT = (D / 64) * (D / 32), I_UP = (D / 64) * (UPC / 32), I_DN = (DFF / 64) * (D / 32);
    constexpr int NITEMS = I_IN + I_GLU + I_OUT + I_UP + I_DN;
    for (int it = gw; it < NITEMS; it += NGW) {
        int r = it;
        if (r < I_IN) { p0_transpose_item(F.w_in, D, INC, (bf16*)(F.ws + WS_WIN), F.g_mix, scr, r, F.lane); continue; } r -= I_IN;
        if (r < I_GLU) { p0_transpose_item(F.w_glu, HD, HD, (bf16*)(F.ws + WS_WGLU), nullptr, scr, r, F.lane); continue; } r -= I_GLU;
        if (r < I_OUT) { p0_transpose_item(F.w_out, D, D, (bf16*)(F.ws + WS_WOUT), nullptr, scr, r, F.lane); continue; } r -= I_OUT;
        if (r < I_UP) { p0_transpose_item(F.w_up, D, UPC, (bf16*)(F.ws + WS_WUP), F.g_ffn, scr, r, F.lane); continue; } r -= I_UP;
        p0_transpose_item(F.w_down, DFF, D, (bf16*)(F.ws + WS_WDN), nullptr, scr, r, F.lane);
    }
    bf16* XN = (bf16*)(F.ws + WS_XN);
    for (int m = gw; m < RT; m += NGW) {
        const float* src = m < R_META ? F.x_prompt + (size_t)m * D : (m < R_SAMP ? F.meta + (size_t)((m - R_META) & 15) * D : F.x_sample + (size_t)(m - R_SAMP) * D);
        rms_row_to_bf16(F.lane, src, XN + (size_t)m * D);
    }
}

__device__ __forceinline__ void s5_prompt_item(Frame& F, int item) {
    const int g = item & 31, n = item >> 5;
    LAS unsigned char* R1 = F.lds;
    LAS float* R2 = (LAS float*)(F.lds + 76032);
    int tid = F.tid; asm volatile("" : "+v"(tid));
    const int lane = tid & 63, w = F.wave, r = lane & 15, q = lane >> 4;
    const bf16* U = (const bf16*)(F.ws + WS_U);
#pragma unroll
    for (int i = 0; i < 9; ++i) { const int idx = tid + 512 * i, c = idx >> 5, pc = idx & 31, s = pc >> 1, half = pc & 1, cc = c < 128 ? c : 128;
        const int grow = cc == 0 ? R_META + 16 * n + s : 2048 * n + 16 * (cc - 1) + s;
        const v4u val = *(const v4u*)(U + (size_t)grow * HD + 16 * g + 8 * half);
        *(LAS v4u*)(R1 + c * 528 + pc * 16) = val; }
    __syncthreads();
    const bf16* W1 = (const bf16*)(F.ws + WS_S5W1) + (size_t)g * 384 * 256; const bf16* W2 = (const bf16*)(F.ws + WS_S5W2) + (size_t)g * 256 * 128;
    f32x4 acc0[9], acc1[9], acc2[9];
#pragma unroll
    for (int mt = 0; mt < 9; ++mt) { acc0[mt] = (f32x4){0.f, 0.f, 0.f, 0.f}; acc1[mt] = acc0[mt]; acc2[mt] = acc0[mt]; }
#pragma unroll 1
    for (int kk = 0; kk < 8; ++kk) {
        const bool need0 = (2 * kk <= w);
        const bool need1 = (2 * kk <= w + 8);
        const bf16x8 b2 = *(const bf16x8*)(W1 + (size_t)(16 * (16 + w) + r) * 256 + 32 * kk + 8 * q);
        bf16x8 b0 = b2, b1 = b2;
        if (need0) b0 = *(const bf16x8*)(W1 + (size_t)(16 * w + r) * 256 + 32 * kk + 8 * q);
        if (need1) b1 = *(const bf16x8*)(W1 + (size_t)(16 * (w + 8) + r) * 256 + 32 * kk + 8 * q);
#pragma unroll
        for (int mt = 0; mt < 9; ++mt) { const bf16x8 a = *(const LAS bf16x8*)(R1 + (16 * mt + r) * 528 + (32 * kk + 8 * q) * 2);
            acc2[mt] = mfma16(a, b2, acc2[mt]);
            if (need0) acc0[mt] = mfma16(a, b0, acc0[mt]);
            if (need1) acc1[mt] = mfma16(a, b1, acc1[mt]); }
    }
#pragma unroll
    for (int mt = 0; mt < 9; ++mt)
#pragma unroll
        for (int i = 0; i < 4; ++i) R2[(16 * mt + 4 * q + i) * 132 + 16 * w + r] = acc2[mt][i];
    __syncthreads();
    if (w == 0) {
        const float* A16 = (const float*)(F.ws + WS_S5F + S5F_A16); const float ar = A16[(g * 64 + lane) * 2], ai = A16[(g * 64 + lane) * 2 + 1];
        float hr = 0.f, hi = 0.f;
        for (int c0 = 0; c0 < 136; c0 += 8) {
            float lr[8], li[8];
#pragma unroll
            for (int j = 0; j < 8; ++j) { lr[j] = R2[(c0 + j) * 132 + lane]; li[j] = R2[(c0 + j) * 132 + 64 + lane]; }
#pragma unroll
            for (int j = 0; j < 8; ++j) { const int c = c0 + j;
                if (c <= 128) {
                    *(LAS bf16*)(R1 + c * 272 + lane * 2) = (bf16)f2bf(hr); *(LAS bf16*)(R1 + c * 272 + 128 + lane * 2) = (bf16)f2bf(hi);
                    const float nr = ar * hr - ai * hi + lr[j], ni = ar * hi + ai * hr + li[j]; hr = nr; hi = ni;
                } else { *(LAS bf16*)(R1 + c * 272 + lane * 2) = 0; *(LAS bf16*)(R1 + c * 272 + 128 + lane * 2) = 0; } }
        }
#pragma unroll
        for (int c = 136; c < 144; ++c) { *(LAS bf16*)(R1 + c * 272 + lane * 2) = 0; *(LAS bf16*)(R1 + c * 272 + 128 + lane * 2) = 0; }
        F.out[OFF_S5RP + (size_t)(n * 32 + g) * 64 + lane] = hr; F.out[OFF_S5IP + (size_t)(n * 32 + g) * 64 + lane] = hi;
    }
    __syncthreads();
#pragma unroll 1
    for (int kk = 0; kk < 4; ++kk) {
        const bf16x8 b0 = *(const bf16x8*)(W2 + (size_t)(16 * w + r) * 128 + 32 * kk + 8 * q), b1 = *(const bf16x8*)(W2 + (size_t)(16 * (w + 8) + r) * 128 + 32 * kk + 8 * q);
#pragma unroll
        for (int mt = 0; mt < 9; ++mt) { const bf16x8 a = *(const LAS bf16x8*)(R1 + (16 * mt + r) * 272 + (32 * kk + 8 * q) * 2);
            acc0[mt] = mfma16(a, b0, acc0[mt]); acc1[mt] = mfma16(a, b1, acc1[mt]); }
    }
    bf16* Y5 = (bf16*)(F.ws + WS_Y5);
#pragma unroll
    for (int mt = 0; mt < 9; ++mt)
#pragma unroll
        for (int i = 0; i < 4; ++i) { const int c = 16 * mt + 4 * q + i;
            if (c <= 128) { const int rb = c == 0 ? R_META + 16 * n : 2048 * n + 16 * (c - 1);
                Y5[(size_t)(rb + w) * HD + 16 * g + r] = (bf16)f2bf(gelu_tanh(acc0[mt][i]));
                Y5[(size_t)(rb + w + 8) * HD + 16 * g + r] = (bf16)f2bf(gelu_tanh(acc1[mt][i])); } }
    __syncthreads();
}
__device__ __forceinline__ void s5_sample_item(Frame& F, int item) {
    const int g = item & 31, s = item >> 5, lane = F.lane, row = R_SAMP + s;
    const bf16* U = (const bf16*)(F.ws + WS_U); bf16* Y5 = (bf16*)(F.ws + WS_Y5);
    const float* A1 = (const float*)(F.ws + WS_S5F + S5F_A1); const float* BBf = (const float*)(F.ws + WS_S5F + S5F_BB);
    const v4u u0 = *(const v4u*)(U + (size_t)row * HD + 16 * g), u1 = *(const v4u*)(U + (size_t)row * HD + 16 * g + 8);
    float uu[16]; uu[0] = bflo(u0.x); uu[1] = bfhi(u0.x); uu[2] = bflo(u0.y); uu[3] = bfhi(u0.y); uu[4] = bflo(u0.z); uu[5] = bfhi(u0.z); uu[6] = bflo(u0.w); uu[7] = bfhi(u0.w);
    uu[8] = bflo(u1.x); uu[9] = bfhi(u1.x); uu[10] = bflo(u1.y); uu[11] = bfhi(u1.y); uu[12] = bflo(u1.z); uu[13] = bfhi(u1.z); uu[14] = bflo(u1.w); uu[15] = bfhi(u1.w);
    float xr = 0.f, xi = 0.f; const float* bb = BBf + (size_t)(g * 64 + lane) * 32;
#pragma unroll
    for (int c = 0; c < 16; ++c) { xr += bb[2 * c] * uu[c]; xi += bb[2 * c + 1] * uu[c]; }
    const float ar = A1[(g * 64 + lane) * 2], ai = A1[(g * 64 + lane) * 2 + 1];
    const float h0r = F.st_s5r[(size_t)(s * 32 + g) * 64 + lane], h0i = F.st_s5i[(size_t)(s * 32 + g) * 64 + lane];
    const float hr = ar * h0r - ai * h0i + xr, hi = ar * h0i + ai * h0r + xi;
    F.out[OFF_S5RS + (size_t)(s * 32 + g) * 64 + lane] = hr; F.out[OFF_S5IS + (size_t)(s * 32 + g) * 64 + lane] = hi;
    float yk = 0.f;
#pragma unroll
    for (int co = 0; co < 16; ++co) { const float part = hr * F.c_re[(g * 16 + co) * 64 + lane] - hi * F.c_im[(g * 16 + co) * 64 + lane]; const float tot = wave_sum(part); if (lane == co) yk = tot; }
    if (lane < 16) { float uc = 0.f;
#pragma unroll
        for (int c = 0; c < 16; ++c) uc = (lane == c) ? uu[c] : uc;
        const float y = yk + F.s5_d[g * 16 + lane] * uc; Y5[(size_t)row * HD + 16 * g + lane] = (bf16)f2bf(gelu_tanh(y)); }
}
#define HG_O_QD 0
#define HG_O_KD 17408
#define HG_O_KT 34816
#define HG_O_VT 53248
#define HG_O_ATT 55552
#define HG_O_ST 64768
#define HG_O_SEG 69120
#define HG_O_DEC 71168
__device__ __forceinline__ void hgrn_prompt_item(Frame& F, int item) {
    const int vs = item & 7, h = (item >> 3) & 3, n = item >> 5;
    LAS unsigned char* L = F.lds;
    int tid = F.tid; asm volatile("" : "+v"(tid));
    const int lane = tid & 63, w = F.wave, r = lane & 15, q = lane >> 4;
    const bf16* Qb = (const bf16*)(F.ws + WS_Q); const bf16* Vb = (const bf16*)(F.ws + WS_V); const float* LF = (const float*)(F.ws + WS_LF);
    bf16* OH = (bf16*)(F.ws + WS_OH); float* HSS = (float*)(F.ws + WS_CTL + CB_HSS);
    for (int i = tid; i < (9216 + 4352) / 4; i += 512) ((LAS unsigned*)(L + HG_O_ATT))[i] = 0u;
    f32x4 Sreg = (f32x4){0.f, 0.f, 0.f, 0.f};
    const int k = tid & 127, s4 = tid >> 7, tv = tid >> 3, pr = tid & 7;
    float lf[16]; unsigned short qv[16]; unsigned vv;
#define HG_LOAD(c) do { \
        _Pragma("unroll") for (int i = 0; i < 16; ++i) { const int t = 16 * s4 + i; const int row = (c) == 0 ? (t < 16 ? R_META + 16 * n + t : -1) : 2048 * n + 64 * ((c) - 1) + t; \
            if (row >= 0) { lf[i] = LF[(size_t)row * HD + 128 * h + k]; qv[i] = Qb[(size_t)row * HD + 128 * h + k]; } else { lf[i] = 0.f; qv[i] = 0; } } \
        { const int row = (c) == 0 ? (tv < 16 ? R_META + 16 * n + tv : -1) : 2048 * n + 64 * ((c) - 1) + tv; \
          vv = row >= 0 ? *(const unsigned*)(Vb + (size_t)row * HD + 128 * h + 16 * vs + 2 * pr) : 0u; } } while (0)
    HG_LOAD(0);
    for (int c = 0; c <= 32; ++c) {
        float bc[16]; float run = 0.f;
#pragma unroll
        for (int i = 0; i < 16; ++i) { run += lf[i]; bc[i] = run; }
        ((LAS float*)(L + HG_O_SEG))[s4 * 128 + k] = run;
        __syncthreads();
        float off = 0.f, bl = 0.f;
#pragma unroll
        for (int s = 0; s < 4; ++s) { const float v = ((LAS float*)(L + HG_O_SEG))[s * 128 + k]; bl += v; off += (s < s4) ? v : 0.f; }
        if (s4 == 0) ((LAS float*)(L + HG_O_DEC))[k] = __expf(bl);
        unsigned kp[8];
#pragma unroll
        for (int i = 0; i < 16; i += 2) { float kdl2[2];
#pragma unroll
            for (int e = 0; e < 2; ++e) { const int ii = i + e; const float b = off + bc[ii], f = __expf(lf[ii]), kk = 1.0f - f, eb = __expf(b), enb = __expf(-b);
                *(LAS bf16*)(L + HG_O_QD + (16 * s4 + ii) * 272 + k * 2) = (bf16)f2bf(bf2f(qv[ii]) * eb);
                *(LAS bf16*)(L + HG_O_KD + (16 * s4 + ii) * 272 + k * 2) = (bf16)f2bf(kk * enb);
                kdl2[e] = kk * __expf(bl - b); }
            kp[i >> 1] = pk2(kdl2[0], kdl2[1]); }
        *(LAS v4u*)(L + HG_O_KT + k * 144 + (16 * s4) * 2) = (v4u){kp[0], kp[1], kp[2], kp[3]};
        *(LAS v4u*)(L + HG_O_KT + k * 144 + (16 * s4) * 2 + 16) = (v4u){kp[4], kp[5], kp[6], kp[7]};
        *(LAS bf16*)(L + HG_O_VT + (2 * pr) * 144 + tv * 2) = (bf16)(vv & 0xffffu); *(LAS bf16*)(L + HG_O_VT + (2 * pr + 1) * 144 + tv * 2) = (bf16)(vv >> 16);
        __syncthreads();
        if (c < 32) HG_LOAD(c + 1);
        f32x4 accS;
#pragma unroll
        for (int i = 0; i < 4; ++i) accS[i] = ((LAS float*)(L + HG_O_DEC))[16 * w + 4 * q + i] * Sreg[i];
#pragma unroll
        for (int kk = 0; kk < 2; ++kk) { const bf16x8 a = *(const LAS bf16x8*)(L + HG_O_KT + (16 * w + r) * 144 + (32 * kk + 8 * q) * 2), b = *(const LAS bf16x8*)(L + HG_O_VT + r * 144 + (32 * kk + 8 * q) * 2); accS = mfma16(a, b, accS); }
#pragma unroll
        for (int rep = 0; rep < 2; ++rep) { const int idx = w + 8 * rep;
            if (idx < 10) { const int ti = idx < 1 ? 0 : (idx < 3 ? 1 : (idx < 6 ? 2 : 3)), sj = idx - (ti * (ti + 1)) / 2;
                f32x4 at = (f32x4){0.f, 0.f, 0.f, 0.f};
#pragma unroll
                for (int kk = 0; kk < 4; ++kk) { const bf16x8 a = *(const LAS bf16x8*)(L + HG_O_QD + (16 * ti + r) * 272 + (32 * kk + 8 * q) * 2), b = *(const LAS bf16x8*)(L + HG_O_KD + (16 * sj + r) * 272 + (32 * kk + 8 * q) * 2); at = mfma16(a, b, at); }
#pragma unroll
                for (int i = 0; i < 4; ++i) { const int t = 16 * ti + 4 * q + i, s = 16 * sj + r; *(LAS bf16*)(L + HG_O_ATT + t * 144 + s * 2) = (bf16)f2bf(s <= t ? at[i] : 0.f); } } }
        f32x4 o = (f32x4){0.f, 0.f, 0.f, 0.f};
        if (w < 4) {
#pragma unroll
            for (int kk = 0; kk < 4; ++kk) { const bf16x8 a = *(const LAS bf16x8*)(L + HG_O_QD + (16 * w + r) * 272 + (32 * kk + 8 * q) * 2), b = *(const LAS bf16x8*)(L + HG_O_ST + r * 272 + (32 * kk + 8 * q) * 2); o = mfma16(a, b, o); } }
        __syncthreads();
        Sreg = accS;
        *(LAS v2u*)(L + HG_O_ST + r * 272 + (16 * w + 4 * q) * 2) = (v2u){pk2(Sreg[0], Sreg[1]), pk2(Sreg[2], Sreg[3])};
        if (w < 4) {
#pragma unroll
            for (int kk = 0; kk < 2; ++kk) { const bf16x8 a = *(const LAS bf16x8*)(L + HG_O_ATT + (16 * w + r) * 144 + (32 * kk + 8 * q) * 2), b = *(const LAS bf16x8*)(L + HG_O_VT + r * 144 + (32 * kk + 8 * q) * 2); o = mfma16(a, b, o); }
#pragma unroll
            for (int i = 0; i < 4; ++i) { const int t = 16 * w + 4 * q + i; const int row = c == 0 ? (t < 16 ? R_META + 16 * n + t : -1) : 2048 * n + 64 * (c - 1) + t;
                float ss = o[i] * o[i]; ss += __shfl_xor(ss, 1); ss += __shfl_xor(ss, 2); ss += __shfl_xor(ss, 4); ss += __shfl_xor(ss, 8);
                if (row >= 0) { OH[(size_t)row * HD + 128 * h + 16 * vs + r] = (bf16)f2bf(o[i]); if (r == 0) atomic_addf(HSS + (size_t)row * 4 + h, ss); } } }
        __syncthreads();
    }
#undef HG_LOAD
#pragma unroll
    for (int i = 0; i < 4; ++i) F.out[OFF_HGP + ((size_t)(n * 4 + h) * 128 + 16 * w + 4 * q + i) * 128 + 16 * vs + r] = Sreg[i];
}
__device__ __forceinline__ void hgrn_sample_item(Frame& F, int item) {
    const int h = item & 3, s = item >> 2, row = R_SAMP + s, tid = F.tid, vq = tid & 31, kg = tid >> 5;
    const bf16* Qb = (const bf16*)(F.ws + WS_Q); const bf16* Vb = (const bf16*)(F.ws + WS_V); const float* LF = (const float*)(F.ws + WS_LF);
    bf16* OH = (bf16*)(F.ws + WS_OH); float* HSS = (float*)(F.ws + WS_CTL + CB_HSS);
    LAS float* red = (LAS float*)F.lds;
    const v2u vw = *(const v2u*)(Vb + (size_t)row * HD + 128 * h + 4 * vq);
    const f32x4 v4 = (f32x4){bflo(vw.x), bfhi(vw.x), bflo(vw.y), bfhi(vw.y)};
    f32x4 o4 = (f32x4){0.f, 0.f, 0.f, 0.f};
#pragma unroll
    for (int i = 0; i < 8; ++i) { const int k = 8 * kg + i; const float f = __expf(LF[(size_t)row * HD + 128 * h + k]), kk = 1.0f - f, qk = bf2f(Qb[(size_t)row * HD + 128 * h + k]);
        const size_t off = ((size_t)(s * 4 + h) * 128 + k) * 128 + 4 * vq;
        const f32x4 sn = *(const f32x4*)(F.st_hg + off) * f + v4 * kk;
        *(f32x4*)(F.out + OFF_HGS + off) = sn; o4 += sn * qk; }
    *(LAS f32x4*)(red + kg * 128 + 4 * vq) = o4;
    __syncthreads();
    if (tid < 128) { float o = 0.f;
#pragma unroll
        for (int j = 0; j < 16; ++j) o += red[j * 128 + tid];
        OH[(size_t)row * HD + 128 * h + tid] = (bf16)f2bf(o);
        const float ss = wave_sum(o * o); if (F.lane == 0) atomic_addf(HSS + (size_t)row * 4 + h, ss); }
    __syncthreads();
}
__device__ __forceinline__ void hgrn_finalize(Frame& F) {
    const bf16* OH = (const bf16*)(F.ws + WS_OH); const bf16* G = (const bf16*)(F.ws + WS_G); const float* HSS = (const float*)(F.ws + WS_CTL + CB_HSS); bf16* MIX = (bf16*)(F.ws + WS_MIX);
    const int gt = F.vcu * 512 + F.tid, NT = F.G * 512;
    for (int idx = gt; idx < RT * 64; idx += NT) { const int row = idx >> 6, c8 = (idx & 63) * 8;
        const float rstd = __builtin_amdgcn_rsqf(ld_agent(HSS + (size_t)row * 4 + (c8 >> 7)) * (1.0f / 128.0f) + EPS);
        const v4u o = *(const v4u*)(OH + (size_t)row * HD + c8), gg = *(const v4u*)(G + (size_t)row * HD + c8);
        const f32x4 n0 = *(const f32x4*)(F.hg_ng + c8), n1 = *(const f32x4*)(F.hg_ng + c8 + 4);
        v4u w;
        w.x = pk2(bflo(o.x) * rstd * n0[0] * bflo(gg.x), bfhi(o.x) * rstd * n0[1] * bfhi(gg.x));
        w.y = pk2(bflo(o.y) * rstd * n0[2] * bflo(gg.y), bfhi(o.y) * rstd * n0[3] * bfhi(gg.y));
        w.z = pk2(bflo(o.z) * rstd * n1[0] * bflo(gg.z), bfhi(o.z) * rstd * n1[1] * bfhi(gg.z));
        w.w = pk2(bflo(o.w) * rstd * n1[2] * bflo(gg.w), bfhi(o.w) * rstd * n1[3] * bfhi(gg.w));
        *(v4u*)(MIX + (size_t)row * D + 512 + c8) = w; }
}
__device__ __forceinline__ void gate_pass(Frame& F) {
    bf16* HID = (bf16*)(F.ws + WS_HID);
    const int gt = F.vcu * 512 + F.tid, NT = F.G * 512;
    for (int idx = gt; idx < RT * 352; idx += NT) { const int row = idx / 352, c8 = (idx - row * 352) * 8;
        float p1[8], p2[8], a[8], v[8];
        { const v4u x = *(const v4u*)(HID + (size_t)row * UPC + c8); a[0] = bflo(x.x); a[1] = bfhi(x.x); a[2] = bflo(x.y); a[3] = bfhi(x.y); a[4] = bflo(x.z); a[5] = bfhi(x.z); a[6] = bflo(x.w); a[7] = bfhi(x.w); }
        { const v4u x = *(const v4u*)(HID + (size_t)row * UPC + DFF + c8); v[0] = bflo(x.x); v[1] = bfhi(x.x); v[2] = bflo(x.y); v[3] = bfhi(x.y); v[4] = bflo(x.z); v[5] = bfhi(x.z); v[6] = bflo(x.w); v[7] = bfhi(x.w); }
        if (row >= R_SAMP) { const int s = row - R_SAMP; const float* b0 = F.st_cv + (size_t)(s * 2) * DFF + c8; const float* b1 = b0 + DFF;
#pragma unroll
            for (int j = 0; j < 8; ++j) { p2[j] = b0[j]; p1[j] = b1[j]; F.out[OFF_CVS + (size_t)(s * 2) * DFF + c8 + j] = b1[j]; }
        } else {
            int r1, r2;
            if (row < R_META) { const int t = row & 2047, nn = row >> 11; r1 = t >= 1 ? row - 1 : R_META + 16 * nn + 15; r2 = t >= 2 ? row - 2 : R_META + 16 * nn + 14 + t; }
            else { const int m = (row - R_META) & 15; r1 = m >= 1 ? row - 1 : -1; r2 = m >= 2 ? row - 2 : -1; }
            if (r1 >= 0) { const v4u x = *(const v4u*)(HID + (size_t)r1 * UPC + c8); p1[0] = bflo(x.x); p1[1] = bfhi(x.x); p1[2] = bflo(x.y); p1[3] = bfhi(x.y); p1[4] = bflo(x.z); p1[5] = bfhi(x.z); p1[6] = bflo(x.w); p1[7] = bfhi(x.w); }
            else {
#pragma unroll
                for (int j = 0; j < 8; ++j) p1[j] = 0.f; }
            if (r2 >= 0) { const v4u x = *(const v4u*)(HID + (size_t)r2 * UPC + c8); p2[0] = bflo(x.x); p2[1] = bfhi(x.x); p2[2] = bflo(x.y); p2[3] = bfhi(x.y); p2[4] = bflo(x.z); p2[5] = bfhi(x.z); p2[6] = bflo(x.w); p2[7] = bfhi(x.w); }
            else {
#pragma unroll
                for (int j = 0; j < 8; ++j) p2[j] = 0.f; }
        }
        float o[8];
#pragma unroll
        for (int j = 0; j < 8; ++j) { const float cc = F.conv_b[c8 + j] + F.conv_w[c8 + j] * p2[j] + F.conv_w[DFF + c8 + j] * p1[j] + F.conv_w[2 * DFF + c8 + j] * a[j]; o[j] = siluf_(cc) * v[j]; }
        v4u w; w.x = pk2(o[0], o[1]); w.y = pk2(o[2], o[3]); w.z = pk2(o[4], o[5]); w.w = pk2(o[6], o[7]);
        *(v4u*)(HID + (size_t)row * UPC + DFF + c8) = w; }
}
__device__ __forceinline__ void final_norm(Frame& F) {
    const float* SS3 = (const float*)(F.ws + WS_CTL + CB_SS3);
    const int gw = F.vcu * NWAVES + F.wave, NGW = F.G * NWAVES;
    for (int i = gw; i < R_META + NS; i += NGW) { const int row = i < R_META ? i : R_SAMP + (i - R_META);
        float* p = row < R_META ? F.out + (size_t)row * D : F.out + OFF_YS + (size_t)(row - R_SAMP) * D;
        const float rstd = __builtin_amdgcn_rsqf(ld_agent(SS3 + row) * (1.0f / D) + EPS);
#pragma unroll
        for (int j = 0; j < 4; ++j) { const int c = 4 * F.lane + 256 * j; f32x4 v = *(const f32x4*)(p + c); const f32x4 gg = *(const f32x4*)(F.g_final + c); v = v * rstd * gg; *(f32x4*)(p + c) = v; } }
}
#ifndef MK_N_LAUNCHES
#define MK_N_LAUNCHES 1
#endif
constexpr int N_LAUNCHES = MK_N_LAUNCHES;
constexpr int PER_PHASE = 9;
struct Args { const float* in[28]; float* out; unsigned char* ws; int ph_lo, ph_hi, li, pad; };
__global__ void __launch_bounds__(NWAVES * 64, 2) hymba_fwd(Args args) {
    extern __shared__ __attribute__((aligned(16))) unsigned char lds[];
    Frame F;
    F.lds = (LAS unsigned char*)lds;
    F.MISC = (volatile LAS unsigned*)(F.lds + MISC_OFF);
    F.tid = threadIdx.x; F.lane = F.tid & 63; F.wave = __builtin_amdgcn_readfirstlane(F.tid >> 6);
    F.G = gridDim.x; { const int bx = blockIdx.x; F.vcu = (F.G % 8 == 0) ? (bx % 8) * (F.G / 8) + bx / 8 : bx; }
    F.ws = args.ws; F.out = args.out; F.ctl = (gu32*)(args.ws + WS_CTL);
    F.x_prompt = args.in[0]; F.x_sample = args.in[1]; F.st_s5r = args.in[2]; F.st_s5i = args.in[3]; F.st_hg = args.in[4]; F.st_cv = args.in[5]; F.meta = args.in[6];
    F.g_mix = args.in[7]; F.w_in = args.in[8]; F.lam_re = args.in[9]; F.lam_im = args.in[10]; F.log_dt = args.in[11]; F.b_re = args.in[12]; F.b_im = args.in[13];
    F.c_re = args.in[14]; F.c_im = args.in[15]; F.s5_d = args.in[16]; F.w_glu = args.in[17]; F.b_glu = args.in[18]; F.hg_lb = args.in[19]; F.hg_ng = args.in[20];
    F.w_out = args.in[21]; F.g_ffn = args.in[22]; F.w_up = args.in[23]; F.conv_w = args.in[24]; F.conv_b = args.in[25]; F.w_down = args.in[26]; F.g_final = args.in[27];
    for (int u = F.tid; u < 64; u += NWAVES * 64) ((LAS unsigned*)(F.lds + MISC_OFF))[u] = 0u;
    __syncthreads();
    XcdBarrier bar; bar.bar = (unsigned*)(F.ctl + CW_BAR); bar.x = 0; bar.st = nullptr;
    if (N_LAUNCHES != PER_PHASE) bar = xcd_barrier_post((unsigned*)(F.ctl + CW_BAR), F.MISC + 8);
#define GRID_BAR() do { if (N_LAUNCHES != PER_PHASE) xcd_barrier(bar); } while (0)
    const int lo = args.ph_lo, hi = args.ph_hi;
#ifndef P2_MASK
#define P2_MASK 15
#endif
#ifndef PH_MASK
#define PH_MASK 0x1ff
#endif
#define IN(k) (((PH_MASK >> (k)) & 1) && lo <= (k) && (k) < hi)
#define BOTH(k) (IN(k) && IN((k) + 1))
    const int gw = F.vcu * NWAVES + F.wave, NGW = F.G * NWAVES;
    bf16* XN = (bf16*)(F.ws + WS_XN);

    if (IN(0)) { p0_prologue(F); if (BOTH(0)) GRID_BAR(); }
    if (IN(1)) {
        pg8::Gemm g{XN, (const bf16*)(F.ws + WS_WIN), RT, INC, D, D}; pg8::StaticOrder S; S.init(RT, INC, F.G, (int)blockIdx.x);
        EpiIn E{(bf16*)(F.ws + WS_U), (bf16*)(F.ws + WS_Q), (bf16*)(F.ws + WS_V), (bf16*)(F.ws + WS_G), (float*)(F.ws + WS_LF), (const float*)(F.ws + WS_S5F + S5F_LB)};
        pg8::gemm_phase<EpiIn, true>(F.lds + RING_OFF, g, S, E);
        if (BOTH(1)) GRID_BAR();
    }
    if (IN(2)) {
        if (P2_MASK & 1) for (int it = F.vcu; it < NB * 32; it += F.G) s5_prompt_item(F, it);
        if (P2_MASK & 2) for (int it = F.vcu; it < NB * 4 * 8; it += F.G) hgrn_prompt_item(F, it);
        if (P2_MASK & 4) for (int it = gw; it < NS * 32; it += NGW) s5_sample_item(F, it);
        if (P2_MASK & 8) for (int it = F.vcu; it < NS * 4; it += F.G) hgrn_sample_item(F, it);
        if (BOTH(2)) GRID_BAR();
    }
    if (IN(3)) {
        hgrn_finalize(F);
        pg8::Gemm g{(const bf16*)(F.ws + WS_Y5), (const bf16*)(F.ws + WS_WGLU), RT, HD, HD, HD}; pg8::StaticOrder S; S.init(RT, HD, F.G, (int)blockIdx.x);
        EpiGlu E{(const bf16*)(F.ws + WS_Y5), F.b_glu, (bf16*)(F.ws + WS_MIX)};
        pg8::gemm_phase<EpiGlu, true>(F.lds + RING_OFF, g, S, E);
        if (BOTH(3)) GRID_BAR();
    }
    if (IN(4)) {
        pg8::Gemm g{(const bf16*)(F.ws + WS_MIX), (const bf16*)(F.ws + WS_WOUT), RT, D, D, D}; pg8::StaticOrder S; S.init(RT, D, F.G, (int)blockIdx.x);
        EpiOut E{F.x_prompt, F.meta, F.x_sample, F.out, (float*)(F.ws + WS_H1META), XN, (float*)(F.ws + WS_CTL + CB_SS2)};
        pg8::gemm_phase<EpiOut, true>(F.lds + RING_OFF, g, S, E);
        if (BOTH(4)) GRID_BAR();
    }
    if (IN(5)) {
        pg8::Gemm g{XN, (const bf16*)(F.ws + WS_WUP), RT, UPC, D, D}; pg8::StaticOrder S; S.init(RT, UPC, F.G, (int)blockIdx.x);
        EpiUp E{(const float*)(F.ws + WS_CTL + CB_SS2), (bf16*)(F.ws + WS_HID), F.out};
        pg8::gemm_phase<EpiUp, true>(F.lds + RING_OFF, g, S, E);
        if (BOTH(5)) GRID_BAR();
    }
    if (IN(6)) { gate_pass(F); if (BOTH(6)) GRID_BAR(); }
    if (IN(7)) {
        pg8::Gemm g{(const bf16*)(F.ws + WS_HID) + DFF, (const bf16*)(F.ws + WS_WDN), RT, D, DFF, UPC}; pg8::StaticOrder S; S.init(RT, D, F.G, (int)blockIdx.x);
        EpiDown E{F.out, (float*)(F.ws + WS_H1META), (float*)(F.ws + WS_CTL + CB_SS3)};
        pg8::gemm_phase<EpiDown, true>(F.lds + RING_OFF, g, S, E);
        if (BOTH(7)) GRID_BAR();
    }
    if (IN(8)) final_norm(F);
#undef IN
#undef BOTH
#undef GRID_BAR
}

extern "C" void kernel_launch(void* const* d_in, const int* in_sizes, int n_in, void* d_out, int out_size, void* d_ws, size_t ws_size, hipStream_t stream) {
    static int grid = 0;
    if (grid == 0) {
        if (n_in != 28 || out_size != (int)OUT_TOTAL || ws_size < WS_END) { fprintf(stderr, "kernel_launch: unexpected problem (n_in %d, out %d, ws %zu); nothing launched\n", n_in, out_size, ws_size); grid = -1; return; }
        int dev = 0, cus = 0, per_cu = 0;
        if (hipGetDevice(&dev) != hipSuccess || hipDeviceGetAttribute(&cus, hipDeviceAttributeMultiprocessorCount, dev) != hipSuccess) { fprintf(stderr, "kernel_launch: device query failed\n"); grid = -1; return; }
        if (hipFuncSetAttribute((const void*)hymba_fwd, hipFuncAttributeMaxDynamicSharedMemorySize, LDS_BYTES) != hipSuccess) { fprintf(stderr, "kernel_launch: hipFuncSetAttribute failed\n"); grid = -1; return; }
        if (hipOccupancyMaxActiveBlocksPerMultiprocessor(&per_cu, (const void*)hymba_fwd, NWAVES * 64, LDS_BYTES) != hipSuccess || per_cu < 1)
            fprintf(stderr, "kernel_launch: note: occupancy query reports %d workgroups per CU\n", per_cu);
        (void)hipGetLastError();
        grid = cus;
    }
    if (grid < 0) return;
    if (hipMemsetAsync((char*)d_ws + WS_CTL, 0, CTL_ZERO_BYTES, stream) != hipSuccess) { fprintf(stderr, "kernel_launch: hipMemsetAsync failed\n"); return; }
    Args a{};
    for (int i = 0; i < 28; ++i) a.in[i] = (const float*)d_in[i];
    a.out = (float*)d_out; a.ws = (unsigned char*)d_ws;
    for (int li = 0; li < N_LAUNCHES; ++li) {
        a.ph_lo = (N_LAUNCHES == PER_PHASE) ? li : 0; a.ph_hi = (N_LAUNCHES == PER_PHASE) ? li + 1 : PER_PHASE; a.li = li;
        hipLaunchKernelGGL(hymba_fwd, dim3(grid), dim3(NWAVES * 64), LDS_BYTES, stream, a);
        const hipError_t le = hipPeekAtLastError();
        if (le != hipSuccess) { fprintf(stderr, "kernel_launch: launch %d failed: %s\n", li, hipGetErrorName(le)); break; }
    }
}
```

```cpp
#include <hip/hip_runtime.h>
#include <cstdio>
#include <cstdint>
#define MK_N_LAUNCHES 1
namespace pg8 {
#define PG8_LAS __attribute__((address_space(3)))
typedef unsigned short bf16_t;
typedef short bf16x8 __attribute__((ext_vector_type(8)));
typedef float f32x4 __attribute__((ext_vector_type(4)));
typedef unsigned u32x4 __attribute__((ext_vector_type(4)));
typedef unsigned u32x2 __attribute__((ext_vector_type(2)));
constexpr int BM = 256, BK = 64, HALF = 128, HTB = HALF * BK * 2  , STAGE_BYTES = 8 * HTB, NXCD = 8, WGM = 8;

__host__ __device__ __forceinline__ int lds_byte(int r, int c) { const int st = (r >> 4) * 2 + (c >> 5), rr = r & 15, cc = c & 31, ob = rr * 64 + cc * 2; return st * 1024 + (ob ^ (((ob >> 9) & 1) << 5)); }
__host__ __device__ __forceinline__ void stage_rc(int b, int& R, int& C) { const int st = b / 1024, sb = b % 1024, swz = sb ^ (((sb >> 9) & 1) << 5); R = (st >> 1) * 16 + swz / 64; C = (st & 1) * 32 + (swz % 64) / 2; }
__host__ __device__ __forceinline__ int perm32(int rho) { const int n = rho >> 4, i = rho & 15; return 8 * (i >> 2) + 4 * n + (i & 3); }

struct Unit { int pm, pn; };
struct Gemm { const bf16_t* A; const bf16_t* Bt; int M, N, K, lda; };

struct StaticOrder {
    int nM, nN, nwg, G, c;
    __host__ __device__ void init(int M, int N, int G_, int c_) { nM = M / BM; nN = N / BM; nwg = nM * nN; G = G_; c = c_; }
    __host__ __device__ bool next(int i, Unit& u) const {
        const long L = (long)i * G + c; if (L >= nwg) return false;
        int wgid = (int)L; { const int q = nwg / NXCD, r = nwg % NXCD, xcd = wgid % NXCD, off = wgid / NXCD; wgid = (xcd < r ? xcd * (q + 1) : r * (q + 1) + (xcd - r) * q) + off; }
        const int nig = WGM * nN, gid = wgid / nig, fm = gid * WGM, gsz = (nM - fm) < WGM ? (nM - fm) : WGM;
        u.pm = fm + ((wgid % nig) % gsz); u.pn = (wgid % nig) / gsz; return true;
    }
};

__device__ __forceinline__ unsigned cvt_pk_bf16(float lo, float hi) { unsigned r; asm volatile("v_cvt_pk_bf16_f32 %0, %1, %2" : "=v"(r) : "v"(lo), "v"(hi)); return r; }

template <class Epi, bool ALIGN_EPI>
__device__ __forceinline__ void gemm_phase(PG8_LAS unsigned char* lds, const Gemm g, const StaticOrder& S, const Epi& E) {
    const int tid = threadIdx.x, wid = __builtin_amdgcn_readfirstlane(tid >> 6), lane = tid & 63, wr = wid >> 2, wc = wid & 3, fr = lane & 15, fq = lane >> 4;
    const int K = g.K, nt = K / BK, lda = g.lda;
    unsigned voffA[2], voffB[2];
#pragma unroll
    for (int i = 0; i < 2; ++i) { int R, C; stage_rc(tid * 16 + i * 8192, R, C); const int Rb = (R & ~31) + perm32(R & 31);
        voffA[i] = (unsigned)(R * lda + C) * 2u; voffB[i] = (unsigned)(Rb * K + C) * 2u; }
    const size_t kstep = (size_t)(BK * 2);
    const size_t hstepA = (size_t)HALF * lda * 2, hstepB = (size_t)HALF * K * 2;
    const size_t tstepA = 2 * hstepA, tstepB = 2 * hstepB;
    const unsigned ldsw = (unsigned)wid * 1024u;
    const int aoff = lds_byte(wr * 64 + fr, fq * 8), boff = lds_byte(wc * 32 + fr, fq * 8);
#define PG8_SA(b, h) (((b) * 2 + (h)) * HTB)
#define PG8_SB(b, h) ((4 + (b) * 2 + (h)) * HTB)
#define PG8_STAGE(bufoff, gbase, voff) do { _Pragma("unroll") for (int _i = 0; _i < 2; ++_i) \
        __builtin_amdgcn_global_load_lds((const unsigned*)((const char*)(gbase) + (voff)[_i]), (PG8_LAS unsigned*)(lds + (bufoff) + ldsw + _i * 8192), 16, 0, 0); } while (0)
#define PG8_LDA(dst, b, h) do { _Pragma("unroll") for (int m = 0; m < 4; ++m) _Pragma("unroll") for (int k = 0; k < 2; ++k) dst[m][k] = *(const PG8_LAS bf16x8*)(lds + PG8_SA(b, h) + aoff + m * 2048 + k * 1024); } while (0)
#define PG8_LDB(dst, b, h) do { _Pragma("unroll") for (int n = 0; n < 2; ++n) _Pragma("unroll") for (int k = 0; k < 2; ++k) dst[n][k] = *(const PG8_LAS bf16x8*)(lds + PG8_SB(b, h) + boff + n * 2048 + k * 1024); } while (0)
#define PG8_MMA(ai, bj, At, Bt) do { __builtin_amdgcn_s_setprio(1); _Pragma("unroll") for (int m = 0; m < 4; ++m) _Pragma("unroll") for (int n = 0; n < 2; ++n) _Pragma("unroll") for (int k = 0; k < 2; ++k) \
        acc[ai][bj][m][n] = __builtin_amdgcn_mfma_f32_16x16x32_bf16(Bt[n][k], At[m][k], acc[ai][bj][m][n], 0, 0, 0); __builtin_amdgcn_s_setprio(0); } while (0)
#define PG8_WAIT_V(n) asm volatile("s_waitcnt vmcnt(" #n ")" ::: "memory")
#define PG8_WAIT_L(n) asm volatile("s_waitcnt lgkmcnt(" #n ")" ::: "memory")
#define PG8_BAR __builtin_amdgcn_s_barrier()
#define PG8_SCHED __builtin_amdgcn_sched_barrier(0)
    Unit cur, nxt; int ui = 0;
    if (!S.next(0, cur)) return;
    f32x4 acc[2][2][4][2];
#pragma unroll
    for (int a = 0; a < 2; ++a)
#pragma unroll
        for (int b = 0; b < 2; ++b)
#pragma unroll
            for (int m = 0; m < 4; ++m)
#pragma unroll
                for (int n = 0; n < 2; ++n) acc[a][b][m][n] = (f32x4){0.f, 0.f, 0.f, 0.f};
    bf16x8 At[4][2], B0[2][2], B1[2][2];
    const char* cA = (const char*)g.A + (size_t)cur.pm * tstepA; const char* cB = (const char*)g.Bt + (size_t)cur.pn * tstepB;
    PG8_STAGE(PG8_SB(0, 0), cB, voffB); PG8_STAGE(PG8_SB(0, 1), cB + hstepB, voffB); PG8_STAGE(PG8_SA(0, 0), cA, voffA); PG8_STAGE(PG8_SA(0, 1), cA + hstepA, voffA);
    if (wr == 1) PG8_BAR;
    PG8_WAIT_V(2); PG8_BAR;
    PG8_STAGE(PG8_SB(1, 0), cB + kstep, voffB); PG8_STAGE(PG8_SA(1, 0), cA + kstep, voffA); PG8_STAGE(PG8_SB(1, 1), cB + hstepB + kstep, voffB);
    PG8_WAIT_V(6); PG8_BAR;
    for (;;) {
        const bool has_next = S.next(ui + 1, nxt);
        const char* nA = has_next ? (const char*)g.A + (size_t)nxt.pm * tstepA : cA; const char* nB = has_next ? (const char*)g.Bt + (size_t)nxt.pn * tstepB : cB;
        for (int t = 0; t < nt; t += 2) {
            const bool last = (t == nt - 2);
            const char* a1 = cA + (size_t)(t + 1) * kstep;
            const char* a2 = last ? nA : cA + (size_t)(t + 2) * kstep; const char* b2 = last ? nB : cB + (size_t)(t + 2) * kstep;
            const char* a3 = a2 + kstep; const char* b3 = b2 + kstep;
            PG8_LDB(B0, 0, 0); PG8_LDB(B1, 0, 1); PG8_SCHED; PG8_LDA(At, 0, 0); PG8_STAGE(PG8_SA(1, 1), a1 + hstepA, voffA);
            PG8_WAIT_V(8); PG8_WAIT_L(0); PG8_BAR; PG8_MMA(0, 0, At, B0); PG8_MMA(0, 1, At, B1); PG8_BAR; PG8_SCHED;
            PG8_LDA(At, 0, 1); PG8_STAGE(PG8_SB(0, 0), b2, voffB); PG8_STAGE(PG8_SB(0, 1), b2 + hstepB, voffB); PG8_STAGE(PG8_SA(0, 0), a2, voffA);
            PG8_WAIT_V(8); PG8_WAIT_L(0); PG8_BAR; PG8_MMA(1, 0, At, B0); PG8_MMA(1, 1, At, B1); PG8_BAR; PG8_SCHED;
            PG8_LDB(B0, 1, 0); PG8_LDB(B1, 1, 1); PG8_SCHED; PG8_LDA(At, 1, 0); PG8_STAGE(PG8_SA(0, 1), a2 + hstepA, voffA);
            PG8_WAIT_V(8); PG8_WAIT_L(0); PG8_BAR; PG8_MMA(0, 0, At, B0); PG8_MMA(0, 1, At, B1); PG8_BAR; PG8_SCHED;
            PG8_LDA(At, 1, 1); PG8_STAGE(PG8_SB(1, 0), b3, voffB); PG8_STAGE(PG8_SB(1, 1), b3 + hstepB, voffB); PG8_STAGE(PG8_SA(1, 0), a3, voffA);
            PG8_WAIT_V(8); PG8_WAIT_L(0); PG8_BAR; PG8_MMA(1, 0, At, B0); PG8_MMA(1, 1, At, B1); PG8_BAR; PG8_SCHED;
        }
        if constexpr (ALIGN_EPI) { if (wr == 0) PG8_BAR; }
        E(acc, cur, wr, wc, fr, fq);
        if (!has_next) break;
#pragma unroll
        for (int a = 0; a < 2; ++a)
#pragma unroll
            for (int b = 0; b < 2; ++b)
#pragma unroll
                for (int m = 0; m < 4; ++m)
#pragma unroll
                    for (int n = 0; n < 2; ++n) acc[a][b][m][n] = (f32x4){0.f, 0.f, 0.f, 0.f};
        cur = nxt; cA = nA; cB = nB; ++ui;
        if constexpr (ALIGN_EPI) { if (wr == 1) PG8_BAR; }
    }
    PG8_WAIT_V(0);
    if constexpr (!ALIGN_EPI) { if (wr == 0) PG8_BAR; }
    PG8_BAR;
#undef PG8_SA
#undef PG8_SB
#undef PG8_STAGE
#undef PG8_LDA
#undef PG8_LDB
#undef PG8_MMA
#undef PG8_WAIT_V
#undef PG8_WAIT_L
#undef PG8_BAR
#undef PG8_SCHED
}
}
using pg8::bf16x8;
constexpr int NWAVES = 8;
constexpr int D = 1024, NB = 8, SEQ = 2048, NMETA = 16, NS = 128;
constexpr int RT = 16640;
constexpr int R_META = 16384, R_SAMP = 16512;
constexpr int HD = 512;
constexpr int INC = 2560, DFF = 2816, UPC = 5632;
constexpr float EPS = 1e-6f;
constexpr size_t OFF_YP = 0, OFF_YS = 16777216, OFF_S5RP = 16908288, OFF_S5IP = 16924672, OFF_HGP = 16941056, OFF_CVP = 17465344,
                 OFF_S5RS = 17510400, OFF_S5IS = 17772544, OFF_HGS = 18034688, OFF_CVS = 26423296, OUT_TOTAL = 27144192;
constexpr size_t KiB = 1024, MiB = 1u << 20;
constexpr size_t WS_CTL = 0, CTL_ZERO_BYTES = 1 * MiB;
constexpr int CW_BAR = 4096;
constexpr size_t CB_SS2 = 64 * KiB, CB_SS3 = 192 * KiB, CB_HSS = 512 * KiB;
constexpr size_t WS_WIN = 2 * MiB, WS_WGLU = 7 * MiB, WS_WOUT = 7 * MiB + 512 * KiB, WS_WUP = 9 * MiB + 512 * KiB, WS_WDN = 20 * MiB + 512 * KiB;
constexpr size_t WS_S5W1 = 26 * MiB, WS_S5W2 = 32 * MiB, WS_S5F = 34 * MiB;
constexpr size_t S5F_A1 = 0, S5F_A16 = 16 * KiB, S5F_BB = 64 * KiB, S5F_LB = 384 * KiB;
constexpr size_t WS_H1META = 35 * MiB;
constexpr size_t WS_XN = 36 * MiB;
constexpr size_t ROWS512_BF16 = (size_t)RT * 512 * 2;
constexpr size_t WS_U = 68 * MiB + 512 * KiB, WS_Q = WS_U + ROWS512_BF16, WS_V = WS_Q + ROWS512_BF16, WS_G = WS_V + ROWS512_BF16, WS_LF = WS_G + ROWS512_BF16,
                 WS_Y5 = WS_LF + 2 * ROWS512_BF16, WS_OH = WS_Y5 + ROWS512_BF16, WS_MIX = WS_OH + ROWS512_BF16, WS_ZEND = WS_MIX + 2 * ROWS512_BF16;
constexpr size_t WS_HID = WS_U;
constexpr size_t WS_END = 256 * MiB;
static_assert(WS_ZEND <= WS_END && WS_HID + (size_t)RT * UPC * 2 <= WS_END && WS_XN + (size_t)RT * D * 2 <= WS_U, "d_ws map");
static_assert(CB_HSS + (size_t)RT * 4 * 4 <= CTL_ZERO_BYTES && CB_SS3 + RT * 4 <= CB_HSS && CB_SS2 + RT * 4 <= CB_SS3 && (CW_BAR + 3456) * 4 <= (int)CB_SS2, "ctl map");

constexpr int LDS_BYTES = 163840;
constexpr int RING_OFF = 0, MISC_OFF = 163840 - 256;

#define GAS __attribute__((address_space(1)))
#define LAS __attribute__((address_space(3)))
typedef unsigned short bf16;
typedef unsigned v4u __attribute__((ext_vector_type(4)));
typedef unsigned v2u __attribute__((ext_vector_type(2)));
typedef float f32x4 __attribute__((ext_vector_type(4)));
typedef short bf16x8 __attribute__((ext_vector_type(8)));
typedef GAS unsigned gu32;
#define RLX_AGENT __ATOMIC_RELAXED, __HIP_MEMORY_SCOPE_AGENT
#define LDS_WAIT() asm volatile("s_waitcnt lgkmcnt(0)" ::: "memory")
#define VM_WAIT() asm volatile("s_waitcnt vmcnt(0)" ::: "memory")
__device__ __forceinline__ unsigned f2bf(float f) { unsigned u = __builtin_bit_cast(unsigned, f); return (u + 0x7fffu + ((u >> 16) & 1u)) >> 16; }
__device__ __forceinline__ unsigned pk2(float lo, float hi) { return f2bf(lo) | (f2bf(hi) << 16); }
__device__ __forceinline__ float bf2f(unsigned short b) { return __builtin_bit_cast(float, (unsigned)b << 16); }
__device__ __forceinline__ float bflo(unsigned w) { return __builtin_bit_cast(float, w << 16); }
__device__ __forceinline__ float bfhi(unsigned w) { return __builtin_bit_cast(float, w & 0xffff0000u); }
__device__ __forceinline__ float sigmoidf_(float x) { return __builtin_amdgcn_rcpf(1.0f + __expf(-x)); }
__device__ __forceinline__ float siluf_(float x) { return x * sigmoidf_(x); }
__device__ __forceinline__ float gelu_tanh(float y) { const float uu = 1.5957691216057308f * (y + 0.044715f * y * y * y); return y * sigmoidf_(uu); }
__device__ __forceinline__ float ld_agent(const float* p) { return __builtin_bit_cast(float, __hip_atomic_load((const unsigned*)p, RLX_AGENT)); }
__device__ __forceinline__ void atomic_addf(float* p, float v) { (void)__hip_atomic_fetch_add(p, v, RLX_AGENT); }
__device__ __forceinline__ f32x4 mfma16(bf16x8 a, bf16x8 b, f32x4 c) { return __builtin_amdgcn_mfma_f32_16x16x32_bf16(a, b, c, 0, 0, 0); }
__device__ __forceinline__ float wave_sum(float v) {
#pragma unroll
    for (int o = 1; o < 64; o <<= 1) v += __shfl_xor(v, o);
    return v;
}

#define XB_TMO      128
#define XB_XCNT(j)  (256  + 64 * (j))
#define XB_XSUB(j)  (1280 + 64 * (j))
#define XB_XGEN(j)  (2304 + 64 * (j))
#define XB_TOP      3328
#define XB_TOPGEN   3392
#define XCD_BAR_WORDS 3456
#define XB_SPIN_CAP (1u << 18)
__device__ __forceinline__ unsigned xb_ld(unsigned* p)              { return __hip_atomic_load(p, __ATOMIC_RELAXED, __HIP_MEMORY_SCOPE_AGENT); }
__device__ __forceinline__ unsigned xb_add(unsigned* p, unsigned v) { return __hip_atomic_fetch_add(p, v, __ATOMIC_RELAXED, __HIP_MEMORY_SCOPE_AGENT); }
__device__ __forceinline__ unsigned xb_xcc_id() { return (unsigned)__builtin_amdgcn_s_getreg((3 << 11) | 20) & 0xFu; }
#define XB_SPIN(cond, bar) do { unsigned _sp = 0; while (cond) { __builtin_amdgcn_s_sleep(1); \
    if ((++_sp & 255u) == 0u) { if (xb_ld(&(bar)[XB_TMO])) break; if (_sp > XB_SPIN_CAP) { atomicAdd(&(bar)[XB_TMO], 1u); break; } } } } while (0)
struct XcdBarrier { unsigned* bar; unsigned x; volatile LAS unsigned* st; };
__device__ __forceinline__ XcdBarrier xcd_barrier_post(unsigned* bar, volatile LAS unsigned* st) {
    XcdBarrier b; b.bar = bar; b.x = xb_xcc_id(); b.st = st;
    if (threadIdx.x == 0) (void)xb_add(&bar[XB_XCNT(b.x)], 1u);
    return b;
}
__device__ __forceinline__ void xcd_barrier_complete(unsigned* bar, unsigned x, unsigned& nloc, unsigned& nx) {
    const unsigned G = gridDim.x * gridDim.y * gridDim.z;
    unsigned sum, cnt, mine, sp = 0u;
    for (;;) {
        sum = 0u; cnt = 0u; mine = 0u;
#pragma unroll
        for (unsigned j = 0; j < 16; ++j) { const unsigned c = xb_ld(&bar[XB_XCNT(j)]); sum += c; cnt += (c > 0u) ? 1u : 0u; mine = (j == x) ? c : mine; }
        if (sum == G) break;
        __builtin_amdgcn_s_sleep(1);
        if ((++sp & 255u) == 0u) { if (xb_ld(&bar[XB_TMO])) break; if (sp > XB_SPIN_CAP) { atomicAdd(&bar[XB_TMO], 1u); break; } }
    }
    nloc = mine > 0u ? mine : 1u; nx = cnt > 0u ? cnt : 1u;
}
__device__ __forceinline__ void xcd_barrier(const XcdBarrier& b) {
    asm volatile("s_waitcnt vmcnt(0)" ::: "memory");
    __syncthreads();
    if (threadIdx.x == 0) {
        unsigned* bar = b.bar;
        __builtin_amdgcn_s_waitcnt(0);
        unsigned nloc = b.st[0], nx = b.st[1];
        if (nloc == 0u) { xcd_barrier_complete(bar, b.x, nloc, nx); b.st[0] = nloc; b.st[1] = nx; }
        const unsigned old = xb_add(&bar[XB_XSUB(b.x)], 1u);
        const unsigned gen = old / nloc;
        if (old + 1u == (gen + 1u) * nloc) {
            __builtin_amdgcn_fence(__ATOMIC_RELEASE, "agent");
            asm volatile("s_waitcnt vmcnt(0)" ::: "memory");
            const unsigned og = xb_add(&bar[XB_TOP], 1u);
            const unsigned tg = og / nx;
            if (og + 1u == (tg + 1u) * nx) xb_add(&bar[XB_TOPGEN], 1u);
            else XB_SPIN(xb_ld(&bar[XB_TOPGEN]) == tg, bar);
            __builtin_amdgcn_fence(__ATOMIC_ACQUIRE, "agent");
            xb_add(&bar[XB_XGEN(b.x)], 1u);
            asm volatile("s_waitcnt vmcnt(0)" ::: "memory");
        } else {
            XB_SPIN(xb_ld(&bar[XB_XGEN(b.x)]) == gen, bar);
            __builtin_amdgcn_fence(__ATOMIC_ACQUIRE, "agent");
            asm volatile("s_waitcnt vmcnt(0)" ::: "memory");
        }
    }
    __syncthreads();
}

struct Frame {
    LAS unsigned char* lds;
    volatile LAS unsigned* MISC;
    gu32* ctl;
    int tid, lane, wave;
    int vcu, G;
    unsigned char* ws; float* out;
    const float *x_prompt, *x_sample, *st_s5r, *st_s5i, *st_hg, *st_cv, *meta, *g_mix, *w_in, *lam_re, *lam_im, *log_dt, *b_re, *b_im, *c_re, *c_im, *s5_d,
                *w_glu, *b_glu, *hg_lb, *hg_ng, *w_out, *g_ffn, *w_up, *conv_w, *conv_b, *w_down, *g_final;
};
#define EPI_ARGS const f32x4 (&acc)[2][2][4][2], const pg8::Unit& u, int wr, int wc, int fr, int fq

struct EpiIn {
    bf16 *U, *Q, *V, *G; float* LF; const float* lb;
    __device__ __forceinline__ void operator()(EPI_ARGS) const {
        const int seg = u.pn >> 1, cb = (u.pn & 1) * 256 + wc * 32 + 8 * fq, row0 = u.pm * 256 + wr * 64 + fr;
        bf16* dstb = seg == 0 ? U : (seg == 1 ? Q : (seg == 3 ? V : G));
#pragma unroll
        for (int ai = 0; ai < 2; ++ai)
#pragma unroll
            for (int m = 0; m < 4; ++m) { const size_t row = (size_t)(row0 + ai * 128 + m * 16);
#pragma unroll
                for (int bj = 0; bj < 2; ++bj) { const int col = cb + bj * 128; f32x4 v0 = acc[ai][bj][m][0], v1 = acc[ai][bj][m][1];
                    if (seg == 2) {
                        const f32x4 l0 = *(const f32x4*)(lb + col), l1 = *(const f32x4*)(lb + col + 4); f32x4 o0, o1;
#pragma unroll
                        for (int j = 0; j < 4; ++j) { o0[j] = __logf(l0[j] + (1.f - l0[j]) * sigmoidf_(v0[j])); o1[j] = __logf(l1[j] + (1.f - l1[j]) * sigmoidf_(v1[j])); }
                        *(f32x4*)(LF + row * HD + col) = o0; *(f32x4*)(LF + row * HD + col + 4) = o1;
                    } else {
                        if (seg == 4) {
#pragma unroll
                            for (int j = 0; j < 4; ++j) { v0[j] = siluf_(v0[j]); v1[j] = siluf_(v1[j]); } }
                        v4u w; w.x = pk2(v0[0], v0[1]); w.y = pk2(v0[2], v0[3]); w.z = pk2(v1[0], v1[1]); w.w = pk2(v1[2], v1[3]);
                        *(v4u*)(dstb + row * HD + col) = w;
                    } } }
    }
};
struct EpiGlu {
    const bf16* Y5; const float* bias; bf16* MIX;
    __device__ __forceinline__ void operator()(EPI_ARGS) const {
        const int col0 = u.pn * 256 + wc * 32 + 8 * fq, row0 = u.pm * 256 + wr * 64 + fr;
#pragma unroll
        for (int ai = 0; ai < 2; ++ai)
#pragma unroll
            for (int m = 0; m < 4; ++m) { const size_t row = (size_t)(row0 + ai * 128 + m * 16);
#pragma unroll
                for (int bj = 0; bj < 2; ++bj) { const int col = col0 + bj * 128; const f32x4 v0 = acc[ai][bj][m][0], v1 = acc[ai][bj][m][1];
                    const f32x4 b0 = *(const f32x4*)(bias + col), b1 = *(const f32x4*)(bias + col + 4);
                    const v4u y = *(const v4u*)(Y5 + row * HD + col);
                    v4u w;
                    w.x = pk2(bflo(y.x) * sigmoidf_(v0[0] + b0[0]), bfhi(y.x) * sigmoidf_(v0[1] + b0[1]));
                    w.y = pk2(bflo(y.y) * sigmoidf_(v0[2] + b0[2]), bfhi(y.y) * sigmoidf_(v0[3] + b0[3]));
                    w.z = pk2(bflo(y.z) * sigmoidf_(v1[0] + b1[0]), bfhi(y.z) * sigmoidf_(v1[1] + b1[1]));
                    w.w = pk2(bflo(y.w) * sigmoidf_(v1[2] + b1[2]), bfhi(y.w) * sigmoidf_(v1[3] + b1[3]));
                    *(v4u*)(MIX + row * D + col) = w; } }
    }
};
struct EpiOut {
    const float *xp, *meta, *xs; float *out, *h1meta; bf16* H1B; float* ss;
    __device__ __forceinline__ void operator()(EPI_ARGS) const {
        const int col0 = u.pn * 256 + wc * 32 + 8 * fq, row0 = u.pm * 256 + wr * 64 + fr;
#pragma unroll
        for (int ai = 0; ai < 2; ++ai)
#pragma unroll
            for (int m = 0; m < 4; ++m) { const int row = row0 + ai * 128 + m * 16;
                const float* src = row < R_META ? xp + (size_t)row * D : (row < R_SAMP ? meta + (size_t)((row - R_META) & 15) * D : xs + (size_t)(row - R_SAMP) * D);
                float* dst = row < R_META ? out + (size_t)row * D : (row < R_SAMP ? h1meta + (size_t)(row - R_META) * D : out + OFF_YS + (size_t)(row - R_SAMP) * D);
                float s = 0.f;
#pragma unroll
                for (int bj = 0; bj < 2; ++bj) { const int col = col0 + bj * 128;
                    const f32x4 h0 = *(const f32x4*)(src + col) + acc[ai][bj][m][0], h1 = *(const f32x4*)(src + col + 4) + acc[ai][bj][m][1];
                    *(f32x4*)(dst + col) = h0; *(f32x4*)(dst + col + 4) = h1;
                    v4u w; w.x = pk2(h0[0], h0[1]); w.y = pk2(h0[2], h0[3]); w.z = pk2(h1[0], h1[1]); w.w = pk2(h1[2], h1[3]);
                    *(v4u*)(H1B + (size_t)row * D + col) = w;
                    s += (h0[0] * h0[0] + h0[1] * h0[1]) + (h0[2] * h0[2] + h0[3] * h0[3]) + (h1[0] * h1[0] + h1[1] * h1[1]) + (h1[2] * h1[2] + h1[3] * h1[3]); }
                s += __shfl_xor(s, 16); s += __shfl_xor(s, 32);
                if (fq == 0 && ss) atomic_addf(ss + row, s); }
    }
};
struct EpiUp {
    const float* ss; bf16* HID; float* out;
    __device__ __forceinline__ void operator()(EPI_ARGS) const {
        const int col0 = u.pn * 256 + wc * 32 + 8 * fq, row0 = u.pm * 256 + wr * 64 + fr;
#pragma unroll
        for (int ai = 0; ai < 2; ++ai)
#pragma unroll
            for (int m = 0; m < 4; ++m) { const int row = row0 + ai * 128 + m * 16;
                const float rstd = __builtin_amdgcn_rsqf(ld_agent(ss + row) * (1.0f / D) + EPS);
                float* cv = nullptr;
                if (u.pn < 11) {
                    if (row < R_META) { const int t = row & 2047; if (t >= 2046) cv = out + OFF_CVP + (size_t)((row >> 11) * 2 + (t - 2046)) * DFF; }
                    else if (row >= R_SAMP) cv = out + OFF_CVS + (size_t)((row - R_SAMP) * 2 + 1) * DFF;
                }
#pragma unroll
                for (int bj = 0; bj < 2; ++bj) { const int col = col0 + bj * 128; const f32x4 v0 = acc[ai][bj][m][0] * rstd, v1 = acc[ai][bj][m][1] * rstd;
                    v4u w; w.x = pk2(v0[0], v0[1]); w.y = pk2(v0[2], v0[3]); w.z = pk2(v1[0], v1[1]); w.w = pk2(v1[2], v1[3]);
                    *(v4u*)(HID + (size_t)row * UPC + col) = w;
                    if (cv) { *(f32x4*)(cv + col) = v0; *(f32x4*)(cv + col + 4) = v1; } } }
    }
};
struct EpiDown {
    float *out, *h1meta; float* ss;
    __device__ __forceinline__ void operator()(EPI_ARGS) const {
        const int col0 = u.pn * 256 + wc * 32 + 8 * fq, row0 = u.pm * 256 + wr * 64 + fr;
#pragma unroll
        for (int ai = 0; ai < 2; ++ai)
#pragma unroll
            for (int m = 0; m < 4; ++m) { const int row = row0 + ai * 128 + m * 16;
                float* dst = row < R_META ? out + (size_t)row * D : (row < R_SAMP ? h1meta + (size_t)(row - R_META) * D : out + OFF_YS + (size_t)(row - R_SAMP) * D);
                float s = 0.f;
#pragma unroll
                for (int bj = 0; bj < 2; ++bj) { const int col = col0 + bj * 128;
                    const f32x4 h0 = *(const f32x4*)(dst + col) + acc[ai][bj][m][0], h1 = *(const f32x4*)(dst + col + 4) + acc[ai][bj][m][1];
                    *(f32x4*)(dst + col) = h0; *(f32x4*)(dst + col + 4) = h1;
                    s += (h0[0] * h0[0] + h0[1] * h0[1]) + (h0[2] * h0[2] + h0[3] * h0[3]) + (h1[0] * h1[0] + h1[1] * h1[1]) + (h1[2] * h1[2] + h1[3] * h1[3]); }
                s += __shfl_xor(s, 16); s += __shfl_xor(s, 32);
                if (fq == 0) atomic_addf(ss + row, s); }
    }
};
__device__ __forceinline__ void p0_transpose_item(const float* W, int K, int N, bf16* WT, const float* ksc, LAS float* scr, int item, int lane) {
    const int nblk = N / 64, kb = item / nblk, nb = item % nblk, k0 = 64 * kb, n0 = 64 * nb;
    const int ks = lane >> 4, n4 = (lane & 15) * 4;
    f32x4 v[16]; float sc[16];
#pragma unroll
    for (int i = 0; i < 16; ++i) { const int kk = 4 * i + ks; v[i] = *(const GAS f32x4*)(W + (size_t)(k0 + kk) * N + n0 + n4); sc[i] = ksc ? ksc[k0 + kk] : 1.0f; }
#pragma unroll
    for (int i = 0; i < 16; ++i) { const int kk = 4 * i + ks; LAS float* d = scr + kk * 65 + n4; d[0] = v[i].x * sc[i]; d[1] = v[i].y * sc[i]; d[2] = v[i].z * sc[i]; d[3] = v[i].w * sc[i]; }
    LDS_WAIT(); asm volatile("" ::: "memory");
    const int c = lane & 7;
#pragma unroll
    for (int j = 0; j < 8; ++j) { const int n = (lane >> 3) + 8 * j; const LAS float* q = scr + (8 * c) * 65 + n;
        v4u o; o.x = pk2(q[0 * 65], q[1 * 65]); o.y = pk2(q[2 * 65], q[3 * 65]); o.z = pk2(q[4 * 65], q[5 * 65]); o.w = pk2(q[6 * 65], q[7 * 65]);
        *(GAS v4u*)(WT + (size_t)(n0 + n) * K + k0 + 8 * c) = o; }
    LDS_WAIT(); asm volatile("" ::: "memory");
}
template <int NR>
__device__ __forceinline__ void rms_rows_to_bf16(int lane, const float* const (&xrow)[NR], bf16* const (&orow)[NR]) {
    f32x4 v[NR][4]; float s[NR];
#pragma unroll
    for (int r = 0; r < NR; ++r) { const GAS f32x4* xr = (const GAS f32x4*)xrow[r] + lane;
#pragma unroll
        for (int j = 0; j < 4; ++j) v[r][j] = xr[64 * j]; }
#pragma unroll
    for (int r = 0; r < NR; ++r) { s[r] = 0.f;
#pragma unroll
        for (int j = 0; j < 4; ++j) s[r] += (v[r][j].x * v[r][j].x + v[r][j].y * v[r][j].y) + (v[r][j].z * v[r][j].z + v[r][j].w * v[r][j].w); }
#pragma unroll
    for (int o = 1; o < 64; o <<= 1) {
#pragma unroll
        for (int r = 0; r < NR; ++r) s[r] += __shfl_xor(s[r], o); }
#pragma unroll
    for (int r = 0; r < NR; ++r) { const float rstd = 1.0f / sqrtf(s[r] * (1.f / D) + EPS);
        GAS unsigned long long* o8 = (GAS unsigned long long*)orow[r] + lane;
#pragma unroll
        for (int j = 0; j < 4; ++j) o8[64 * j] = (unsigned long long)pk2(v[r][j].x * rstd, v[r][j].y * rstd) | ((unsigned long long)pk2(v[r][j].z * rstd, v[r][j].w * rstd) << 32); }
}
__device__ __forceinline__ void s5_precompute_item(Frame& F, int item) {
    const int g = item >> 3, b = item & 7;
    LAS float* Ap = (LAS float*)F.lds;
    LAS float* Bb = Ap + 2176;
    LAS float* Cc = Bb + 2048;
    LAS float* Kt = Cc + 2048;
    const int tid = F.tid;
    float* A1 = (float*)(F.ws + WS_S5F + S5F_A1); float* A16 = (float*)(F.ws + WS_S5F + S5F_A16); float* BBf = (float*)(F.ws + WS_S5F + S5F_BB);
    const float dt = expf(F.log_dt[g]);
    for (int idx = tid; idx < 17 * 64; idx += 512) { const int j = idx >> 6, p = idx & 63; const float lr = F.lam_re[g * 64 + p], li = F.lam_im[g * 64 + p];
        const double TWO_PI = 6.283185307179586476925286766559;
        const float mag = expf(lr * dt * (float)j);
        double rev = ((double)li * (double)dt * (double)j) / TWO_PI; rev -= rint(rev);
        const float ang = (float)(rev * TWO_PI);
        Ap[idx * 2] = mag * cosf(ang); Ap[idx * 2 + 1] = mag * sinf(ang); }
    for (int idx = tid; idx < 1024; idx += 512) { const int co = idx >> 6, p = idx & 63; Cc[idx * 2] = F.c_re[(g * 16 + co) * 64 + p]; Cc[idx * 2 + 1] = F.c_im[(g * 16 + co) * 64 + p]; }
    __syncthreads();
    for (int idx = tid; idx < 1024; idx += 512) { const int p = idx >> 4, c = idx & 15; const float lr = F.lam_re[g * 64 + p], li = F.lam_im[g * 64 + p];
        const float ar = Ap[(64 + p) * 2], ai = Ap[(64 + p) * 2 + 1];
        const float nr = ar - 1.0f, den = lr * lr + li * li, cr = (nr * lr + ai * li) / den, ci = (ai * lr - nr * li) / den;
        const float bre = F.b_re[(g * 64 + p) * 16 + c], bim = F.b_im[(g * 64 + p) * 16 + c];
        const float xr = cr * bre - ci * bim, xi = cr * bim + ci * bre;
        Bb[idx * 2] = xr; Bb[idx * 2 + 1] = xi;
        if (b == 0) { BBf[((g * 64 + p) * 16 + c) * 2] = xr; BBf[((g * 64 + p) * 16 + c) * 2 + 1] = xi;
            if (c == 0) { A1[(g * 64 + p) * 2] = ar; A1[(g * 64 + p) * 2 + 1] = ai; A16[(g * 64 + p) * 2] = Ap[(16 * 64 + p) * 2]; A16[(g * 64 + p) * 2 + 1] = Ap[(16 * 64 + p) * 2 + 1]; } } }
    __syncthreads();
    { const int jl = tid >> 8, co = (tid >> 4) & 15, ci = tid & 15, j = 2 * b + jl; float kv = 0.f;
        for (int p = 0; p < 64; ++p) { const float cr = Cc[(co * 64 + p) * 2], cim = Cc[(co * 64 + p) * 2 + 1], ar = Ap[(j * 64 + p) * 2], ai = Ap[(j * 64 + p) * 2 + 1];
            const float car = cr * ar - cim * ai, cai = cr * ai + cim * ar; kv += car * Bb[(p * 16 + ci) * 2] - cai * Bb[(p * 16 + ci) * 2 + 1]; }
        if (j == 0 && co == ci) kv += F.s5_d[g * 16 + co];
        Kt[tid] = kv; }
    __syncthreads();
    bf16* W1 = (bf16*)(F.ws + WS_S5W1) + (size_t)g * 384 * 256; bf16* W2 = (bf16*)(F.ws + WS_S5W2) + (size_t)g * 256 * 128;
    for (int idx = tid; idx < 2 * 16 * 128; idx += 512) { const int jl = idx >> 11, d = (idx >> 7) & 15, co = (idx >> 3) & 15, cp = idx & 7, j = 2 * b + jl;
        if (d + j < 16) { const int s = d, t = d + j;
            *(unsigned*)(W1 + (size_t)(t * 16 + co) * 256 + s * 16 + 2 * cp) = pk2(Kt[jl * 256 + co * 16 + 2 * cp], Kt[jl * 256 + co * 16 + 2 * cp + 1]);
            if (j >= 1) *(unsigned*)(W1 + (size_t)(s * 16 + co) * 256 + t * 16 + 2 * cp) = 0u; } }
    for (int idx = tid; idx < 16 * 128; idx += 512) { const int pp = 16 * b + (idx >> 7), k = (idx & 127) * 2, s = k >> 4, ci = k & 15, p = pp & 63;
        const float ar = Ap[((15 - s) * 64 + p) * 2], ai = Ap[((15 - s) * 64 + p) * 2 + 1];
        const float b0r = Bb[(p * 16 + ci) * 2], b0i = Bb[(p * 16 + ci) * 2 + 1], b1r = Bb[(p * 16 + ci + 1) * 2], b1i = Bb[(p * 16 + ci + 1) * 2 + 1];
        const float v0 = pp < 64 ? ar * b0r - ai * b0i : ar * b0i + ai * b0r, v1 = pp < 64 ? ar * b1r - ai * b1i : ar * b1i + ai * b1r;
        *(unsigned*)(W1 + (size_t)(256 + pp) * 256 + k) = pk2(v0, v1); }
    for (int idx = tid; idx < 32 * 64; idx += 512) { const int n = 32 * b + (idx >> 6), kq = (idx & 63) * 2, t = n >> 4, co = n & 15; float v[2];
#pragma unroll
        for (int e = 0; e < 2; ++e) { const int pp = kq + e, p = pp & 63; const float cr = Cc[(co * 64 + p) * 2], cim = Cc[(co * 64 + p) * 2 + 1], ar = Ap[((t + 1) * 64 + p) * 2], ai = Ap[((t + 1) * 64 + p) * 2 + 1];
            v[e] = pp < 64 ? (cr * ar - cim * ai) : -(cr * ai + cim * ar); }
        *(unsigned*)(W2 + (size_t)n * 128 + kq) = pk2(v[0], v[1]); }
    __syncthreads();
}
__device__ __forceinline__ void p0_prologue(Frame& F) {
    for (int it = F.vcu; it < 256; it += F.G) s5_precompute_item(F, it);
    if (F.vcu == 32 % F.G) {
        float* LB = (float*)(F.ws + WS_S5F + S5F_LB); const float a0 = F.hg_lb[F.tid], a1 = F.hg_lb[512 + F.tid], mx = fmaxf(a0, a1), e0 = expf(a0 - mx), e1 = expf(a1 - mx); LB[F.tid] = e0 / (e0 + e1); }
    LAS float* scr = (LAS float*)(F.lds + RING_OFF + F.wave * 16896);
    const int gw = F.vcu * NWAVES + F.wave, NGW = F.G * NWAVES;
    constexpr int I_IN = (D / 64) * (INC / 64), I_GLU = (HD / 64) * (HD / 64), I_OUT = (D / 64) * (D / 64), I_UP = (D / 64) * (UPC / 64), I_DN = (DFF / 64) * (D / 64);
    constexpr int NITEMS = I_IN + I_GLU + I_OUT + I_UP + I_DN;
    for (int it = gw; it < NITEMS; it += NGW) {
        int r = it;
        if (r < I_IN) { p0_transpose_item(F.w_in, D, INC, (bf16*)(F.ws + WS_WIN), F.g_mix, scr, r, F.lane); continue; } r -= I_IN;
        if (r < I_GLU) { p0_transpose_item(F.w_glu, HD, HD, (bf16*)(F.ws + WS_WGLU), nullptr, scr, r, F.lane); continue; } r -= I_GLU;
        if (r < I_OUT) { p0_transpose_item(F.w_out, D, D, (bf16*)(F.ws + WS_WOUT), nullptr, scr, r, F.lane); continue; } r -= I_OUT;
        if (r < I_UP) { p0_transpose_item(F.w_up, D, UPC, (bf16*)(F.ws + WS_WUP), F.g_ffn, scr, r, F.lane); continue; } r -= I_UP;
        p0_transpose_item(F.w_down, DFF, D, (bf16*)(F.ws + WS_WDN), nullptr, scr, r, F.lane);
    }
    bf16* XN = (bf16*)(F.ws + WS_XN);
    for (int m0 = gw * 4; m0 < RT; m0 += NGW * 4) {
        const float* src[4]; bf16* dst[4];
#pragma unroll
        for (int r = 0; r < 4; ++r) { const int m = m0 + r;
            src[r] = m < R_META ? F.x_prompt + (size_t)m * D : (m < R_SAMP ? F.meta + (size_t)((m - R_META) & 15) * D : F.x_sample + (size_t)(m - R_SAMP) * D);
            dst[r] = XN + (size_t)m * D; }
        rms_rows_to_bf16<4>(F.lane, src, dst);
    }
}

__device__ __forceinline__ void s5_prompt_item(Frame& F, int item) {
    const int g = item & 31, n = item >> 5;
    LAS unsigned char* R1 = F.lds;
    LAS float* R2 = (LAS float*)(F.lds + 76032);
    int tid = F.tid; asm volatile("" : "+v"(tid));
    const int lane = tid & 63, w = F.wave, r = lane & 15, q = lane >> 4;
    const bf16* U = (const bf16*)(F.ws + WS_U);
#pragma unroll
    for (int i = 0; i < 9; ++i) { const int idx = tid + 512 * i, c = idx >> 5, pc = idx & 31, s = pc >> 1, half = pc & 1, cc = c < 128 ? c : 128;
        const int grow = cc == 0 ? R_META + 16 * n + s : 2048 * n + 16 * (cc - 1) + s;
        const v4u val = *(const v4u*)(U + (size_t)grow * HD + 16 * g + 8 * half);
        *(LAS v4u*)(R1 + c * 528 + pc * 16) = val; }
    __syncthreads();
    const bf16* W1 = (const bf16*)(F.ws + WS_S5W1) + (size_t)g * 384 * 256; const bf16* W2 = (const bf16*)(F.ws + WS_S5W2) + (size_t)g * 256 * 128;
    f32x4 acc0[9], acc1[9], acc2[9];
#pragma unroll
    for (int mt = 0; mt < 9; ++mt) { acc0[mt] = (f32x4){0.f, 0.f, 0.f, 0.f}; acc1[mt] = acc0[mt]; acc2[mt] = acc0[mt]; }
#pragma unroll 1
    for (int kk = 0; kk < 8; ++kk) {
        const bool need0 = (2 * kk <= w);
        const bool need1 = (2 * kk <= w + 8);
        const bf16x8 b2 = *(const bf16x8*)(W1 + (size_t)(16 * (16 + w) + r) * 256 + 32 * kk + 8 * q);
        bf16x8 b0 = b2, b1 = b2;
        if (need0) b0 = *(const bf16x8*)(W1 + (size_t)(16 * w + r) * 256 + 32 * kk + 8 * q);
        if (need1) b1 = *(const bf16x8*)(W1 + (size_t)(16 * (w + 8) + r) * 256 + 32 * kk + 8 * q);
#pragma unroll
        for (int mt = 0; mt < 9; ++mt) { const bf16x8 a = *(const LAS bf16x8*)(R1 + (16 * mt + r) * 528 + (32 * kk + 8 * q) * 2);
            acc2[mt] = mfma16(a, b2, acc2[mt]);
            if (need0) acc0[mt] = mfma16(a, b0, acc0[mt]);
            if (need1) acc1[mt] = mfma16(a, b1, acc1[mt]); }
    }
#pragma unroll
    for (int mt = 0; mt < 9; ++mt)
#pragma unroll
        for (int i = 0; i < 4; ++i) R2[(16 * mt + 4 * q + i) * 132 + 16 * w + r] = acc2[mt][i];
    __syncthreads();
    if (w == 0) {
        const float* A16 = (const float*)(F.ws + WS_S5F + S5F_A16); const float ar = A16[(g * 64 + lane) * 2], ai = A16[(g * 64 + lane) * 2 + 1];
        float hr = 0.f, hi = 0.f;
        for (int c0 = 0; c0 < 136; c0 += 8) {
            float lr[8], li[8];
#pragma unroll
            for (int j = 0; j < 8; ++j) { lr[j] = R2[(c0 + j) * 132 + lane]; li[j] = R2[(c0 + j) * 132 + 64 + lane]; }
#pragma unroll
            for (int j = 0; j < 8; ++j) { const int c = c0 + j;
                if (c <= 128) {
                    *(LAS bf16*)(R1 + c * 272 + lane * 2) = (bf16)f2bf(hr); *(LAS bf16*)(R1 + c * 272 + 128 + lane * 2) = (bf16)f2bf(hi);
                    const float nr = ar * hr - ai * hi + lr[j], ni = ar * hi + ai * hr + li[j]; hr = nr; hi = ni;
                } else { *(LAS bf16*)(R1 + c * 272 + lane * 2) = 0; *(LAS bf16*)(R1 + c * 272 + 128 + lane * 2) = 0; } }
        }
#pragma unroll
        for (int c = 136; c < 144; ++c) { *(LAS bf16*)(R1 + c * 272 + lane * 2) = 0; *(LAS bf16*)(R1 + c * 272 + 128 + lane * 2) = 0; }
        F.out[OFF_S5RP + (size_t)(n * 32 + g) * 64 + lane] = hr; F.out[OFF_S5IP + (size_t)(n * 32 + g) * 64 + lane] = hi;
    }
    __syncthreads();
#pragma unroll 1
    for (int kk = 0; kk < 4; ++kk) {
        const bf16x8 b0 = *(const bf16x8*)(W2 + (size_t)(16 * w + r) * 128 + 32 * kk + 8 * q), b1 = *(const bf16x8*)(W2 + (size_t)(16 * (w + 8) + r) * 128 + 32 * kk + 8 * q);
#pragma unroll
        for (int mt = 0; mt < 9; ++mt) { const bf16x8 a = *(const LAS bf16x8*)(R1 + (16 * mt + r) * 272 + (32 * kk + 8 * q) * 2);
            acc0[mt] = mfma16(a, b0, acc0[mt]); acc1[mt] = mfma16(a, b1, acc1[mt]); }
    }
    bf16* Y5 = (bf16*)(F.ws + WS_Y5);
#pragma unroll
    for (int mt = 0; mt < 9; ++mt)
#pragma unroll
        for (int i = 0; i < 4; ++i) { const int c = 16 * mt + 4 * q + i;
            if (c <= 128) { const int rb = c == 0 ? R_META + 16 * n : 2048 * n + 16 * (c - 1);
                Y5[(size_t)(rb + w) * HD + 16 * g + r] = (bf16)f2bf(gelu_tanh(acc0[mt][i]));
                Y5[(size_t)(rb + w + 8) * HD + 16 * g + r] = (bf16)f2bf(gelu_tanh(acc1[mt][i])); } }
    __syncthreads();
}
__device__ __forceinline__ void s5_sample_item(Frame& F, int item) {
    const int g = item & 31, s = item >> 5, lane = F.lane, row = R_SAMP + s;
    const bf16* U = (const bf16*)(F.ws + WS_U); bf16* Y5 = (bf16*)(F.ws + WS_Y5);
    const float* A1 = (const float*)(F.ws + WS_S5F + S5F_A1); const float* BBf = (const float*)(F.ws + WS_S5F + S5F_BB);
    const v4u u0 = *(const v4u*)(U + (size_t)row * HD + 16 * g), u1 = *(const v4u*)(U + (size_t)row * HD + 16 * g + 8);
    float uu[16]; uu[0] = bflo(u0.x); uu[1] = bfhi(u0.x); uu[2] = bflo(u0.y); uu[3] = bfhi(u0.y); uu[4] = bflo(u0.z); uu[5] = bfhi(u0.z); uu[6] = bflo(u0.w); uu[7] = bfhi(u0.w);
    uu[8] = bflo(u1.x); uu[9] = bfhi(u1.x); uu[10] = bflo(u1.y); uu[11] = bfhi(u1.y); uu[12] = bflo(u1.z); uu[13] = bfhi(u1.z); uu[14] = bflo(u1.w); uu[15] = bfhi(u1.w);
    float xr = 0.f, xi = 0.f; const float* bb = BBf + (size_t)(g * 64 + lane) * 32;
#pragma unroll
    for (int c = 0; c < 16; ++c) { xr += bb[2 * c] * uu[c]; xi += bb[2 * c + 1] * uu[c]; }
    const float ar = A1[(g * 64 + lane) * 2], ai = A1[(g * 64 + lane) * 2 + 1];
    const float h0r = F.st_s5r[(size_t)(s * 32 + g) * 64 + lane], h0i = F.st_s5i[(size_t)(s * 32 + g) * 64 + lane];
    const float hr = ar * h0r - ai * h0i + xr, hi = ar * h0i + ai * h0r + xi;
    F.out[OFF_S5RS + (size_t)(s * 32 + g) * 64 + lane] = hr; F.out[OFF_S5IS + (size_t)(s * 32 + g) * 64 + lane] = hi;
    float yk = 0.f;
#pragma unroll
    for (int co = 0; co < 16; ++co) { const float part = hr * F.c_re[(g * 16 + co) * 64 + lane] - hi * F.c_im[(g * 16 + co) * 64 + lane]; const float tot = wave_sum(part); if (lane == co) yk = tot; }
    if (lane < 16) { float uc = 0.f;
#pragma unroll
        for (int c = 0; c < 16; ++c) uc = (lane == c) ? uu[c] : uc;
        const float y = yk + F.s5_d[g * 16 + lane] * uc; Y5[(size_t)row * HD + 16 * g + lane] = (bf16)f2bf(gelu_tanh(y)); }
}
#define HG_O_QD 0
#define HG_O_KD 17408
#define HG_O_KT 34816
#define HG_O_VT 53248
#define HG_O_ATT 55552
#define HG_O_ST 64768
#define HG_O_SEG 69120
#define HG_O_DEC 71168
__device__ __forceinline__ void hgrn_prompt_item(Frame& F, int item, bool atom = true) {
    const int vs = item & 7, h = (item >> 3) & 3, n = item >> 5;
    LAS unsigned char* L = F.lds;
    int tid = F.tid; asm volatile("" : "+v"(tid));
    const int lane = tid & 63, w = F.wave, r = lane & 15, q = lane >> 4;
    const bf16* Qb = (const bf16*)(F.ws + WS_Q); const bf16* Vb = (const bf16*)(F.ws + WS_V); const float* LF = (const float*)(F.ws + WS_LF);
    bf16* OH = (bf16*)(F.ws + WS_OH); float* HSS = (float*)(F.ws + WS_CTL + CB_HSS);
    for (int i = tid; i < (9216 + 4352) / 4; i += 512) ((LAS unsigned*)(L + HG_O_ATT))[i] = 0u;
    f32x4 Sreg = (f32x4){0.f, 0.f, 0.f, 0.f};
    const int k = tid & 127, s4 = tid >> 7, tv = tid >> 3, pr = tid & 7;
    float lf[16]; unsigned short qv[16]; unsigned vv;
#define HG_LOAD(c) do { \
        _Pragma("unroll") for (int i = 0; i < 16; ++i) { const int t = 16 * s4 + i; const int row = (c) == 0 ? (t < 16 ? R_META + 16 * n + t : -1) : 2048 * n + 64 * ((c) - 1) + t; \
            if (row >= 0) { lf[i] = LF[(size_t)row * HD + 128 * h + k]; qv[i] = Qb[(size_t)row * HD + 128 * h + k]; } else { lf[i] = 0.f; qv[i] = 0; } } \
        { const int row = (c) == 0 ? (tv < 16 ? R_META + 16 * n + tv : -1) : 2048 * n + 64 * ((c) - 1) + tv; \
          vv = row >= 0 ? *(const unsigned*)(Vb + (size_t)row * HD + 128 * h + 16 * vs + 2 * pr) : 0u; } } while (0)
    HG_LOAD(0);
    for (int c = 0; c <= 32; ++c) {
        float bc[16]; float run = 0.f;
#pragma unroll
        for (int i = 0; i < 16; ++i) { run += lf[i]; bc[i] = run; }
        ((LAS float*)(L + HG_O_SEG))[s4 * 128 + k] = run;
        __syncthreads();
        float off = 0.f, bl = 0.f;
#pragma unroll
        for (int s = 0; s < 4; ++s) { const float v = ((LAS float*)(L + HG_O_SEG))[s * 128 + k]; bl += v; off += (s < s4) ? v : 0.f; }
        if (s4 == 0) ((LAS float*)(L + HG_O_DEC))[k] = __expf(bl);
        unsigned kp[8];
#pragma unroll
        for (int i = 0; i < 16; i += 2) { float kdl2[2];
#pragma unroll
            for (int e = 0; e < 2; ++e) { const int ii = i + e; const float b = off + bc[ii], f = __expf(lf[ii]), kk = 1.0f - f, eb = __expf(b), enb = __expf(-b);
                *(LAS bf16*)(L + HG_O_QD + (16 * s4 + ii) * 272 + k * 2) = (bf16)f2bf(bf2f(qv[ii]) * eb);
                *(LAS bf16*)(L + HG_O_KD + (16 * s4 + ii) * 272 + k * 2) = (bf16)f2bf(kk * enb);
                kdl2[e] = kk * __expf(bl - b); }
            kp[i >> 1] = pk2(kdl2[0], kdl2[1]); }
        *(LAS v4u*)(L + HG_O_KT + k * 144 + (16 * s4) * 2) = (v4u){kp[0], kp[1], kp[2], kp[3]};
        *(LAS v4u*)(L + HG_O_KT + k * 144 + (16 * s4) * 2 + 16) = (v4u){kp[4], kp[5], kp[6], kp[7]};
        *(LAS bf16*)(L + HG_O_VT + (2 * pr) * 144 + tv * 2) = (bf16)(vv & 0xffffu); *(LAS bf16*)(L + HG_O_VT + (2 * pr + 1) * 144 + tv * 2) = (bf16)(vv >> 16);
        __syncthreads();
        if (c < 32) HG_LOAD(c + 1);
        f32x4 accS;
#pragma unroll
        for (int i = 0; i < 4; ++i) accS[i] = ((LAS float*)(L + HG_O_DEC))[16 * w + 4 * q + i] * Sreg[i];
#pragma unroll
        for (int kk = 0; kk < 2; ++kk) { const bf16x8 a = *(const LAS bf16x8*)(L + HG_O_KT + (16 * w + r) * 144 + (32 * kk + 8 * q) * 2), b = *(const LAS bf16x8*)(L + HG_O_VT + r * 144 + (32 * kk + 8 * q) * 2); accS = mfma16(a, b, accS); }
#pragma unroll
        for (int rep = 0; rep < 2; ++rep) { const int idx = w + 8 * rep;
            if (idx < 10) { const int ti = idx < 1 ? 0 : (idx < 3 ? 1 : (idx < 6 ? 2 : 3)), sj = idx - (ti * (ti + 1)) / 2;
                f32x4 at = (f32x4){0.f, 0.f, 0.f, 0.f};
#pragma unroll
                for (int kk = 0; kk < 4; ++kk) { const bf16x8 a = *(const LAS bf16x8*)(L + HG_O_QD + (16 * ti + r) * 272 + (32 * kk + 8 * q) * 2), b = *(const LAS bf16x8*)(L + HG_O_KD + (16 * sj + r) * 272 + (32 * kk + 8 * q) * 2); at = mfma16(a, b, at); }
#pragma unroll
                for (int i = 0; i < 4; ++i) { const int t = 16 * ti + 4 * q + i, s = 16 * sj + r; *(LAS bf16*)(L + HG_O_ATT + t * 144 + s * 2) = (bf16)f2bf(s <= t ? at[i] : 0.f); } } }
        f32x4 o = (f32x4){0.f, 0.f, 0.f, 0.f};
        if (w < 4) {
#pragma unroll
            for (int kk = 0; kk < 4; ++kk) { const bf16x8 a = *(const LAS bf16x8*)(L + HG_O_QD + (16 * w + r) * 272 + (32 * kk + 8 * q) * 2), b = *(const LAS bf16x8*)(L + HG_O_ST + r * 272 + (32 * kk + 8 * q) * 2); o = mfma16(a, b, o); } }
        __syncthreads();
        Sreg = accS;
        *(LAS v2u*)(L + HG_O_ST + r * 272 + (16 * w + 4 * q) * 2) = (v2u){pk2(Sreg[0], Sreg[1]), pk2(Sreg[2], Sreg[3])};
        if (w < 4) {
#pragma unroll
            for (int kk = 0; kk < 2; ++kk) { const bf16x8 a = *(const LAS bf16x8*)(L + HG_O_ATT + (16 * w + r) * 144 + (32 * kk + 8 * q) * 2), b = *(const LAS bf16x8*)(L + HG_O_VT + r * 144 + (32 * kk + 8 * q) * 2); o = mfma16(a, b, o); }
#pragma unroll
            for (int i = 0; i < 4; ++i) { const int t = 16 * w + 4 * q + i; const int row = c == 0 ? (t < 16 ? R_META + 16 * n + t : -1) : 2048 * n + 64 * (c - 1) + t;
                float ss = o[i] * o[i]; ss += __shfl_xor(ss, 1); ss += __shfl_xor(ss, 2); ss += __shfl_xor(ss, 4); ss += __shfl_xor(ss, 8);
                if (row >= 0) { OH[(size_t)row * HD + 128 * h + 16 * vs + r] = (bf16)f2bf(o[i]); if (r == 0 && atom) atomic_addf(HSS + (size_t)row * 4 + h, ss); } } }
        __syncthreads();
    }
#undef HG_LOAD
#pragma unroll
    for (int i = 0; i < 4; ++i) F.out[OFF_HGP + ((size_t)(n * 4 + h) * 128 + 16 * w + 4 * q + i) * 128 + 16 * vs + r] = Sreg[i];
}
__device__ __forceinline__ void hgrn_sample_item(Frame& F, int item, bool atom = true) {
    const int h = item & 3, s = item >> 2, row = R_SAMP + s, tid = F.tid, vq = tid & 31, kg = tid >> 5;
    const bf16* Qb = (const bf16*)(F.ws + WS_Q); const bf16* Vb = (const bf16*)(F.ws + WS_V); const float* LF = (const float*)(F.ws + WS_LF);
    bf16* OH = (bf16*)(F.ws + WS_OH); float* HSS = (float*)(F.ws + WS_CTL + CB_HSS);
    LAS float* red = (LAS float*)F.lds;
    const v2u vw = *(const v2u*)(Vb + (size_t)row * HD + 128 * h + 4 * vq);
    const f32x4 v4 = (f32x4){bflo(vw.x), bfhi(vw.x), bflo(vw.y), bfhi(vw.y)};
    f32x4 o4 = (f32x4){0.f, 0.f, 0.f, 0.f};
#pragma unroll
    for (int i = 0; i < 8; ++i) { const int k = 8 * kg + i; const float f = __expf(LF[(size_t)row * HD + 128 * h + k]), kk = 1.0f - f, qk = bf2f(Qb[(size_t)row * HD + 128 * h + k]);
        const size_t off = ((size_t)(s * 4 + h) * 128 + k) * 128 + 4 * vq;
        const f32x4 sn = *(const f32x4*)(F.st_hg + off) * f + v4 * kk;
        *(f32x4*)(F.out + OFF_HGS + off) = sn; o4 += sn * qk; }
    *(LAS f32x4*)(red + kg * 128 + 4 * vq) = o4;
    __syncthreads();
    if (tid < 128) { float o = 0.f;
#pragma unroll
        for (int j = 0; j < 16; ++j) o += red[j * 128 + tid];
        OH[(size_t)row * HD + 128 * h + tid] = (bf16)f2bf(o);
        const float ss = wave_sum(o * o); if (F.lane == 0 && atom) atomic_addf(HSS + (size_t)row * 4 + h, ss); }
    __syncthreads();
}
__device__ __forceinline__ void hgrn_finalize(Frame& F) {
    const bf16* OH = (const bf16*)(F.ws + WS_OH); const bf16* G = (const bf16*)(F.ws + WS_G); const float* HSS = (const float*)(F.ws + WS_CTL + CB_HSS); bf16* MIX = (bf16*)(F.ws + WS_MIX);
    const int gt = F.vcu * 512 + F.tid, NT = F.G * 512;
    for (int idx = gt; idx < RT * 64; idx += NT) { const int row = idx >> 6, c8 = (idx & 63) * 8;
        const float rstd = __builtin_amdgcn_rsqf(ld_agent(HSS + (size_t)row * 4 + (c8 >> 7)) * (1.0f / 128.0f) + EPS);
        const v4u o = *(const v4u*)(OH + (size_t)row * HD + c8), gg = *(const v4u*)(G + (size_t)row * HD + c8);
        const f32x4 n0 = *(const f32x4*)(F.hg_ng + c8), n1 = *(const f32x4*)(F.hg_ng + c8 + 4);
        v4u w;
        w.x = pk2(bflo(o.x) * rstd * n0[0] * bflo(gg.x), bfhi(o.x) * rstd * n0[1] * bfhi(gg.x));
        w.y = pk2(bflo(o.y) * rstd * n0[2] * bflo(gg.y), bfhi(o.y) * rstd * n0[3] * bfhi(gg.y));
        w.z = pk2(bflo(o.z) * rstd * n1[0] * bflo(gg.z), bfhi(o.z) * rstd * n1[1] * bfhi(gg.z));
        w.w = pk2(bflo(o.w) * rstd * n1[2] * bflo(gg.w), bfhi(o.w) * rstd * n1[3] * bfhi(gg.w));
        *(v4u*)(MIX + (size_t)row * D + 512 + c8) = w; }
}
__device__ __forceinline__ void gate_pass(Frame& F) {
    bf16* HID = (bf16*)(F.ws + WS_HID);
    const int gt = F.vcu * 512 + F.tid, NT = F.G * 512;
    for (int idx = gt; idx < RT * 352; idx += NT) { const int row = idx / 352, c8 = (idx - row * 352) * 8;
        float p1[8], p2[8], a[8], v[8];
        { const v4u x = *(const v4u*)(HID + (size_t)row * UPC + c8); a[0] = bflo(x.x); a[1] = bfhi(x.x); a[2] = bflo(x.y); a[3] = bfhi(x.y); a[4] = bflo(x.z); a[5] = bfhi(x.z); a[6] = bflo(x.w); a[7] = bfhi(x.w); }
        { const v4u x = *(const v4u*)(HID + (size_t)row * UPC + DFF + c8); v[0] = bflo(x.x); v[1] = bfhi(x.x); v[2] = bflo(x.y); v[3] = bfhi(x.y); v[4] = bflo(x.z); v[5] = bfhi(x.z); v[6] = bflo(x.w); v[7] = bfhi(x.w); }
        if (row >= R_SAMP) { const int s = row - R_SAMP; const float* b0 = F.st_cv + (size_t)(s * 2) * DFF + c8; const float* b1 = b0 + DFF;
#pragma unroll
            for (int j = 0; j < 8; ++j) { p2[j] = b0[j]; p1[j] = b1[j]; F.out[OFF_CVS + (size_t)(s * 2) * DFF + c8 + j] = b1[j]; }
        } else {
            int r1, r2;
            if (row < R_META) { const int t = row & 2047, nn = row >> 11; r1 = t >= 1 ? row - 1 : R_META + 16 * nn + 15; r2 = t >= 2 ? row - 2 : R_META + 16 * nn + 14 + t; }
            else { const int m = (row - R_META) & 15; r1 = m >= 1 ? row - 1 : -1; r2 = m >= 2 ? row - 2 : -1; }
            if (r1 >= 0) { const v4u x = *(const v4u*)(HID + (size_t)r1 * UPC + c8); p1[0] = bflo(x.x); p1[1] = bfhi(x.x); p1[2] = bflo(x.y); p1[3] = bfhi(x.y); p1[4] = bflo(x.z); p1[5] = bfhi(x.z); p1[6] = bflo(x.w); p1[7] = bfhi(x.w); }
            else {
#pragma unroll
                for (int j = 0; j < 8; ++j) p1[j] = 0.f; }
            if (r2 >= 0) { const v4u x = *(const v4u*)(HID + (size_t)r2 * UPC + c8); p2[0] = bflo(x.x); p2[1] = bfhi(x.x); p2[2] = bflo(x.y); p2[3] = bfhi(x.y); p2[4] = bflo(x.z); p2[5] = bfhi(x.z); p2[6] = bflo(x.w); p2[7] = bfhi(x.w); }
            else {
#pragma unroll
                for (int j = 0; j < 8; ++j) p2[j] = 0.f; }
        }
        float o[8];
#pragma unroll
        for (int j = 0; j < 8; ++j) { const float cc = F.conv_b[c8 + j] + F.conv_w[c8 + j] * p2[j] + F.conv_w[DFF + c8 + j] * p1[j] + F.conv_w[2 * DFF + c8 + j] * a[j]; o[j] = siluf_(cc) * v[j]; }
        v4u w; w.x = pk2(o[0], o[1]); w.y = pk2(o[2], o[3]); w.z = pk2(o[4], o[5]); w.w = pk2(o[6], o[7]);
        *(v4u*)(HID + (size_t)row * UPC + DFF + c8) = w; }
}
__device__ __forceinline__ void final_norm(Frame& F) {
    const float* SS3 = (const float*)(F.ws + WS_CTL + CB_SS3);
    const int gw = F.vcu * NWAVES + F.wave, NGW = F.G * NWAVES;
    for (int i = gw; i < R_META + NS; i += NGW) { const int row = i < R_META ? i : R_SAMP + (i - R_META);
        float* p = row < R_META ? F.out + (size_t)row * D : F.out + OFF_YS + (size_t)(row - R_SAMP) * D;
        const float rstd = __builtin_amdgcn_rsqf(ld_agent(SS3 + row) * (1.0f / D) + EPS);
#pragma unroll
        for (int j = 0; j < 4; ++j) { const int c = 4 * F.lane + 256 * j; f32x4 v = *(const f32x4*)(p + c); const f32x4 gg = *(const f32x4*)(F.g_final + c); v = v * rstd * gg; *(f32x4*)(p + c) = v; } }
}
#ifndef MK_N_LAUNCHES
#define MK_N_LAUNCHES 1
#endif
constexpr int N_LAUNCHES = MK_N_LAUNCHES;
constexpr int PER_PHASE = 9;
struct Args { const float* in[28]; float* out; unsigned char* ws; int ph_lo, ph_hi, li, pad; };
__global__ void __launch_bounds__(NWAVES * 64, 2) hymba_fwd(Args args) {
    extern __shared__ __attribute__((aligned(16))) unsigned char lds[];
    Frame F;
    F.lds = (LAS unsigned char*)lds;
    F.MISC = (volatile LAS unsigned*)(F.lds + MISC_OFF);
    F.tid = threadIdx.x; F.lane = F.tid & 63; F.wave = __builtin_amdgcn_readfirstlane(F.tid >> 6);
    F.G = gridDim.x; { const int bx = blockIdx.x; F.vcu = (F.G % 8 == 0) ? (bx % 8) * (F.G / 8) + bx / 8 : bx; }
    F.ws = args.ws; F.out = args.out; F.ctl = (gu32*)(args.ws + WS_CTL);
    F.x_prompt = args.in[0]; F.x_sample = args.in[1]; F.st_s5r = args.in[2]; F.st_s5i = args.in[3]; F.st_hg = args.in[4]; F.st_cv = args.in[5]; F.meta = args.in[6];
    F.g_mix = args.in[7]; F.w_in = args.in[8]; F.lam_re = args.in[9]; F.lam_im = args.in[10]; F.log_dt = args.in[11]; F.b_re = args.in[12]; F.b_im = args.in[13];
    F.c_re = args.in[14]; F.c_im = args.in[15]; F.s5_d = args.in[16]; F.w_glu = args.in[17]; F.b_glu = args.in[18]; F.hg_lb = args.in[19]; F.hg_ng = args.in[20];
    F.w_out = args.in[21]; F.g_ffn = args.in[22]; F.w_up = args.in[23]; F.conv_w = args.in[24]; F.conv_b = args.in[25]; F.w_down = args.in[26]; F.g_final = args.in[27];
    for (int u = F.tid; u < 64; u += NWAVES * 64) ((LAS unsigned*)(F.lds + MISC_OFF))[u] = 0u;
    __syncthreads();
    XcdBarrier bar; bar.bar = (unsigned*)(F.ctl + CW_BAR); bar.x = 0; bar.st = nullptr;
    if (N_LAUNCHES != PER_PHASE) bar = xcd_barrier_post((unsigned*)(F.ctl + CW_BAR), F.MISC + 8);
#define GRID_BAR() do { if (N_LAUNCHES != PER_PHASE) xcd_barrier(bar); } while (0)
    const int lo = args.ph_lo, hi = args.ph_hi;
#ifndef P2_MASK
#define P2_MASK 15
#endif
#ifndef PH_MASK
#define PH_MASK 0x1ff
#endif
#define IN(k) (((PH_MASK >> (k)) & 1) && lo <= (k) && (k) < hi)
#define BOTH(k) (IN(k) && IN((k) + 1))
    const int gw = F.vcu * NWAVES + F.wave, NGW = F.G * NWAVES;
    bf16* XN = (bf16*)(F.ws + WS_XN);

#if defined(PROBE_DUP) && (PROBE_DUP & 0x0f) == 0
    if (IN(0)) { p0_prologue(F); __syncthreads(); }
#endif
    if (IN(0)) { p0_prologue(F); if (BOTH(0)) GRID_BAR(); }
    if (IN(1)) {
        pg8::Gemm g{XN, (const bf16*)(F.ws + WS_WIN), RT, INC, D, D}; pg8::StaticOrder S; S.init(RT, INC, F.G, (int)blockIdx.x);
        EpiIn E{(bf16*)(F.ws + WS_U), (bf16*)(F.ws + WS_Q), (bf16*)(F.ws + WS_V), (bf16*)(F.ws + WS_G), (float*)(F.ws + WS_LF), (const float*)(F.ws + WS_S5F + S5F_LB)};
#if defined(PROBE_DUP) && (PROBE_DUP & 0x0f) == 1
        pg8::gemm_phase<EpiIn, true>(F.lds + RING_OFF, g, S, E);
#endif
        pg8::gemm_phase<EpiIn, true>(F.lds + RING_OFF, g, S, E);
        if (BOTH(1)) GRID_BAR();
    }
#if defined(PROBE_DUP) && (PROBE_DUP & 0x0f) == 2
    if (IN(2)) {
        if (PROBE_DUP & 0x10) for (int it = F.vcu; it < NB * 32; it += F.G) s5_prompt_item(F, it);
        if (PROBE_DUP & 0x20) for (int it = F.vcu; it < NB * 4 * 8; it += F.G) hgrn_prompt_item(F, it, false);
        if (PROBE_DUP & 0x40) for (int it = gw; it < NS * 32; it += NGW) s5_sample_item(F, it);
        if (PROBE_DUP & 0x80) for (int it = F.vcu; it < NS * 4; it += F.G) hgrn_sample_item(F, it, false);
    }
#endif
    if (IN(2)) {
        if (P2_MASK & 1) for (int it = F.vcu; it < NB * 32; it += F.G) s5_prompt_item(F, it);
        if (P2_MASK & 2) for (int it = F.vcu; it < NB * 4 * 8; it += F.G) hgrn_prompt_item(F, it);
        if (P2_MASK & 4) for (int it = gw; it < NS * 32; it += NGW) s5_sample_item(F, it);
        if (P2_MASK & 8) for (int it = F.vcu; it < NS * 4; it += F.G) hgrn_sample_item(F, it);
        if (BOTH(2)) GRID_BAR();
    }
    if (IN(3)) {
        hgrn_finalize(F);
        pg8::Gemm g{(const bf16*)(F.ws + WS_Y5), (const bf16*)(F.ws + WS_WGLU), RT, HD, HD, HD}; pg8::StaticOrder S; S.init(RT, HD, F.G, (int)blockIdx.x);
        EpiGlu E{(const bf16*)(F.ws + WS_Y5), F.b_glu, (bf16*)(F.ws + WS_MIX)};
#if defined(PROBE_DUP) && (PROBE_DUP & 0x0f) == 3
        hgrn_finalize(F);
        pg8::gemm_phase<EpiGlu, true>(F.lds + RING_OFF, g, S, E);
#endif
        pg8::gemm_phase<EpiGlu, true>(F.lds + RING_OFF, g, S, E);
        if (BOTH(3)) GRID_BAR();
    }
    if (IN(4)) {
        pg8::Gemm g{(const bf16*)(F.ws + WS_MIX), (const bf16*)(F.ws + WS_WOUT), RT, D, D, D}; pg8::StaticOrder S; S.init(RT, D, F.G, (int)blockIdx.x);
        EpiOut E{F.x_prompt, F.meta, F.x_sample, F.out, (float*)(F.ws + WS_H1META), XN, (float*)(F.ws + WS_CTL + CB_SS2)};
#if defined(PROBE_DUP) && (PROBE_DUP & 0x0f) == 4
        { EpiOut E2 = E; E2.ss = nullptr; pg8::gemm_phase<EpiOut, true>(F.lds + RING_OFF, g, S, E2); }
#endif
        pg8::gemm_phase<EpiOut, true>(F.lds + RING_OFF, g, S, E);
        if (BOTH(4)) GRID_BAR();
    }
    if (IN(5)) {
        pg8::Gemm g{XN, (const bf16*)(F.ws + WS_WUP), RT, UPC, D, D}; pg8::StaticOrder S; S.init(RT, UPC, F.G, (int)blockIdx.x);
        EpiUp E{(const float*)(F.ws + WS_CTL + CB_SS2), (bf16*)(F.ws + WS_HID), F.out};
#if defined(PROBE_DUP) && (PROBE_DUP & 0x0f) == 5
        pg8::gemm_phase<EpiUp, true>(F.lds + RING_OFF, g, S, E);
#endif
        pg8::gemm_phase<EpiUp, true>(F.lds + RING_OFF, g, S, E);
        if (BOTH(5)) GRID_BAR();
    }
    if (IN(6)) { gate_pass(F); if (BOTH(6)) GRID_BAR(); }
    if (IN(7)) {
        pg8::Gemm g{(const bf16*)(F.ws + WS_HID) + DFF, (const bf16*)(F.ws + WS_WDN), RT, D, DFF, UPC}; pg8::StaticOrder S; S.init(RT, D, F.G, (int)blockIdx.x);
        EpiDown E{F.out, (float*)(F.ws + WS_H1META), (float*)(F.ws + WS_CTL + CB_SS3)};
        pg8::gemm_phase<EpiDown, true>(F.lds + RING_OFF, g, S, E);
        if (BOTH(7)) GRID_BAR();
    }
    if (IN(8)) final_norm(F);
#undef IN
#undef BOTH
#undef GRID_BAR
}

extern "C" void kernel_launch(void* const* d_in, const int* in_sizes, int n_in, void* d_out, int out_size, void* d_ws, size_t ws_size, hipStream_t stream) {
    static int grid = 0;
    if (grid == 0) {
        if (n_in != 28 || out_size != (int)OUT_TOTAL || ws_size < WS_END) { fprintf(stderr, "kernel_launch: unexpected problem (n_in %d, out %d, ws %zu); nothing launched\n", n_in, out_size, ws_size); grid = -1; return; }
        int dev = 0, cus = 0, per_cu = 0;
        if (hipGetDevice(&dev) != hipSuccess || hipDeviceGetAttribute(&cus, hipDeviceAttributeMultiprocessorCount, dev) != hipSuccess) { fprintf(stderr, "kernel_launch: device query failed\n"); grid = -1; return; }
        if (hipFuncSetAttribute((const void*)hymba_fwd, hipFuncAttributeMaxDynamicSharedMemorySize, LDS_BYTES) != hipSuccess) { fprintf(stderr, "kernel_launch: hipFuncSetAttribute failed\n"); grid = -1; return; }
        if (hipOccupancyMaxActiveBlocksPerMultiprocessor(&per_cu, (const void*)hymba_fwd, NWAVES * 64, LDS_BYTES) != hipSuccess || per_cu < 1)
            fprintf(stderr, "kernel_launch: note: occupancy query reports %d workgroups per CU\n", per_cu);
        (void)hipGetLastError();
        grid = cus;
    }
    if (grid < 0) return;
    if (hipMemsetAsync((char*)d_ws + WS_CTL, 0, CTL_ZERO_BYTES, stream) != hipSuccess) { fprintf(stderr, "kernel_launch: hipMemsetAsync failed\n"); return; }
    Args a{};
    for (int i = 0; i < 28; ++i) a.in[i] = (const float*)d_in[i];
    a.out = (float*)d_out; a.ws = (unsigned char*)d_ws;
    for (int li = 0; li < N_LAUNCHES; ++li) {
        a.ph_lo = (N_LAUNCHES == PER_PHASE) ? li : 0; a.ph_hi = (N_LAUNCHES == PER_PHASE) ? li + 1 : PER_PHASE; a.li = li;
        hipLaunchKernelGGL(hymba_fwd, dim3(grid), dim3(NWAVES * 64), LDS_BYTES, stream, a);
        const hipError_t le = hipPeekAtLastError();
        if (le != hipSuccess) { fprintf(stderr, "kernel_launch: launch %d failed: %s\n", li, hipGetErrorName(le)); break; }
    }
}
```

```cpp
#include <hip/hip_runtime.h>
#include <cstdio>
#include <cstdint>
#define MK_N_LAUNCHES 1
namespace pg8 {
#define PG8_LAS __attribute__((address_space(3)))
typedef unsigned short bf16_t;
typedef short bf16x8 __attribute__((ext_vector_type(8)));
typedef float f32x4 __attribute__((ext_vector_type(4)));
typedef unsigned u32x4 __attribute__((ext_vector_type(4)));
typedef unsigned u32x2 __attribute__((ext_vector_type(2)));
constexpr int BM = 256, BK = 64, HALF = 128, HTB = HALF * BK * 2  , STAGE_BYTES = 8 * HTB, NXCD = 8, WGM = 8;

__host__ __device__ __forceinline__ int lds_byte(int r, int c) { const int st = (r >> 4) * 2 + (c >> 5), rr = r & 15, cc = c & 31, ob = rr * 64 + cc * 2; return st * 1024 + (ob ^ (((ob >> 9) & 1) << 5)); }
__host__ __device__ __forceinline__ void stage_rc(int b, int& R, int& C) { const int st = b / 1024, sb = b % 1024, swz = sb ^ (((sb >> 9) & 1) << 5); R = (st >> 1) * 16 + swz / 64; C = (st & 1) * 32 + (swz % 64) / 2; }
__host__ __device__ __forceinline__ int perm32(int rho) { const int n = rho >> 4, i = rho & 15; return 8 * (i >> 2) + 4 * n + (i & 3); }

struct Unit { int pm, pn; };
struct Gemm { const bf16_t* A; const bf16_t* Bt; int M, N, K, lda, a_tile_rows; };

struct StaticOrder {
    int nM, nN, nwg, G, c;
    __host__ __device__ void init(int M, int N, int G_, int c_) { nM = M / BM; nN = N / BM; nwg = nM * nN; G = G_; c = c_; }
    __host__ __device__ bool next(int i, Unit& u) const {
        const long L = (long)i * G + c; if (L >= nwg) return false;
        int wgid = (int)L; { const int q = nwg / NXCD, r = nwg % NXCD, xcd = wgid % NXCD, off = wgid / NXCD; wgid = (xcd < r ? xcd * (q + 1) : r * (q + 1) + (xcd - r) * q) + off; }
        const int nig = WGM * nN, gid = wgid / nig, fm = gid * WGM, gsz = (nM - fm) < WGM ? (nM - fm) : WGM;
        u.pm = fm + ((wgid % nig) % gsz); u.pn = (wgid % nig) / gsz; return true;
    }
};

__device__ __forceinline__ unsigned cvt_pk_bf16(float lo, float hi) { unsigned r; asm volatile("v_cvt_pk_bf16_f32 %0, %1, %2" : "=v"(r) : "v"(lo), "v"(hi)); return r; }

template <class Epi, bool ALIGN_EPI>
__device__ __forceinline__ void gemm_phase(PG8_LAS unsigned char* lds, const Gemm g, const StaticOrder& S, const Epi& E) {
    const int tid = threadIdx.x, wid = __builtin_amdgcn_readfirstlane(tid >> 6), lane = tid & 63, wr = wid >> 2, wc = wid & 3, fr = lane & 15, fq = lane >> 4;
    const int K = g.K, nt = K / BK, lda = g.lda;
    unsigned voffA[2], voffB[2];
#pragma unroll
    for (int i = 0; i < 2; ++i) { int R, C; stage_rc(tid * 16 + i * 8192, R, C); const int Rb = (R & ~31) + perm32(R & 31);
        voffA[i] = (unsigned)(R * lda + C) * 2u; voffB[i] = (unsigned)(Rb * K + C) * 2u; }
    const size_t kstep = (size_t)(BK * 2);
    const size_t hstepA = (size_t)HALF * lda * 2, hstepB = (size_t)HALF * K * 2;
    const size_t tstepA = (size_t)g.a_tile_rows * lda * 2, tstepB = 2 * hstepB;
    const unsigned ldsw = (unsigned)wid * 1024u;
    const int aoff = lds_byte(wr * 64 + fr, fq * 8), boff = lds_byte(wc * 32 + fr, fq * 8);
#define PG8_SA(b, h) (((b) * 2 + (h)) * HTB)
#define PG8_SB(b, h) ((4 + (b) * 2 + (h)) * HTB)
#define PG8_STAGE(bufoff, gbase, voff) do { _Pragma("unroll") for (int _i = 0; _i < 2; ++_i) \
        __builtin_amdgcn_global_load_lds((const unsigned*)((const char*)(gbase) + (voff)[_i]), (PG8_LAS unsigned*)(lds + (bufoff) + ldsw + _i * 8192), 16, 0, 0); } while (0)
#define PG8_LDA(dst, b, h) do { _Pragma("unroll") for (int m = 0; m < 4; ++m) _Pragma("unroll") for (int k = 0; k < 2; ++k) dst[m][k] = *(const PG8_LAS bf16x8*)(lds + PG8_SA(b, h) + aoff + m * 2048 + k * 1024); } while (0)
#define PG8_LDB(dst, b, h) do { _Pragma("unroll") for (int n = 0; n < 2; ++n) _Pragma("unroll") for (int k = 0; k < 2; ++k) dst[n][k] = *(const PG8_LAS bf16x8*)(lds + PG8_SB(b, h) + boff + n * 2048 + k * 1024); } while (0)
#define PG8_MMA(ai, bj, At, Bt) do { __builtin_amdgcn_s_setprio(1); _Pragma("unroll") for (int m = 0; m < 4; ++m) _Pragma("unroll") for (int n = 0; n < 2; ++n) _Pragma("unroll") for (int k = 0; k < 2; ++k) \
        acc[ai][bj][m][n] = __builtin_amdgcn_mfma_f32_16x16x32_bf16(Bt[n][k], At[m][k], acc[ai][bj][m][n], 0, 0, 0); __builtin_amdgcn_s_setprio(0); } while (0)
#define PG8_WAIT_V(n) asm volatile("s_waitcnt vmcnt(" #n ")" ::: "memory")
#define PG8_WAIT_L(n) asm volatile("s_waitcnt lgkmcnt(" #n ")" ::: "memory")
#define PG8_BAR __builtin_amdgcn_s_barrier()
#define PG8_SCHED __builtin_amdgcn_sched_barrier(0)
    Unit cur, nxt; int ui = 0;
    if (!S.next(0, cur)) return;
    f32x4 acc[2][2][4][2];
#pragma unroll
    for (int a = 0; a < 2; ++a)
#pragma unroll
        for (int b = 0; b < 2; ++b)
#pragma unroll
            for (int m = 0; m < 4; ++m)
#pragma unroll
                for (int n = 0; n < 2; ++n) acc[a][b][m][n] = (f32x4){0.f, 0.f, 0.f, 0.f};
    bf16x8 At[4][2], B0[2][2], B1[2][2];
    const char* cA = (const char*)g.A + (size_t)cur.pm * tstepA; const char* cB = (const char*)g.Bt + (size_t)cur.pn * tstepB;
    PG8_STAGE(PG8_SB(0, 0), cB, voffB); PG8_STAGE(PG8_SB(0, 1), cB + hstepB, voffB); PG8_STAGE(PG8_SA(0, 0), cA, voffA); PG8_STAGE(PG8_SA(0, 1), cA + hstepA, voffA);
    if (wr == 1) PG8_BAR;
    PG8_WAIT_V(2); PG8_BAR;
    PG8_STAGE(PG8_SB(1, 0), cB + kstep, voffB); PG8_STAGE(PG8_SA(1, 0), cA + kstep, voffA); PG8_STAGE(PG8_SB(1, 1), cB + hstepB + kstep, voffB);
    PG8_WAIT_V(6); PG8_BAR;
    for (;;) {
        const bool has_next = S.next(ui + 1, nxt);
        const char* nA = has_next ? (const char*)g.A + (size_t)nxt.pm * tstepA : cA; const char* nB = has_next ? (const char*)g.Bt + (size_t)nxt.pn * tstepB : cB;
        for (int t = 0; t < nt; t += 2) {
            const bool last = (t == nt - 2);
            const char* a1 = cA + (size_t)(t + 1) * kstep;
            const char* a2 = last ? nA : cA + (size_t)(t + 2) * kstep; const char* b2 = last ? nB : cB + (size_t)(t + 2) * kstep;
            const char* a3 = a2 + kstep; const char* b3 = b2 + kstep;
            PG8_LDB(B0, 0, 0); PG8_LDB(B1, 0, 1); PG8_SCHED; PG8_LDA(At, 0, 0); PG8_STAGE(PG8_SA(1, 1), a1 + hstepA, voffA);
            PG8_WAIT_V(8); PG8_WAIT_L(0); PG8_BAR; PG8_MMA(0, 0, At, B0); PG8_MMA(0, 1, At, B1); PG8_BAR; PG8_SCHED;
            PG8_LDA(At, 0, 1); PG8_STAGE(PG8_SB(0, 0), b2, voffB); PG8_STAGE(PG8_SB(0, 1), b2 + hstepB, voffB); PG8_STAGE(PG8_SA(0, 0), a2, voffA);
            PG8_WAIT_V(8); PG8_WAIT_L(0); PG8_BAR; PG8_MMA(1, 0, At, B0); PG8_MMA(1, 1, At, B1); PG8_BAR; PG8_SCHED;
            PG8_LDB(B0, 1, 0); PG8_LDB(B1, 1, 1); PG8_SCHED; PG8_LDA(At, 1, 0); PG8_STAGE(PG8_SA(0, 1), a2 + hstepA, voffA);
            PG8_WAIT_V(8); PG8_WAIT_L(0); PG8_BAR; PG8_MMA(0, 0, At, B0); PG8_MMA(0, 1, At, B1); PG8_BAR; PG8_SCHED;
            PG8_LDA(At, 1, 1); PG8_STAGE(PG8_SB(1, 0), b3, voffB); PG8_STAGE(PG8_SB(1, 1), b3 + hstepB, voffB); PG8_STAGE(PG8_SA(1, 0), a3, voffA);
            PG8_WAIT_V(8); PG8_WAIT_L(0); PG8_BAR; PG8_MMA(1, 0, At, B0); PG8_MMA(1, 1, At, B1); PG8_BAR; PG8_SCHED;
        }
        if constexpr (ALIGN_EPI) { if (wr == 0) PG8_BAR; }
        E(acc, cur, wr, wc, fr, fq);
        if (!has_next) break;
#pragma unroll
        for (int a = 0; a < 2; ++a)
#pragma unroll
            for (int b = 0; b < 2; ++b)
#pragma unroll
                for (int m = 0; m < 4; ++m)
#pragma unroll
                    for (int n = 0; n < 2; ++n) acc[a][b][m][n] = (f32x4){0.f, 0.f, 0.f, 0.f};
        cur = nxt; cA = nA; cB = nB; ++ui;
        if constexpr (ALIGN_EPI) { if (wr == 1) PG8_BAR; }
    }
    PG8_WAIT_V(0);
    if constexpr (!ALIGN_EPI) { if (wr == 0) PG8_BAR; }
    PG8_BAR;
#undef PG8_SA
#undef PG8_SB
#undef PG8_STAGE
#undef PG8_LDA
#undef PG8_LDB
#undef PG8_MMA
#undef PG8_WAIT_V
#undef PG8_WAIT_L
#undef PG8_BAR
#undef PG8_SCHED
}
}
using pg8::bf16x8;
constexpr int NWAVES = 8;
constexpr int D = 1024, NB = 8, SEQ = 2048, NMETA = 16, NS = 128;
constexpr int RT = 16640;
constexpr int SEQP = 2064, R_SAMP = 16512;
__device__ __forceinline__ int seq_of(int r) { return (int)__umulhi((unsigned)r, 2080903u); }
constexpr int HD = 512;
constexpr int INC = 2560, DFF = 2816, UPC = 5632;
constexpr float EPS = 1e-6f;
constexpr size_t OFF_YP = 0, OFF_YS = 16777216, OFF_S5RP = 16908288, OFF_S5IP = 16924672, OFF_HGP = 16941056, OFF_CVP = 17465344,
                 OFF_S5RS = 17510400, OFF_S5IS = 17772544, OFF_HGS = 18034688, OFF_CVS = 26423296, OUT_TOTAL = 27144192;
constexpr size_t KiB = 1024, MiB = 1u << 20;
constexpr size_t WS_CTL = 0, CTL_ZERO_BYTES = 1 * MiB;
constexpr int CW_BAR = 4096;
constexpr size_t CB_SS2 = 64 * KiB, CB_SS3 = 192 * KiB, CB_HSS = 512 * KiB;
constexpr size_t WS_WIN = 2 * MiB, WS_WGLU = 7 * MiB, WS_WOUT = 7 * MiB + 512 * KiB, WS_WUP = 9 * MiB + 512 * KiB, WS_WDN = 20 * MiB + 512 * KiB;
constexpr size_t WS_S5W1 = 26 * MiB, WS_S5W2 = 32 * MiB, WS_S5F = 34 * MiB;
constexpr size_t S5F_A1 = 0, S5F_A16 = 16 * KiB, S5F_BB = 64 * KiB, S5F_LB = 384 * KiB;
constexpr size_t WS_H1META = 35 * MiB;
constexpr size_t WS_XN = 36 * MiB;
constexpr size_t ROWS512_BF16 = (size_t)RT * 512 * 2;
constexpr size_t WS_U = 68 * MiB + 512 * KiB, WS_Q = WS_U + ROWS512_BF16, WS_V = WS_Q + ROWS512_BF16, WS_G = WS_V + ROWS512_BF16, WS_LF = WS_G + ROWS512_BF16,
                 WS_Y5 = WS_LF + 2 * ROWS512_BF16, WS_OH = WS_Y5 + ROWS512_BF16, WS_MIX = WS_OH + ROWS512_BF16, WS_ZEND = WS_MIX + 2 * ROWS512_BF16;
constexpr size_t WS_GATED = WS_U;
constexpr size_t WS_END = 256 * MiB;
static_assert(WS_ZEND <= WS_END && WS_GATED + (size_t)RT * DFF * 2 <= WS_MIX && WS_XN + (size_t)RT * D * 2 <= WS_U, "d_ws map");
static_assert(CB_HSS + (size_t)RT * 4 * 4 <= CTL_ZERO_BYTES && CB_SS3 + RT * 4 <= CB_HSS && CB_SS2 + RT * 4 <= CB_SS3 && (CW_BAR + 3456) * 4 <= (int)CB_SS2, "ctl map");

constexpr int LDS_BYTES = 163840;
constexpr int RING_OFF = 0, XCH_OFF = 131072, MISC_OFF = 163840 - 256;

#define GAS __attribute__((address_space(1)))
#define LAS __attribute__((address_space(3)))
typedef unsigned short bf16;
typedef unsigned v4u __attribute__((ext_vector_type(4)));
typedef unsigned v2u __attribute__((ext_vector_type(2)));
typedef float f32x4 __attribute__((ext_vector_type(4)));
typedef short bf16x8 __attribute__((ext_vector_type(8)));
typedef GAS unsigned gu32;
#define RLX_AGENT __ATOMIC_RELAXED, __HIP_MEMORY_SCOPE_AGENT
#define LDS_WAIT() asm volatile("s_waitcnt lgkmcnt(0)" ::: "memory")
#define VM_WAIT() asm volatile("s_waitcnt vmcnt(0)" ::: "memory")
__device__ __forceinline__ unsigned f2bf(float f) { unsigned u = __builtin_bit_cast(unsigned, f); return (u + 0x7fffu + ((u >> 16) & 1u)) >> 16; }
__device__ __forceinline__ unsigned pk2(float lo, float hi) { return f2bf(lo) | (f2bf(hi) << 16); }
__device__ __forceinline__ float bf2f(unsigned short b) { return __builtin_bit_cast(float, (unsigned)b << 16); }
__device__ __forceinline__ float bflo(unsigned w) { return __builtin_bit_cast(float, w << 16); }
__device__ __forceinline__ float bfhi(unsigned w) { return __builtin_bit_cast(float, w & 0xffff0000u); }
__device__ __forceinline__ float sigmoidf_(float x) { return __builtin_amdgcn_rcpf(1.0f + __expf(-x)); }
__device__ __forceinline__ float siluf_(float x) { return x * sigmoidf_(x); }
__device__ __forceinline__ float gelu_tanh(float y) { const float uu = 1.5957691216057308f * (y + 0.044715f * y * y * y); return y * sigmoidf_(uu); }
__device__ __forceinline__ float ld_agent(const float* p) { return __builtin_bit_cast(float, __hip_atomic_load((const unsigned*)p, RLX_AGENT)); }
__device__ __forceinline__ void atomic_addf(float* p, float v) { (void)__hip_atomic_fetch_add(p, v, RLX_AGENT); }
__device__ __forceinline__ f32x4 mfma16(bf16x8 a, bf16x8 b, f32x4 c) { return __builtin_amdgcn_mfma_f32_16x16x32_bf16(a, b, c, 0, 0, 0); }
__device__ __forceinline__ float wave_sum(float v) {
#pragma unroll
    for (int o = 1; o < 64; o <<= 1) v += __shfl_xor(v, o);
    return v;
}

#define XB_TMO      128
#define XB_XCNT(j)  (256  + 64 * (j))
#define XB_XSUB(j)  (1280 + 64 * (j))
#define XB_XGEN(j)  (2304 + 64 * (j))
#define XB_TOP      3328
#define XB_TOPGEN   3392
#define XCD_BAR_WORDS 3456
#define XB_SPIN_CAP (1u << 18)
__device__ __forceinline__ unsigned xb_ld(unsigned* p)              { return __hip_atomic_load(p, __ATOMIC_RELAXED, __HIP_MEMORY_SCOPE_AGENT); }
__device__ __forceinline__ unsigned xb_add(unsigned* p, unsigned v) { return __hip_atomic_fetch_add(p, v, __ATOMIC_RELAXED, __HIP_MEMORY_SCOPE_AGENT); }
__device__ __forceinline__ unsigned xb_xcc_id() { return (unsigned)__builtin_amdgcn_s_getreg((3 << 11) | 20) & 0xFu; }
#define XB_SPIN(cond, bar) do { unsigned _sp = 0; while (cond) { __builtin_amdgcn_s_sleep(1); \
    if ((++_sp & 255u) == 0u) { if (xb_ld(&(bar)[XB_TMO])) break; if (_sp > XB_SPIN_CAP) { atomicAdd(&(bar)[XB_TMO], 1u); break; } } } } while (0)
struct XcdBarrier { unsigned* bar; unsigned x; volatile LAS unsigned* st; };
__device__ __forceinline__ XcdBarrier xcd_barrier_post(unsigned* bar, volatile LAS unsigned* st) {
    XcdBarrier b; b.bar = bar; b.x = xb_xcc_id(); b.st = st;
    if (threadIdx.x == 0) (void)xb_add(&bar[XB_XCNT(b.x)], 1u);
    return b;
}
__device__ __forceinline__ void xcd_barrier_complete(unsigned* bar, unsigned x, unsigned& nloc, unsigned& nx) {
    const unsigned G = gridDim.x * gridDim.y * gridDim.z;
    unsigned sum, cnt, mine, sp = 0u;
    for (;;) {
        sum = 0u; cnt = 0u; mine = 0u;
#pragma unroll
        for (unsigned j = 0; j < 16; ++j) { const unsigned c = xb_ld(&bar[XB_XCNT(j)]); sum += c; cnt += (c > 0u) ? 1u : 0u; mine = (j == x) ? c : mine; }
        if (sum == G) break;
        __builtin_amdgcn_s_sleep(1);
        if ((++sp & 255u) == 0u) { if (xb_ld(&bar[XB_TMO])) break; if (sp > XB_SPIN_CAP) { atomicAdd(&bar[XB_TMO], 1u); break; } }
    }
    nloc = mine > 0u ? mine : 1u; nx = cnt > 0u ? cnt : 1u;
}
__device__ __forceinline__ void xcd_barrier(const XcdBarrier& b) {
    asm volatile("s_waitcnt vmcnt(0)" ::: "memory");
    __syncthreads();
    if (threadIdx.x == 0) {
        unsigned* bar = b.bar;
        __builtin_amdgcn_s_waitcnt(0);
        unsigned nloc = b.st[0], nx = b.st[1];
        if (nloc == 0u) { xcd_barrier_complete(bar, b.x, nloc, nx); b.st[0] = nloc; b.st[1] = nx; }
        const unsigned old = xb_add(&bar[XB_XSUB(b.x)], 1u);
        const unsigned gen = old / nloc;
        if (old + 1u == (gen + 1u) * nloc) {
            __builtin_amdgcn_fence(__ATOMIC_RELEASE, "agent");
            asm volatile("s_waitcnt vmcnt(0)" ::: "memory");
            const unsigned og = xb_add(&bar[XB_TOP], 1u);
            const unsigned tg = og / nx;
            if (og + 1u == (tg + 1u) * nx) xb_add(&bar[XB_TOPGEN], 1u);
            else XB_SPIN(xb_ld(&bar[XB_TOPGEN]) == tg, bar);
            __builtin_amdgcn_fence(__ATOMIC_ACQUIRE, "agent");
            xb_add(&bar[XB_XGEN(b.x)], 1u);
            asm volatile("s_waitcnt vmcnt(0)" ::: "memory");
        } else {
            XB_SPIN(xb_ld(&bar[XB_XGEN(b.x)]) == gen, bar);
            __builtin_amdgcn_fence(__ATOMIC_ACQUIRE, "agent");
            asm volatile("s_waitcnt vmcnt(0)" ::: "memory");
        }
    }
    __syncthreads();
}

struct Frame {
    LAS unsigned char* lds;
    volatile LAS unsigned* MISC;
    gu32* ctl;
    int tid, lane, wave;
    int vcu, G;
    unsigned char* ws; float* out;
    const float *x_prompt, *x_sample, *st_s5r, *st_s5i, *st_hg, *st_cv, *meta, *g_mix, *w_in, *lam_re, *lam_im, *log_dt, *b_re, *b_im, *c_re, *c_im, *s5_d,
                *w_glu, *b_glu, *hg_lb, *hg_ng, *w_out, *g_ffn, *w_up, *conv_w, *conv_b, *w_down, *g_final;
};
#define EPI_ARGS const f32x4 (&acc)[2][2][4][2], const pg8::Unit& u, int wr, int wc, int fr, int fq

__device__ __forceinline__ const float* h0_src(int row, const float* xp, const float* meta, const float* xs) {
    if (row >= R_SAMP) return xs + (size_t)(row - R_SAMP) * D;
    const int n = seq_of(row), s = row - n * SEQP;
    return s < NMETA ? meta + (size_t)s * D : xp + (size_t)(n * SEQ + s - NMETA) * D;
}
__device__ __forceinline__ float* h1_dst(int row, float* out, float* h1meta) {
    if (row >= R_SAMP) return out + OFF_YS + (size_t)(row - R_SAMP) * D;
    const int n = seq_of(row), s = row - n * SEQP;
    return s < NMETA ? h1meta + (size_t)(n * NMETA + s) * D : out + (size_t)(n * SEQ + s - NMETA) * D;
}
struct EpiIn {
    bf16 *U, *Q, *V, *G; float* LF; const float* lb;
    __device__ __forceinline__ void operator()(EPI_ARGS) const {
        const int seg = u.pn >> 1, cb = (u.pn & 1) * 256 + wc * 32 + 8 * fq, row0 = u.pm * 256 + wr * 64 + fr;
        bf16* dstb = seg == 0 ? U : (seg == 1 ? Q : (seg == 3 ? V : G));
#pragma unroll
        for (int ai = 0; ai < 2; ++ai)
#pragma unroll
            for (int m = 0; m < 4; ++m) { const size_t row = (size_t)(row0 + ai * 128 + m * 16);
#pragma unroll
                for (int bj = 0; bj < 2; ++bj) { const int col = cb + bj * 128; f32x4 v0 = acc[ai][bj][m][0], v1 = acc[ai][bj][m][1];
                    if (seg == 2) {
                        const f32x4 l0 = *(const f32x4*)(lb + col), l1 = *(const f32x4*)(lb + col + 4); f32x4 o0, o1;
#pragma unroll
                        for (int j = 0; j < 4; ++j) { o0[j] = __logf(l0[j] + (1.f - l0[j]) * sigmoidf_(v0[j])); o1[j] = __logf(l1[j] + (1.f - l1[j]) * sigmoidf_(v1[j])); }
                        *(f32x4*)(LF + row * HD + col) = o0; *(f32x4*)(LF + row * HD + col + 4) = o1;
                    } else {
                        if (seg == 4) {
#pragma unroll
                            for (int j = 0; j < 4; ++j) { v0[j] = siluf_(v0[j]); v1[j] = siluf_(v1[j]); } }
                        v4u w; w.x = pk2(v0[0], v0[1]); w.y = pk2(v0[2], v0[3]); w.z = pk2(v1[0], v1[1]); w.w = pk2(v1[2], v1[3]);
                        *(v4u*)(dstb + row * HD + col) = w;
                    } } }
    }
};
struct EpiGlu {
    const bf16* Y5; const float* bias; bf16* MIX;
    __device__ __forceinline__ void operator()(EPI_ARGS) const {
        const int col0 = u.pn * 256 + wc * 32 + 8 * fq, row0 = u.pm * 256 + wr * 64 + fr;
#pragma unroll
        for (int ai = 0; ai < 2; ++ai)
#pragma unroll
            for (int m = 0; m < 4; ++m) { const size_t row = (size_t)(row0 + ai * 128 + m * 16);
#pragma unroll
                for (int bj = 0; bj < 2; ++bj) { const int col = col0 + bj * 128; const f32x4 v0 = acc[ai][bj][m][0], v1 = acc[ai][bj][m][1];
                    const f32x4 b0 = *(const f32x4*)(bias + col), b1 = *(const f32x4*)(bias + col + 4);
                    const v4u y = *(const v4u*)(Y5 + row * HD + col);
                    v4u w;
                    w.x = pk2(bflo(y.x) * sigmoidf_(v0[0] + b0[0]), bfhi(y.x) * sigmoidf_(v0[1] + b0[1]));
                    w.y = pk2(bflo(y.y) * sigmoidf_(v0[2] + b0[2]), bfhi(y.y) * sigmoidf_(v0[3] + b0[3]));
                    w.z = pk2(bflo(y.z) * sigmoidf_(v1[0] + b1[0]), bfhi(y.z) * sigmoidf_(v1[1] + b1[1]));
                    w.w = pk2(bflo(y.w) * sigmoidf_(v1[2] + b1[2]), bfhi(y.w) * sigmoidf_(v1[3] + b1[3]));
                    *(v4u*)(MIX + row * D + col) = w; } }
    }
};
struct EpiOut {
    const float *xp, *meta, *xs; float *out, *h1meta; bf16* H1B; float* ss;
    __device__ __forceinline__ void operator()(EPI_ARGS) const {
        const int col0 = u.pn * 256 + wc * 32 + 8 * fq, row0 = u.pm * 256 + wr * 64 + fr;
#pragma unroll
        for (int ai = 0; ai < 2; ++ai)
#pragma unroll
            for (int m = 0; m < 4; ++m) { const int row = row0 + ai * 128 + m * 16;
                const float* src = h0_src(row, xp, meta, xs);
                float* dst = h1_dst(row, out, h1meta);
                float s = 0.f;
#pragma unroll
                for (int bj = 0; bj < 2; ++bj) { const int col = col0 + bj * 128;
                    const f32x4 h0 = *(const f32x4*)(src + col) + acc[ai][bj][m][0], h1 = *(const f32x4*)(src + col + 4) + acc[ai][bj][m][1];
                    *(f32x4*)(dst + col) = h0; *(f32x4*)(dst + col + 4) = h1;
                    v4u w; w.x = pk2(h0[0], h0[1]); w.y = pk2(h0[2], h0[3]); w.z = pk2(h1[0], h1[1]); w.w = pk2(h1[2], h1[3]);
                    *(v4u*)(H1B + (size_t)row * D + col) = w;
                    s += (h0[0] * h0[0] + h0[1] * h0[1]) + (h0[2] * h0[2] + h0[3] * h0[3]) + (h1[0] * h1[0] + h1[1] * h1[1]) + (h1[2] * h1[2] + h1[3] * h1[3]); }
                s += __shfl_xor(s, 16); s += __shfl_xor(s, 32);
                if (fq == 0 && ss) atomic_addf(ss + row, s); }
    }
};
struct EpiUpGate {
    const float* ss; bf16* GATED; float* out; const float *conv_w, *conv_b, *st_cv; LAS float* xch;
    __device__ __forceinline__ void operator()(EPI_ARGS) const {
        const int lane = fq * 16 + fr, cl = wc * 32 + 8 * fq, col = u.pn * 128 + cl;
        const int rbase = u.pm * 254 - 2 + wr * 64 + fr;
        f32x4 cb[2], w0[2], w1[2], w2[2];
#pragma unroll
        for (int n = 0; n < 2; ++n) { cb[n] = *(const f32x4*)(conv_b + col + 4 * n); w0[n] = *(const f32x4*)(conv_w + col + 4 * n); w1[n] = *(const f32x4*)(conv_w + DFF + col + 4 * n); w2[n] = *(const f32x4*)(conv_w + 2 * DFF + col + 4 * n); }
        float rstd[2][4];
#pragma unroll
        for (int ai = 0; ai < 2; ++ai)
#pragma unroll
            for (int m = 0; m < 4; ++m) { int row = rbase + ai * 128 + m * 16; row = row < 0 ? 0 : (row >= RT ? RT - 1 : row); rstd[ai][m] = __builtin_amdgcn_rsqf(ld_agent(ss + row) * (1.0f / D) + EPS); }
        if (fr >= 14) {
#pragma unroll
            for (int ai = 0; ai < 2; ++ai)
#pragma unroll
                for (int n = 0; n < 2; ++n) *(LAS f32x4*)(xch + ((ai * 2 + wr) * 2 + (fr - 14)) * 128 + cl + 4 * n) = acc[ai][0][3][n] * rstd[ai][3];
        }
        asm volatile("s_waitcnt lgkmcnt(0)" ::: "memory"); __builtin_amdgcn_s_barrier(); asm volatile("" ::: "memory");
        const int src1 = (lane & 48) | ((fr - 1) & 15), src2 = (lane & 48) | ((fr - 2) & 15);
#pragma unroll
        for (int ai = 0; ai < 2; ++ai) {
            int pb = ai * 2 + wr - 1; pb = pb < 0 ? 0 : pb;
            f32x4 r1p[2], r2p[2];
#pragma unroll
            for (int n = 0; n < 2; ++n) { r1p[n] = *(const LAS f32x4*)(xch + (pb * 2 + 1) * 128 + cl + 4 * n); r2p[n] = *(const LAS f32x4*)(xch + (pb * 2 + (fr & 1)) * 128 + cl + 4 * n); }
#pragma unroll
            for (int m = 0; m < 4; ++m) {
                const int i = ai * 128 + wr * 64 + m * 16 + fr, row = rbase + ai * 128 + m * 16;
                f32x4 a[2], v[2], p1[2], p2[2], c1[2], c2[2];
#pragma unroll
                for (int n = 0; n < 2; ++n) { a[n] = acc[ai][0][m][n] * rstd[ai][m]; v[n] = acc[ai][1][m][n] * rstd[ai][m];
#pragma unroll
                    for (int j = 0; j < 4; ++j) { c1[n][j] = __shfl(a[n][j], src1); c2[n][j] = __shfl(a[n][j], src2); }
                    p1[n] = fr == 0 ? r1p[n] : c1[n]; p2[n] = fr < 2 ? r2p[n] : c2[n];
                    r1p[n] = c1[n]; r2p[n] = c2[n]; }
                if (i >= 2 && row < RT) {
                    float* cv = nullptr;
                    if (row >= R_SAMP) { const int sm = row - R_SAMP; const float* st = st_cv + (size_t)(sm * 2) * DFF + col;
#pragma unroll
                        for (int n = 0; n < 2; ++n) { p2[n] = *(const f32x4*)(st + 4 * n); p1[n] = *(const f32x4*)(st + DFF + 4 * n); *(f32x4*)(out + OFF_CVS + (size_t)(sm * 2) * DFF + col + 4 * n) = p1[n]; }
                        cv = out + OFF_CVS + (size_t)(sm * 2 + 1) * DFF + col;
                    } else { const int nn = seq_of(row), sq = row - nn * SEQP;
                        if (sq == 0) { p1[0] = (f32x4){0.f, 0.f, 0.f, 0.f}; p1[1] = p1[0]; }
                        if (sq <= 1) { p2[0] = (f32x4){0.f, 0.f, 0.f, 0.f}; p2[1] = p2[0]; }
                        if (sq >= SEQP - 2) cv = out + OFF_CVP + (size_t)(nn * 2 + sq - (SEQP - 2)) * DFF + col; }
                    if (cv) { *(f32x4*)cv = a[0]; *(f32x4*)(cv + 4) = a[1]; }
                    float o[8];
#pragma unroll
                    for (int n = 0; n < 2; ++n)
#pragma unroll
                        for (int j = 0; j < 4; ++j) { const float cc = cb[n][j] + w0[n][j] * p2[n][j] + w1[n][j] * p1[n][j] + w2[n][j] * a[n][j]; o[4 * n + j] = siluf_(cc) * v[n][j]; }
                    v4u w; w.x = pk2(o[0], o[1]); w.y = pk2(o[2], o[3]); w.z = pk2(o[4], o[5]); w.w = pk2(o[6], o[7]);
                    *(v4u*)(GATED + (size_t)row * DFF + col) = w; }
            }
        }
    }
};
struct EpiDown {
    float *out, *h1meta; float* ss;
    __device__ __forceinline__ void operator()(EPI_ARGS) const {
        const int col0 = u.pn * 256 + wc * 32 + 8 * fq, row0 = u.pm * 256 + wr * 64 + fr;
#pragma unroll
        for (int ai = 0; ai < 2; ++ai)
#pragma unroll
            for (int m = 0; m < 4; ++m) { const int row = row0 + ai * 128 + m * 16;
                float* dst = h1_dst(row, out, h1meta);
                float s = 0.f;
#pragma unroll
                for (int bj = 0; bj < 2; ++bj) { const int col = col0 + bj * 128;
                    const f32x4 h0 = *(const f32x4*)(dst + col) + acc[ai][bj][m][0], h1 = *(const f32x4*)(dst + col + 4) + acc[ai][bj][m][1];
                    *(f32x4*)(dst + col) = h0; *(f32x4*)(dst + col + 4) = h1;
                    s += (h0[0] * h0[0] + h0[1] * h0[1]) + (h0[2] * h0[2] + h0[3] * h0[3]) + (h1[0] * h1[0] + h1[1] * h1[1]) + (h1[2] * h1[2] + h1[3] * h1[3]); }
                s += __shfl_xor(s, 16); s += __shfl_xor(s, 32);
                if (fq == 0) atomic_addf(ss + row, s); }
    }
};
__device__ __forceinline__ void p0_transpose_item(const float* W, int K, int N, bf16* WT, const float* ksc, LAS float* scr, int item, int lane, bool upmap = false) {
    const int nblk = N / 64, kb = item / nblk, nb = item % nblk, k0 = 64 * kb, n0 = 64 * nb;
    const int d0 = !upmap ? n0 : (n0 < DFF ? 256 * (n0 >> 7) + (n0 & 127) : 256 * ((n0 - DFF) >> 7) + 128 + ((n0 - DFF) & 127));
    const int ks = lane >> 4, n4 = (lane & 15) * 4;
    f32x4 v[16]; float sc[16];
#pragma unroll
    for (int i = 0; i < 16; ++i) { const int kk = 4 * i + ks; v[i] = *(const GAS f32x4*)(W + (size_t)(k0 + kk) * N + n0 + n4); sc[i] = ksc ? ksc[k0 + kk] : 1.0f; }
#pragma unroll
    for (int i = 0; i < 16; ++i) { const int kk = 4 * i + ks; LAS float* d = scr + kk * 65 + n4; d[0] = v[i].x * sc[i]; d[1] = v[i].y * sc[i]; d[2] = v[i].z * sc[i]; d[3] = v[i].w * sc[i]; }
    LDS_WAIT(); asm volatile("" ::: "memory");
    const int c = lane & 7;
#pragma unroll
    for (int j = 0; j < 8; ++j) { const int n = (lane >> 3) + 8 * j; const LAS float* q = scr + (8 * c) * 65 + n;
        v4u o; o.x = pk2(q[0 * 65], q[1 * 65]); o.y = pk2(q[2 * 65], q[3 * 65]); o.z = pk2(q[4 * 65], q[5 * 65]); o.w = pk2(q[6 * 65], q[7 * 65]);
        *(GAS v4u*)(WT + (size_t)(d0 + n) * K + k0 + 8 * c) = o; }
    LDS_WAIT(); asm volatile("" ::: "memory");
}
template <int NR>
__device__ __forceinline__ void rms_rows_to_bf16(int lane, const float* const (&xrow)[NR], bf16* const (&orow)[NR]) {
    f32x4 v[NR][4]; float s[NR];
#pragma unroll
    for (int r = 0; r < NR; ++r) { const GAS f32x4* xr = (const GAS f32x4*)xrow[r] + lane;
#pragma unroll
        for (int j = 0; j < 4; ++j) v[r][j] = xr[64 * j]; }
#pragma unroll
    for (int r = 0; r < NR; ++r) { s[r] = 0.f;
#pragma unroll
        for (int j = 0; j < 4; ++j) s[r] += (v[r][j].x * v[r][j].x + v[r][j].y * v[r][j].y) + (v[r][j].z * v[r][j].z + v[r][j].w * v[r][j].w); }
#pragma unroll
    for (int o = 1; o < 64; o <<= 1) {
#pragma unroll
        for (int r = 0; r < NR; ++r) s[r] += __shfl_xor(s[r], o); }
#pragma unroll
    for (int r = 0; r < NR; ++r) { const float rstd = 1.0f / sqrtf(s[r] * (1.f / D) + EPS);
        GAS unsigned long long* o8 = (GAS unsigned long long*)orow[r] + lane;
#pragma unroll
        for (int j = 0; j < 4; ++j) o8[64 * j] = (unsigned long long)pk2(v[r][j].x * rstd, v[r][j].y * rstd) | ((unsigned long long)pk2(v[r][j].z * rstd, v[r][j].w * rstd) << 32); }
}
__device__ __forceinline__ void s5_precompute_item(Frame& F, int item) {
    const int g = item >> 3, b = item & 7;
    LAS float* Ap = (LAS float*)F.lds;
    LAS float* Bb = Ap + 2176;
    LAS float* Cc = Bb + 2048;
    LAS float* Kt = Cc + 2048;
    const int tid = F.tid;
    float* A1 = (float*)(F.ws + WS_S5F + S5F_A1); float* A16 = (float*)(F.ws + WS_S5F + S5F_A16); float* BBf = (float*)(F.ws + WS_S5F + S5F_BB);
    const float dt = expf(F.log_dt[g]);
    for (int idx = tid; idx < 17 * 64; idx += 512) { const int j = idx >> 6, p = idx & 63; const float lr = F.lam_re[g * 64 + p], li = F.lam_im[g * 64 + p];
        const double TWO_PI = 6.283185307179586476925286766559;
        const float mag = expf(lr * dt * (float)j);
        double rev = ((double)li * (double)dt * (double)j) / TWO_PI; rev -= rint(rev);
        const float ang = (float)(rev * TWO_PI);
        Ap[idx * 2] = mag * cosf(ang); Ap[idx * 2 + 1] = mag * sinf(ang); }
    for (int idx = tid; idx < 1024; idx += 512) { const int co = idx >> 6, p = idx & 63; Cc[idx * 2] = F.c_re[(g * 16 + co) * 64 + p]; Cc[idx * 2 + 1] = F.c_im[(g * 16 + co) * 64 + p]; }
    __syncthreads();
    for (int idx = tid; idx < 1024; idx += 512) { const int p = idx >> 4, c = idx & 15; const float lr = F.lam_re[g * 64 + p], li = F.lam_im[g * 64 + p];
        const float ar = Ap[(64 + p) * 2], ai = Ap[(64 + p) * 2 + 1];
        const float nr = ar - 1.0f, den = lr * lr + li * li, cr = (nr * lr + ai * li) / den, ci = (ai * lr - nr * li) / den;
        const float bre = F.b_re[(g * 64 + p) * 16 + c], bim = F.b_im[(g * 64 + p) * 16 + c];
        const float xr = cr * bre - ci * bim, xi = cr * bim + ci * bre;
        Bb[idx * 2] = xr; Bb[idx * 2 + 1] = xi;
        if (b == 0) { BBf[((g * 64 + p) * 16 + c) * 2] = xr; BBf[((g * 64 + p) * 16 + c) * 2 + 1] = xi;
            if (c == 0) { A1[(g * 64 + p) * 2] = ar; A1[(g * 64 + p) * 2 + 1] = ai; A16[(g * 64 + p) * 2] = Ap[(16 * 64 + p) * 2]; A16[(g * 64 + p) * 2 + 1] = Ap[(16 * 64 + p) * 2 + 1]; } } }
    __syncthreads();
    { const int jl = tid >> 8, co = (tid >> 4) & 15, ci = tid & 15, j = 2 * b + jl; float kv = 0.f;
        for (int p = 0; p < 64; ++p) { const float cr = Cc[(co * 64 + p) * 2], cim = Cc[(co * 64 + p) * 2 + 1], ar = Ap[(j * 64 + p) * 2], ai = Ap[(j * 64 + p) * 2 + 1];
            const float car = cr * ar - cim * ai, cai = cr * ai + cim * ar; kv += car * Bb[(p * 16 + ci) * 2] - cai * Bb[(p * 16 + ci) * 2 + 1]; }
        if (j == 0 && co == ci) kv += F.s5_d[g * 16 + co];
        Kt[tid] = kv; }
    __syncthreads();
    bf16* W1 = (bf16*)(F.ws + WS_S5W1) + (size_t)g * 384 * 256; bf16* W2 = (bf16*)(F.ws + WS_S5W2) + (size_t)g * 256 * 128;
    for (int idx = tid; idx < 2 * 16 * 128; idx += 512) { const int jl = idx >> 11, d = (idx >> 7) & 15, co = (idx >> 3) & 15, cp = idx & 7, j = 2 * b + jl;
        if (d + j < 16) { const int s = d, t = d + j;
            *(unsigned*)(W1 + (size_t)(t * 16 + co) * 256 + s * 16 + 2 * cp) = pk2(Kt[jl * 256 + co * 16 + 2 * cp], Kt[jl * 256 + co * 16 + 2 * cp + 1]);
            if (j >= 1) *(unsigned*)(W1 + (size_t)(s * 16 + co) * 256 + t * 16 + 2 * cp) = 0u; } }
    for (int idx = tid; idx < 16 * 128; idx += 512) { const int pp = 16 * b + (idx >> 7), k = (idx & 127) * 2, s = k >> 4, ci = k & 15, p = pp & 63;
        const float ar = Ap[((15 - s) * 64 + p) * 2], ai = Ap[((15 - s) * 64 + p) * 2 + 1];
        const float b0r = Bb[(p * 16 + ci) * 2], b0i = Bb[(p * 16 + ci) * 2 + 1], b1r = Bb[(p * 16 + ci + 1) * 2], b1i = Bb[(p * 16 + ci + 1) * 2 + 1];
        const float v0 = pp < 64 ? ar * b0r - ai * b0i : ar * b0i + ai * b0r, v1 = pp < 64 ? ar * b1r - ai * b1i : ar * b1i + ai * b1r;
        *(unsigned*)(W1 + (size_t)(256 + pp) * 256 + k) = pk2(v0, v1); }
    for (int idx = tid; idx < 32 * 64; idx += 512) { const int n = 32 * b + (idx >> 6), kq = (idx & 63) * 2, t = n >> 4, co = n & 15; float v[2];
#pragma unroll
        for (int e = 0; e < 2; ++e) { const int pp = kq + e, p = pp & 63; const float cr = Cc[(co * 64 + p) * 2], cim = Cc[(co * 64 + p) * 2 + 1], ar = Ap[((t + 1) * 64 + p) * 2], ai = Ap[((t + 1) * 64 + p) * 2 + 1];
            v[e] = pp < 64 ? (cr * ar - cim * ai) : -(cr * ai + cim * ar); }
        *(unsigned*)(W2 + (size_t)n * 128 + kq) = pk2(v[0], v[1]); }
    __syncthreads();
}
__device__ __forceinline__ void p0_prologue(Frame& F) {
    for (int it = F.vcu; it < 256; it += F.G) s5_precompute_item(F, it);
    if (F.vcu == 32 % F.G) {
        float* LB = (float*)(F.ws + WS_S5F + S5F_LB); const float a0 = F.hg_lb[F.tid], a1 = F.hg_lb[512 + F.tid], mx = fmaxf(a0, a1), e0 = expf(a0 - mx), e1 = expf(a1 - mx); LB[F.tid] = e0 / (e0 + e1); }
    LAS float* scr = (LAS float*)(F.lds + RING_OFF + F.wave * 16896);
    const int gw = F.vcu * NWAVES + F.wave, NGW = F.G * NWAVES;
    constexpr int I_IN = (D / 64) * (INC / 64), I_GLU = (HD / 64) * (HD / 64), I_OUT = (D / 64) * (D / 64), I_UP = (D / 64) * (UPC / 64), I_DN = (DFF / 64) * (D / 64);
    constexpr int NITEMS = I_IN + I_GLU + I_OUT + I_UP + I_DN;
    for (int it = gw; it < NITEMS; it += NGW) {
        int r = it;
        if (r < I_IN) { p0_transpose_item(F.w_in, D, INC, (bf16*)(F.ws + WS_WIN), F.g_mix, scr, r, F.lane); continue; } r -= I_IN;
        if (r < I_GLU) { p0_transpose_item(F.w_glu, HD, HD, (bf16*)(F.ws + WS_WGLU), nullptr, scr, r, F.lane); continue; } r -= I_GLU;
        if (r < I_OUT) { p0_transpose_item(F.w_out, D, D, (bf16*)(F.ws + WS_WOUT), nullptr, scr, r, F.lane); continue; } r -= I_OUT;
        if (r < I_UP) { p0_transpose_item(F.w_up, D, UPC, (bf16*)(F.ws + WS_WUP), F.g_ffn, scr, r, F.lane, true); continue; } r -= I_UP;
        p0_transpose_item(F.w_down, DFF, D, (bf16*)(F.ws + WS_WDN), nullptr, scr, r, F.lane);
    }
    bf16* XN = (bf16*)(F.ws + WS_XN);
    for (int m0 = gw * 4; m0 < RT; m0 += NGW * 4) {
        const float* src[4]; bf16* dst[4];
#pragma unroll
        for (int r = 0; r < 4; ++r) { const int m = m0 + r;
            src[r] = h0_src(m, F.x_prompt, F.meta, F.x_sample);
            dst[r] = XN + (size_t)m * D; }
        rms_rows_to_bf16<4>(F.lane, src, dst);
    }
}

__device__ __forceinline__ void s5_prompt_item(Frame& F, int item) {
    const int g = item & 31, n = item >> 5;
    LAS unsigned char* R1 = F.lds;
    LAS float* R2 = (LAS float*)(F.lds + 76032);
    int tid = F.tid; asm volatile("" : "+v"(tid));
    const int lane = tid & 63, w = F.wave, r = lane & 15, q = lane >> 4;
    const bf16* U = (const bf16*)(F.ws + WS_U);
#pragma unroll
    for (int i = 0; i < 9; ++i) { const int idx = tid + 512 * i, c = idx >> 5, pc = idx & 31, s = pc >> 1, half = pc & 1, cc = c < 128 ? c : 128;
        const int grow = SEQP * n + 16 * cc + s;
        const v4u val = *(const v4u*)(U + (size_t)grow * HD + 16 * g + 8 * half);
        *(LAS v4u*)(R1 + c * 528 + pc * 16) = val; }
    __syncthreads();
    const bf16* W1 = (const bf16*)(F.ws + WS_S5W1) + (size_t)g * 384 * 256; const bf16* W2 = (const bf16*)(F.ws + WS_S5W2) + (size_t)g * 256 * 128;
    f32x4 acc0[9], acc1[9], acc2[9];
#pragma unroll
    for (int mt = 0; mt < 9; ++mt) { acc0[mt] = (f32x4){0.f, 0.f, 0.f, 0.f}; acc1[mt] = acc0[mt]; acc2[mt] = acc0[mt]; }
#pragma unroll 1
    for (int kk = 0; kk < 8; ++kk) {
        const bool need0 = (2 * kk <= w);
        const bool need1 = (2 * kk <= w + 8);
        const bf16x8 b2 = *(const bf16x8*)(W1 + (size_t)(16 * (16 + w) + r) * 256 + 32 * kk + 8 * q);
        bf16x8 b0 = b2, b1 = b2;
        if (need0) b0 = *(const bf16x8*)(W1 + (size_t)(16 * w + r) * 256 + 32 * kk + 8 * q);
        if (need1) b1 = *(const bf16x8*)(W1 + (size_t)(16 * (w + 8) + r) * 256 + 32 * kk + 8 * q);
#pragma unroll
        for (int mt = 0; mt < 9; ++mt) { const bf16x8 a = *(const LAS bf16x8*)(R1 + (16 * mt + r) * 528 + (32 * kk + 8 * q) * 2);
            acc2[mt] = mfma16(a, b2, acc2[mt]);
            if (need0) acc0[mt] = mfma16(a, b0, acc0[mt]);
            if (need1) acc1[mt] = mfma16(a, b1, acc1[mt]); }
    }
#pragma unroll
    for (int mt = 0; mt < 9; ++mt)
#pragma unroll
        for (int i = 0; i < 4; ++i) R2[(16 * mt + 4 * q + i) * 132 + 16 * w + r] = acc2[mt][i];
    __syncthreads();
    if (w == 0) {
        const float* A16 = (const float*)(F.ws + WS_S5F + S5F_A16); const float ar = A16[(g * 64 + lane) * 2], ai = A16[(g * 64 + lane) * 2 + 1];
        float hr = 0.f, hi = 0.f;
        for (int c0 = 0; c0 < 136; c0 += 8) {
            float lr[8], li[8];
#pragma unroll
            for (int j = 0; j < 8; ++j) { lr[j] = R2[(c0 + j) * 132 + lane]; li[j] = R2[(c0 + j) * 132 + 64 + lane]; }
#pragma unroll
            for (int j = 0; j < 8; ++j) { const int c = c0 + j;
                if (c <= 128) {
                    *(LAS bf16*)(R1 + c * 272 + lane * 2) = (bf16)f2bf(hr); *(LAS bf16*)(R1 + c * 272 + 128 + lane * 2) = (bf16)f2bf(hi);
                    const float nr = ar * hr - ai * hi + lr[j], ni = ar * hi + ai * hr + li[j]; hr = nr; hi = ni;
                } else { *(LAS bf16*)(R1 + c * 272 + lane * 2) = 0; *(LAS bf16*)(R1 + c * 272 + 128 + lane * 2) = 0; } }
        }
#pragma unroll
        for (int c = 136; c < 144; ++c) { *(LAS bf16*)(R1 + c * 272 + lane * 2) = 0; *(LAS bf16*)(R1 + c * 272 + 128 + lane * 2) = 0; }
        F.out[OFF_S5RP + (size_t)(n * 32 + g) * 64 + lane] = hr; F.out[OFF_S5IP + (size_t)(n * 32 + g) * 64 + lane] = hi;
    }
    __syncthreads();
#pragma unroll 1
    for (int kk = 0; kk < 4; ++kk) {
        const bf16x8 b0 = *(const bf16x8*)(W2 + (size_t)(16 * w + r) * 128 + 32 * kk + 8 * q), b1 = *(const bf16x8*)(W2 + (size_t)(16 * (w + 8) + r) * 128 + 32 * kk + 8 * q);
#pragma unroll
        for (int mt = 0; mt < 9; ++mt) { const bf16x8 a = *(const LAS bf16x8*)(R1 + (16 * mt + r) * 272 + (32 * kk + 8 * q) * 2);
            acc0[mt] = mfma16(a, b0, acc0[mt]); acc1[mt] = mfma16(a, b1, acc1[mt]); }
    }
    bf16* Y5 = (bf16*)(F.ws + WS_Y5);
#pragma unroll
    for (int mt = 0; mt < 9; ++mt)
#pragma unroll
        for (int i = 0; i < 4; ++i) { const int c = 16 * mt + 4 * q + i;
            if (c <= 128) { const int rb = SEQP * n + 16 * c;
                Y5[(size_t)(rb + w) * HD + 16 * g + r] = (bf16)f2bf(gelu_tanh(acc0[mt][i]));
                Y5[(size_t)(rb + w + 8) * HD + 16 * g + r] = (bf16)f2bf(gelu_tanh(acc1[mt][i])); } }
    __syncthreads();
}
__device__ __forceinline__ void s5_sample_item(Frame& F, int item) {
    const int g = item & 31, s = item >> 5, lane = F.lane, row = R_SAMP + s;
    const bf16* U = (const bf16*)(F.ws + WS_U); bf16* Y5 = (bf16*)(F.ws + WS_Y5);
    const float* A1 = (const float*)(F.ws + WS_S5F + S5F_A1); const float* BBf = (const float*)(F.ws + WS_S5F + S5F_BB);
    const v4u u0 = *(const v4u*)(U + (size_t)row * HD + 16 * g), u1 = *(const v4u*)(U + (size_t)row * HD + 16 * g + 8);
    float uu[16]; uu[0] = bflo(u0.x); uu[1] = bfhi(u0.x); uu[2] = bflo(u0.y); uu[3] = bfhi(u0.y); uu[4] = bflo(u0.z); uu[5] = bfhi(u0.z); uu[6] = bflo(u0.w); uu[7] = bfhi(u0.w);
    uu[8] = bflo(u1.x); uu[9] = bfhi(u1.x); uu[10] = bflo(u1.y); uu[11] = bfhi(u1.y); uu[12] = bflo(u1.z); uu[13] = bfhi(u1.z); uu[14] = bflo(u1.w); uu[15] = bfhi(u1.w);
    float xr = 0.f, xi = 0.f; const float* bb = BBf + (size_t)(g * 64 + lane) * 32;
#pragma unroll
    for (int c = 0; c < 16; ++c) { xr += bb[2 * c] * uu[c]; xi += bb[2 * c + 1] * uu[c]; }
    const float ar = A1[(g * 64 + lane) * 2], ai = A1[(g * 64 + lane) * 2 + 1];
    const float h0r = F.st_s5r[(size_t)(s * 32 + g) * 64 + lane], h0i = F.st_s5i[(size_t)(s * 32 + g) * 64 + lane];
    const float hr = ar * h0r - ai * h0i + xr, hi = ar * h0i + ai * h0r + xi;
    F.out[OFF_S5RS + (size_t)(s * 32 + g) * 64 + lane] = hr; F.out[OFF_S5IS + (size_t)(s * 32 + g) * 64 + lane] = hi;
    float yk = 0.f;
#pragma unroll
    for (int co = 0; co < 16; ++co) { const float part = hr * F.c_re[(g * 16 + co) * 64 + lane] - hi * F.c_im[(g * 16 + co) * 64 + lane]; const float tot = wave_sum(part); if (lane == co) yk = tot; }
    if (lane < 16) { float uc = 0.f;
#pragma unroll
        for (int c = 0; c < 16; ++c) uc = (lane == c) ? uu[c] : uc;
        const float y = yk + F.s5_d[g * 16 + lane] * uc; Y5[(size_t)row * HD + 16 * g + lane] = (bf16)f2bf(gelu_tanh(y)); }
}
#define HG_O_QD 0
#define HG_O_KD 17408
#define HG_O_KT 34816
#define HG_O_VT 53248
#define HG_O_ATT 55552
#define HG_O_ST 64768
#define HG_O_SEG 69120
#define HG_O_DEC 71168
__device__ __forceinline__ void hgrn_prompt_item(Frame& F, int item, bool atom = true) {
    const int vs = item & 7, h = (item >> 3) & 3, n = item >> 5;
    LAS unsigned char* L = F.lds;
    int tid = F.tid; asm volatile("" : "+v"(tid));
    const int lane = tid & 63, w = F.wave, r = lane & 15, q = lane >> 4;
    const bf16* Qb = (const bf16*)(F.ws + WS_Q); const bf16* Vb = (const bf16*)(F.ws + WS_V); const float* LF = (const float*)(F.ws + WS_LF);
    bf16* OH = (bf16*)(F.ws + WS_OH); float* HSS = (float*)(F.ws + WS_CTL + CB_HSS);
    for (int i = tid; i < (9216 + 4352) / 4; i += 512) ((LAS unsigned*)(L + HG_O_ATT))[i] = 0u;
    f32x4 Sreg = (f32x4){0.f, 0.f, 0.f, 0.f};
    const int k = tid & 127, s4 = tid >> 7, tv = tid >> 3, pr = tid & 7;
    float lf[16]; unsigned short qv[16]; unsigned vv;
#define HG_LOAD(c) do { \
        _Pragma("unroll") for (int i = 0; i < 16; ++i) { const int t = 16 * s4 + i; const int row = (c) == 0 ? (t < 16 ? SEQP * n + t : -1) : SEQP * n + 16 + 64 * ((c) - 1) + t; \
            if (row >= 0) { lf[i] = LF[(size_t)row * HD + 128 * h + k]; qv[i] = Qb[(size_t)row * HD + 128 * h + k]; } else { lf[i] = 0.f; qv[i] = 0; } } \
        { const int row = (c) == 0 ? (tv < 16 ? SEQP * n + tv : -1) : SEQP * n + 16 + 64 * ((c) - 1) + tv; \
          vv = row >= 0 ? *(const unsigned*)(Vb + (size_t)row * HD + 128 * h + 16 * vs + 2 * pr) : 0u; } } while (0)
    HG_LOAD(0);
    for (int c = 0; c <= 32; ++c) {
        float bc[16]; float run = 0.f;
#pragma unroll
        for (int i = 0; i < 16; ++i) { run += lf[i]; bc[i] = run; }
        ((LAS float*)(L + HG_O_SEG))[s4 * 128 + k] = run;
        __syncthreads();
        float off = 0.f, bl = 0.f;
#pragma unroll
        for (int s = 0; s < 4; ++s) { const float v = ((LAS float*)(L + HG_O_SEG))[s * 128 + k]; bl += v; off += (s < s4) ? v : 0.f; }
        if (s4 == 0) ((LAS float*)(L + HG_O_DEC))[k] = __expf(bl);
        unsigned kp[8];
#pragma unroll
        for (int i = 0; i < 16; i += 2) { float kdl2[2];
#pragma unroll
            for (int e = 0; e < 2; ++e) { const int ii = i + e; const float b = off + bc[ii], f = __expf(lf[ii]), kk = 1.0f - f, eb = __expf(b), enb = __expf(-b);
                *(LAS bf16*)(L + HG_O_QD + (16 * s4 + ii) * 272 + k * 2) = (bf16)f2bf(bf2f(qv[ii]) * eb);
                *(LAS bf16*)(L + HG_O_KD + (16 * s4 + ii) * 272 + k * 2) = (bf16)f2bf(kk * enb);
                kdl2[e] = kk * __expf(bl - b); }
            kp[i >> 1] = pk2(kdl2[0], kdl2[1]); }
        *(LAS v4u*)(L + HG_O_KT + k * 144 + (16 * s4) * 2) = (v4u){kp[0], kp[1], kp[2], kp[3]};
        *(LAS v4u*)(L + HG_O_KT + k * 144 + (16 * s4) * 2 + 16) = (v4u){kp[4], kp[5], kp[6], kp[7]};
        *(LAS bf16*)(L + HG_O_VT + (2 * pr) * 144 + tv * 2) = (bf16)(vv & 0xffffu); *(LAS bf16*)(L + HG_O_VT + (2 * pr + 1) * 144 + tv * 2) = (bf16)(vv >> 16);
        __syncthreads();
        if (c < 32) HG_LOAD(c + 1);
        f32x4 accS;
#pragma unroll
        for (int i = 0; i < 4; ++i) accS[i] = ((LAS float*)(L + HG_O_DEC))[16 * w + 4 * q + i] * Sreg[i];
#pragma unroll
        for (int kk = 0; kk < 2; ++kk) { const bf16x8 a = *(const LAS bf16x8*)(L + HG_O_KT + (16 * w + r) * 144 + (32 * kk + 8 * q) * 2), b = *(const LAS bf16x8*)(L + HG_O_VT + r * 144 + (32 * kk + 8 * q) * 2); accS = mfma16(a, b, accS); }
#pragma unroll
        for (int rep = 0; rep < 2; ++rep) { const int idx = w + 8 * rep;
            if (idx < 10) { const int ti = idx < 1 ? 0 : (idx < 3 ? 1 : (idx < 6 ? 2 : 3)), sj = idx - (ti * (ti + 1)) / 2;
                f32x4 at = (f32x4){0.f, 0.f, 0.f, 0.f};
#pragma unroll
                for (int kk = 0; kk < 4; ++kk) { const bf16x8 a = *(const LAS bf16x8*)(L + HG_O_QD + (16 * ti + r) * 272 + (32 * kk + 8 * q) * 2), b = *(const LAS bf16x8*)(L + HG_O_KD + (16 * sj + r) * 272 + (32 * kk + 8 * q) * 2); at = mfma16(a, b, at); }
#pragma unroll
                for (int i = 0; i < 4; ++i) { const int t = 16 * ti + 4 * q + i, s = 16 * sj + r; *(LAS bf16*)(L + HG_O_ATT + t * 144 + s * 2) = (bf16)f2bf(s <= t ? at[i] : 0.f); } } }
        f32x4 o = (f32x4){0.f, 0.f, 0.f, 0.f};
        if (w < 4) {
#pragma unroll
            for (int kk = 0; kk < 4; ++kk) { const bf16x8 a = *(const LAS bf16x8*)(L + HG_O_QD + (16 * w + r) * 272 + (32 * kk + 8 * q) * 2), b = *(const LAS bf16x8*)(L + HG_O_ST + r * 272 + (32 * kk + 8 * q) * 2); o = mfma16(a, b, o); } }
        __syncthreads();
        Sreg = accS;
        *(LAS v2u*)(L + HG_O_ST + r * 272 + (16 * w + 4 * q) * 2) = (v2u){pk2(Sreg[0], Sreg[1]), pk2(Sreg[2], Sreg[3])};
        if (w < 4) {
#pragma unroll
            for (int kk = 0; kk < 2; ++kk) { const bf16x8 a = *(const LAS bf16x8*)(L + HG_O_ATT + (16 * w + r) * 144 + (32 * kk + 8 * q) * 2), b = *(const LAS bf16x8*)(L + HG_O_VT + r * 144 + (32 * kk + 8 * q) * 2); o = mfma16(a, b, o); }
#pragma unroll
            for (int i = 0; i < 4; ++i) { const int t = 16 * w + 4 * q + i; const int row = c == 0 ? (t < 16 ? SEQP * n + t : -1) : SEQP * n + 16 + 64 * (c - 1) + t;
                float ss = o[i] * o[i]; ss += __shfl_xor(ss, 1); ss += __shfl_xor(ss, 2); ss += __shfl_xor(ss, 4); ss += __shfl_xor(ss, 8);
                if (row >= 0) { OH[(size_t)row * HD + 128 * h + 16 * vs + r] = (bf16)f2bf(o[i]); if (r == 0 && atom) atomic_addf(HSS + (size_t)row * 4 + h, ss); } } }
        __syncthreads();
    }
#undef HG_LOAD
#pragma unroll
    for (int i = 0; i < 4; ++i) F.out[OFF_HGP + ((size_t)(n * 4 + h) * 128 + 16 * w + 4 * q + i) * 128 + 16 * vs + r] = Sreg[i];
}
__device__ __forceinline__ void hgrn_sample_item(Frame& F, int item, bool atom = true) {
    const int h = item & 3, s = item >> 2, row = R_SAMP + s, tid = F.tid, vq = tid & 31, kg = tid >> 5;
    const bf16* Qb = (const bf16*)(F.ws + WS_Q); const bf16* Vb = (const bf16*)(F.ws + WS_V); const float* LF = (const float*)(F.ws + WS_LF);
    bf16* OH = (bf16*)(F.ws + WS_OH); float* HSS = (float*)(F.ws + WS_CTL + CB_HSS);
    LAS float* red = (LAS float*)F.lds;
    const v2u vw = *(const v2u*)(Vb + (size_t)row * HD + 128 * h + 4 * vq);
    const f32x4 v4 = (f32x4){bflo(vw.x), bfhi(vw.x), bflo(vw.y), bfhi(vw.y)};
    f32x4 o4 = (f32x4){0.f, 0.f, 0.f, 0.f};
#pragma unroll
    for (int i = 0; i < 8; ++i) { const int k = 8 * kg + i; const float f = __expf(LF[(size_t)row * HD + 128 * h + k]), kk = 1.0f - f, qk = bf2f(Qb[(size_t)row * HD + 128 * h + k]);
        const size_t off = ((size_t)(s * 4 + h) * 128 + k) * 128 + 4 * vq;
        const f32x4 sn = *(const f32x4*)(F.st_hg + off) * f + v4 * kk;
        *(f32x4*)(F.out + OFF_HGS + off) = sn; o4 += sn * qk; }
    *(LAS f32x4*)(red + kg * 128 + 4 * vq) = o4;
    __syncthreads();
    if (tid < 128) { float o = 0.f;
#pragma unroll
        for (int j = 0; j < 16; ++j) o += red[j * 128 + tid];
        OH[(size_t)row * HD + 128 * h + tid] = (bf16)f2bf(o);
        const float ss = wave_sum(o * o); if (F.lane == 0 && atom) atomic_addf(HSS + (size_t)row * 4 + h, ss); }
    __syncthreads();
}
__device__ __forceinline__ void hgrn_finalize(Frame& F) {
    const bf16* OH = (const bf16*)(F.ws + WS_OH); const bf16* G = (const bf16*)(F.ws + WS_G); const float* HSS = (const float*)(F.ws + WS_CTL + CB_HSS); bf16* MIX = (bf16*)(F.ws + WS_MIX);
    const int gt = F.vcu * 512 + F.tid, NT = F.G * 512;
    for (int idx = gt; idx < RT * 64; idx += NT) { const int row = idx >> 6, c8 = (idx & 63) * 8;
        const float rstd = __builtin_amdgcn_rsqf(ld_agent(HSS + (size_t)row * 4 + (c8 >> 7)) * (1.0f / 128.0f) + EPS);
        const v4u o = *(const v4u*)(OH + (size_t)row * HD + c8), gg = *(const v4u*)(G + (size_t)row * HD + c8);
        const f32x4 n0 = *(const f32x4*)(F.hg_ng + c8), n1 = *(const f32x4*)(F.hg_ng + c8 + 4);
        v4u w;
        w.x = pk2(bflo(o.x) * rstd * n0[0] * bflo(gg.x), bfhi(o.x) * rstd * n0[1] * bfhi(gg.x));
        w.y = pk2(bflo(o.y) * rstd * n0[2] * bflo(gg.y), bfhi(o.y) * rstd * n0[3] * bfhi(gg.y));
        w.z = pk2(bflo(o.z) * rstd * n1[0] * bflo(gg.z), bfhi(o.z) * rstd * n1[1] * bfhi(gg.z));
        w.w = pk2(bflo(o.w) * rstd * n1[2] * bflo(gg.w), bfhi(o.w) * rstd * n1[3] * bfhi(gg.w));
        *(v4u*)(MIX + (size_t)row * D + 512 + c8) = w; }
}
__device__ __forceinline__ void final_norm(Frame& F) {
    const float* SS3 = (const float*)(F.ws + WS_CTL + CB_SS3);
    const int gw = F.vcu * NWAVES + F.wave, NGW = F.G * NWAVES;
    for (int row = gw; row < RT; row += NGW) {
        if (row < R_SAMP && row - seq_of(row) * SEQP < NMETA) continue;
        float* p = h1_dst(row, F.out, nullptr);
        const float rstd = __builtin_amdgcn_rsqf(ld_agent(SS3 + row) * (1.0f / D) + EPS);
#pragma unroll
        for (int j = 0; j < 4; ++j) { const int c = 4 * F.lane + 256 * j; f32x4 v = *(const f32x4*)(p + c); const f32x4 gg = *(const f32x4*)(F.g_final + c); v = v * rstd * gg; *(f32x4*)(p + c) = v; } }
}
#ifndef MK_N_LAUNCHES
#define MK_N_LAUNCHES 1
#endif
constexpr int N_LAUNCHES = MK_N_LAUNCHES;
constexpr int PER_PHASE = 9;
struct Args { const float* in[28]; float* out; unsigned char* ws; int ph_lo, ph_hi, li, pad; };
__global__ void __launch_bounds__(NWAVES * 64, 2) hymba_fwd(Args args) {
    extern __shared__ __attribute__((aligned(16))) unsigned char lds[];
    Frame F;
    F.lds = (LAS unsigned char*)lds;
    F.MISC = (volatile LAS unsigned*)(F.lds + MISC_OFF);
    F.tid = threadIdx.x; F.lane = F.tid & 63; F.wave = __builtin_amdgcn_readfirstlane(F.tid >> 6);
    F.G = gridDim.x; { const int bx = blockIdx.x; F.vcu = (F.G % 8 == 0) ? (bx % 8) * (F.G / 8) + bx / 8 : bx; }
    F.ws = args.ws; F.out = args.out; F.ctl = (gu32*)(args.ws + WS_CTL);
    F.x_prompt = args.in[0]; F.x_sample = args.in[1]; F.st_s5r = args.in[2]; F.st_s5i = args.in[3]; F.st_hg = args.in[4]; F.st_cv = args.in[5]; F.meta = args.in[6];
    F.g_mix = args.in[7]; F.w_in = args.in[8]; F.lam_re = args.in[9]; F.lam_im = args.in[10]; F.log_dt = args.in[11]; F.b_re = args.in[12]; F.b_im = args.in[13];
    F.c_re = args.in[14]; F.c_im = args.in[15]; F.s5_d = args.in[16]; F.w_glu = args.in[17]; F.b_glu = args.in[18]; F.hg_lb = args.in[19]; F.hg_ng = args.in[20];
    F.w_out = args.in[21]; F.g_ffn = args.in[22]; F.w_up = args.in[23]; F.conv_w = args.in[24]; F.conv_b = args.in[25]; F.w_down = args.in[26]; F.g_final = args.in[27];
    for (int u = F.tid; u < 64; u += NWAVES * 64) ((LAS unsigned*)(F.lds + MISC_OFF))[u] = 0u;
    __syncthreads();
    XcdBarrier bar; bar.bar = (unsigned*)(F.ctl + CW_BAR); bar.x = 0; bar.st = nullptr;
    if (N_LAUNCHES != PER_PHASE) bar = xcd_barrier_post((unsigned*)(F.ctl + CW_BAR), F.MISC + 8);
#define GRID_BAR() do { if (N_LAUNCHES != PER_PHASE) xcd_barrier(bar); } while (0)
    const int lo = args.ph_lo, hi = args.ph_hi;
#ifndef P2_MASK
#define P2_MASK 15
#endif
#ifndef PH_MASK
#define PH_MASK 0x1ff
#endif
#define IN(k) (((PH_MASK >> (k)) & 1) && lo <= (k) && (k) < hi)
#define BOTH(k) (IN(k) && IN((k) + 1))
    const int gw = F.vcu * NWAVES + F.wave, NGW = F.G * NWAVES;
    bf16* XN = (bf16*)(F.ws + WS_XN);

#if defined(PROBE_DUP) && (PROBE_DUP & 0x0f) == 0
    if (IN(0)) { p0_prologue(F); __syncthreads(); }
#endif
    if (IN(0)) { p0_prologue(F); if (BOTH(0)) GRID_BAR(); }
    if (IN(1)) {
        pg8::Gemm g{XN, (const bf16*)(F.ws + WS_WIN), RT, INC, D, D, 256}; pg8::StaticOrder S; S.init(RT, INC, F.G, (int)blockIdx.x);
        EpiIn E{(bf16*)(F.ws + WS_U), (bf16*)(F.ws + WS_Q), (bf16*)(F.ws + WS_V), (bf16*)(F.ws + WS_G), (float*)(F.ws + WS_LF), (const float*)(F.ws + WS_S5F + S5F_LB)};
#if defined(PROBE_DUP) && (PROBE_DUP & 0x0f) == 1
        pg8::gemm_phase<EpiIn, true>(F.lds + RING_OFF, g, S, E);
#endif
        pg8::gemm_phase<EpiIn, true>(F.lds + RING_OFF, g, S, E);
        if (BOTH(1)) GRID_BAR();
    }
#if defined(PROBE_DUP) && (PROBE_DUP & 0x0f) == 2
    if (IN(2)) {
        if (PROBE_DUP & 0x10) for (int it = F.vcu; it < NB * 32; it += F.G) s5_prompt_item(F, it);
        if (PROBE_DUP & 0x20) for (int it = F.vcu; it < NB * 4 * 8; it += F.G) hgrn_prompt_item(F, it, false);
        if (PROBE_DUP & 0x40) for (int it = gw; it < NS * 32; it += NGW) s5_sample_item(F, it);
        if (PROBE_DUP & 0x80) for (int it = F.vcu; it < NS * 4; it += F.G) hgrn_sample_item(F, it, false);
    }
#endif
    if (IN(2)) {
        if (P2_MASK & 1) for (int it = F.vcu; it < NB * 32; it += F.G) s5_prompt_item(F, it);
        if (P2_MASK & 2) for (int it = F.vcu; it < NB * 4 * 8; it += F.G) hgrn_prompt_item(F, it);
        if (P2_MASK & 4) for (int it = gw; it < NS * 32; it += NGW) s5_sample_item(F, it);
        if (P2_MASK & 8) for (int it = F.vcu; it < NS * 4; it += F.G) hgrn_sample_item(F, it);
        if (BOTH(2)) GRID_BAR();
    }
    if (IN(3)) {
        hgrn_finalize(F);
        pg8::Gemm g{(const bf16*)(F.ws + WS_Y5), (const bf16*)(F.ws + WS_WGLU), RT, HD, HD, HD, 256}; pg8::StaticOrder S; S.init(RT, HD, F.G, (int)blockIdx.x);
        EpiGlu E{(const bf16*)(F.ws + WS_Y5), F.b_glu, (bf16*)(F.ws + WS_MIX)};
#if defined(PROBE_DUP) && (PROBE_DUP & 0x0f) == 3
        hgrn_finalize(F);
        pg8::gemm_phase<EpiGlu, true>(F.lds + RING_OFF, g, S, E);
#endif
        pg8::gemm_phase<EpiGlu, true>(F.lds + RING_OFF, g, S, E);
        if (BOTH(3)) GRID_BAR();
    }
    if (IN(4)) {
        pg8::Gemm g{(const bf16*)(F.ws + WS_MIX), (const bf16*)(F.ws + WS_WOUT), RT, D, D, D, 256}; pg8::StaticOrder S; S.init(RT, D, F.G, (int)blockIdx.x);
        EpiOut E{F.x_prompt, F.meta, F.x_sample, F.out, (float*)(F.ws + WS_H1META), XN, (float*)(F.ws + WS_CTL + CB_SS2)};
#if defined(PROBE_DUP) && (PROBE_DUP & 0x0f) == 4
        { EpiOut E2 = E; E2.ss = nullptr; pg8::gemm_phase<EpiOut, true>(F.lds + RING_OFF, g, S, E2); }
#endif
        pg8::gemm_phase<EpiOut, true>(F.lds + RING_OFF, g, S, E);
        if (BOTH(4)) GRID_BAR();
    }
    if (IN(5)) {
        pg8::Gemm g{XN - 2 * D, (const bf16*)(F.ws + WS_WUP), 66 * 256, UPC, D, D, 254}; pg8::StaticOrder S; S.init(66 * 256, UPC, F.G, (int)blockIdx.x);
        EpiUpGate E{(const float*)(F.ws + WS_CTL + CB_SS2), (bf16*)(F.ws + WS_GATED), F.out, F.conv_w, F.conv_b, F.st_cv, (LAS float*)(F.lds + XCH_OFF)};
#if defined(PROBE_DUP) && (PROBE_DUP & 0x0f) == 5
        pg8::gemm_phase<EpiUpGate, true>(F.lds + RING_OFF, g, S, E);
#endif
        pg8::gemm_phase<EpiUpGate, true>(F.lds + RING_OFF, g, S, E);
        if (BOTH(5)) GRID_BAR();
    }
    if (IN(6)) { }
    if (IN(7)) {
        pg8::Gemm g{(const bf16*)(F.ws + WS_GATED), (const bf16*)(F.ws + WS_WDN), RT, D, DFF, DFF, 256}; pg8::StaticOrder S; S.init(RT, D, F.G, (int)blockIdx.x);
        EpiDown E{F.out, (float*)(F.ws + WS_H1META), (float*)(F.ws + WS_CTL + CB_SS3)};
        pg8::gemm_phase<EpiDown, true>(F.lds + RING_OFF, g, S, E);
        if (BOTH(7)) GRID_BAR();
    }
    if (IN(8)) final_norm(F);
#undef IN
#undef BOTH
#undef GRID_BAR
}

extern "C" void kernel_launch(void* const* d_in, const int* in_sizes, int n_in, void* d_out, int out_size, void* d_ws, size_t ws_size, hipStream_t stream) {
    static int grid = 0;
    if (grid == 0) {
        if (n_in != 28 || out_size != (int)OUT_TOTAL || ws_size < WS_END) { fprintf(stderr, "kernel_launch: unexpected problem (n_in %d, out %d, ws %zu); nothing launched\n", n_in, out_size, ws_size); grid = -1; return; }
        int dev = 0, cus = 0, per_cu = 0;
        if (hipGetDevice(&dev) != hipSuccess || hipDeviceGetAttribute(&cus, hipDeviceAttributeMultiprocessorCount, dev) != hipSuccess) { fprintf(stderr, "kernel_launch: device query failed\n"); grid = -1; return; }
        if (hipFuncSetAttribute((const void*)hymba_fwd, hipFuncAttributeMaxDynamicSharedMemorySize, LDS_BYTES) != hipSuccess) { fprintf(stderr, "kernel_launch: hipFuncSetAttribute failed\n"); grid = -1; return; }
        if (hipOccupancyMaxActiveBlocksPerMultiprocessor(&per_cu, (const void*)hymba_fwd, NWAVES * 64, LDS_BYTES) != hipSuccess || per_cu < 1)
            fprintf(stderr, "kernel_launch: note: occupancy query reports %d workgroups per CU\n", per_cu);
        (void)hipGetLastError();
        grid = cus;
    }
    if (grid < 0) return;
    if (hipMemsetAsync((char*)d_ws + WS_CTL, 0, CTL_ZERO_BYTES, stream) != hipSuccess) { fprintf(stderr, "kernel_launch: hipMemsetAsync failed\n"); return; }
    Args a{};
    for (int i = 0; i < 28; ++i) a.in[i] = (const float*)d_in[i];
    a.out = (float*)d_out; a.ws = (unsigned char*)d_ws;
    for (int li = 0; li < N_LAUNCHES; ++li) {
        a.ph_lo = (N_LAUNCHES == PER_PHASE) ? li : 0; a.ph_hi = (N_LAUNCHES == PER_PHASE) ? li + 1 : PER_PHASE; a.li = li;
        hipLaunchKernelGGL(hymba_fwd, dim3(grid), dim3(NWAVES * 64), LDS_BYTES, stream, a);
        const hipError_t le = hipPeekAtLastError();
        if (le != hipSuccess) { fprintf(stderr, "kernel_launch: launch %d failed: %s\n", li, hipGetErrorName(le)); break; }
    }
}
```

```cpp
#include <hip/hip_runtime.h>
#include <cstdio>
#include <cstdint>
#define MK_N_LAUNCHES 1
namespace pg8 {
#define PG8_LAS __attribute__((address_space(3)))
typedef unsigned short bf16_t;
typedef short bf16x8 __attribute__((ext_vector_type(8)));
typedef float f32x4 __attribute__((ext_vector_type(4)));
typedef unsigned u32x4 __attribute__((ext_vector_type(4)));
typedef unsigned u32x2 __attribute__((ext_vector_type(2)));
constexpr int BM = 256, BK = 64, HALF = 128, HTB = HALF * BK * 2  , STAGE_BYTES = 8 * HTB, NXCD = 8, WGM = 8;

__host__ __device__ __forceinline__ int lds_byte(int r, int c) { const int st = (r >> 4) * 2 + (c >> 5), rr = r & 15, cc = c & 31, ob = rr * 64 + cc * 2; return st * 1024 + (ob ^ (((ob >> 9) & 1) << 5)); }
__host__ __device__ __forceinline__ void stage_rc(int b, int& R, int& C) { const int st = b / 1024, sb = b % 1024, swz = sb ^ (((sb >> 9) & 1) << 5); R = (st >> 1) * 16 + swz / 64; C = (st & 1) * 32 + (swz % 64) / 2; }
__host__ __device__ __forceinline__ int perm32(int rho) { const int n = rho >> 4, i = rho & 15; return 8 * (i >> 2) + 4 * n + (i & 3); }

struct Unit { int pm, pn; };
struct Gemm { const bf16_t* A; const bf16_t* Bt; int M, N, K, lda, a_tile_rows; };

struct StaticOrder {
    int nM, nN, nwg, G, c;
    __host__ __device__ void init(int M, int N, int G_, int c_) { nM = M / BM; nN = N / BM; nwg = nM * nN; G = G_; c = c_; }
    __host__ __device__ bool next(int i, Unit& u) const {
        const long L = (long)i * G + c; if (L >= nwg) return false;
        int wgid = (int)L; { const int q = nwg / NXCD, r = nwg % NXCD, xcd = wgid % NXCD, off = wgid / NXCD; wgid = (xcd < r ? xcd * (q + 1) : r * (q + 1) + (xcd - r) * q) + off; }
        const int nig = WGM * nN, gid = wgid / nig, fm = gid * WGM, gsz = (nM - fm) < WGM ? (nM - fm) : WGM;
        u.pm = fm + ((wgid % nig) % gsz); u.pn = (wgid % nig) / gsz; return true;
    }
};

__device__ __forceinline__ unsigned cvt_pk_bf16(float lo, float hi) { unsigned r; asm volatile("v_cvt_pk_bf16_f32 %0, %1, %2" : "=v"(r) : "v"(lo), "v"(hi)); return r; }

template <class Epi, bool ALIGN_EPI>
__device__ __forceinline__ void gemm_phase(PG8_LAS unsigned char* lds, const Gemm g, const StaticOrder& S, const Epi& E) {
    const int tid = threadIdx.x, wid = __builtin_amdgcn_readfirstlane(tid >> 6), lane = tid & 63, wr = wid >> 2, wc = wid & 3, fr = lane & 15, fq = lane >> 4;
    const int K = g.K, nt = K / BK, lda = g.lda;
    unsigned voffA[2], voffB[2];
#pragma unroll
    for (int i = 0; i < 2; ++i) { int R, C; stage_rc(tid * 16 + i * 8192, R, C); const int Rb = (R & ~31) + perm32(R & 31);
        voffA[i] = (unsigned)(R * lda + C) * 2u; voffB[i] = (unsigned)(Rb * K + C) * 2u; }
    const size_t kstep = (size_t)(BK * 2);
    const size_t hstepA = (size_t)HALF * lda * 2, hstepB = (size_t)HALF * K * 2;
    const size_t tstepA = (size_t)g.a_tile_rows * lda * 2, tstepB = 2 * hstepB;
    const unsigned ldsw = (unsigned)wid * 1024u;
    const int aoff = lds_byte(wr * 64 + fr, fq * 8), boff = lds_byte(wc * 32 + fr, fq * 8);
#define PG8_SA(b, h) (((b) * 2 + (h)) * HTB)
#define PG8_SB(b, h) ((4 + (b) * 2 + (h)) * HTB)
#define PG8_STAGE(bufoff, gbase, voff) do { _Pragma("unroll") for (int _i = 0; _i < 2; ++_i) \
        __builtin_amdgcn_global_load_lds((const unsigned*)((const char*)(gbase) + (voff)[_i]), (PG8_LAS unsigned*)(lds + (bufoff) + ldsw + _i * 8192), 16, 0, 0); } while (0)
#define PG8_LDA(dst, b, h) do { _Pragma("unroll") for (int m = 0; m < 4; ++m) _Pragma("unroll") for (int k = 0; k < 2; ++k) dst[m][k] = *(const PG8_LAS bf16x8*)(lds + PG8_SA(b, h) + aoff + m * 2048 + k * 1024); } while (0)
#define PG8_LDB(dst, b, h) do { _Pragma("unroll") for (int n = 0; n < 2; ++n) _Pragma("unroll") for (int k = 0; k < 2; ++k) dst[n][k] = *(const PG8_LAS bf16x8*)(lds + PG8_SB(b, h) + boff + n * 2048 + k * 1024); } while (0)
#define PG8_MMA(ai, bj, At, Bt) do { __builtin_amdgcn_s_setprio(1); _Pragma("unroll") for (int m = 0; m < 4; ++m) _Pragma("unroll") for (int n = 0; n < 2; ++n) _Pragma("unroll") for (int k = 0; k < 2; ++k) \
        acc[ai][bj][m][n] = __builtin_amdgcn_mfma_f32_16x16x32_bf16(Bt[n][k], At[m][k], acc[ai][bj][m][n], 0, 0, 0); __builtin_amdgcn_s_setprio(0); } while (0)
#define PG8_WAIT_V(n) asm volatile("s_waitcnt vmcnt(" #n ")" ::: "memory")
#define PG8_WAIT_L(n) asm volatile("s_waitcnt lgkmcnt(" #n ")" ::: "memory")
#define PG8_BAR __builtin_amdgcn_s_barrier()
#define PG8_SCHED __builtin_amdgcn_sched_barrier(0)
    Unit cur, nxt; int ui = 0;
    if (!S.next(0, cur)) return;
    f32x4 acc[2][2][4][2];
#pragma unroll
    for (int a = 0; a < 2; ++a)
#pragma unroll
        for (int b = 0; b < 2; ++b)
#pragma unroll
            for (int m = 0; m < 4; ++m)
#pragma unroll
                for (int n = 0; n < 2; ++n) acc[a][b][m][n] = (f32x4){0.f, 0.f, 0.f, 0.f};
    bf16x8 At[4][2], B0[2][2], B1[2][2];
    const char* cA = (const char*)g.A + (size_t)cur.pm * tstepA; const char* cB = (const char*)g.Bt + (size_t)cur.pn * tstepB;
    PG8_STAGE(PG8_SB(0, 0), cB, voffB); PG8_STAGE(PG8_SB(0, 1), cB + hstepB, voffB); PG8_STAGE(PG8_SA(0, 0), cA, voffA); PG8_STAGE(PG8_SA(0, 1), cA + hstepA, voffA);
    if (wr == 1) PG8_BAR;
    PG8_WAIT_V(2); PG8_BAR;
    PG8_STAGE(PG8_SB(1, 0), cB + kstep, voffB); PG8_STAGE(PG8_SA(1, 0), cA + kstep, voffA); PG8_STAGE(PG8_SB(1, 1), cB + hstepB + kstep, voffB);
    PG8_WAIT_V(6); PG8_BAR;
    for (;;) {
        const bool has_next = S.next(ui + 1, nxt);
        const char* nA = has_next ? (const char*)g.A + (size_t)nxt.pm * tstepA : cA; const char* nB = has_next ? (const char*)g.Bt + (size_t)nxt.pn * tstepB : cB;
        for (int t = 0; t < nt; t += 2) {
            const bool last = (t == nt - 2);
            const char* a1 = cA + (size_t)(t + 1) * kstep;
            const char* a2 = last ? nA : cA + (size_t)(t + 2) * kstep; const char* b2 = last ? nB : cB + (size_t)(t + 2) * kstep;
            const char* a3 = a2 + kstep; const char* b3 = b2 + kstep;
            PG8_LDB(B0, 0, 0); PG8_LDB(B1, 0, 1); PG8_SCHED; PG8_LDA(At, 0, 0); PG8_STAGE(PG8_SA(1, 1), a1 + hstepA, voffA);
            PG8_WAIT_V(8); PG8_WAIT_L(0); PG8_BAR; PG8_MMA(0, 0, At, B0); PG8_MMA(0, 1, At, B1); PG8_BAR; PG8_SCHED;
            PG8_LDA(At, 0, 1); PG8_STAGE(PG8_SB(0, 0), b2, voffB); PG8_STAGE(PG8_SB(0, 1), b2 + hstepB, voffB); PG8_STAGE(PG8_SA(0, 0), a2, voffA);
            PG8_WAIT_V(8); PG8_WAIT_L(0); PG8_BAR; PG8_MMA(1, 0, At, B0); PG8_MMA(1, 1, At, B1); PG8_BAR; PG8_SCHED;
            PG8_LDB(B0, 1, 0); PG8_LDB(B1, 1, 1); PG8_SCHED; PG8_LDA(At, 1, 0); PG8_STAGE(PG8_SA(0, 1), a2 + hstepA, voffA);
            PG8_WAIT_V(8); PG8_WAIT_L(0); PG8_BAR; PG8_MMA(0, 0, At, B0); PG8_MMA(0, 1, At, B1); PG8_BAR; PG8_SCHED;
            PG8_LDA(At, 1, 1); PG8_STAGE(PG8_SB(1, 0), b3, voffB); PG8_STAGE(PG8_SB(1, 1), b3 + hstepB, voffB); PG8_STAGE(PG8_SA(1, 0), a3, voffA);
            PG8_WAIT_V(8); PG8_WAIT_L(0); PG8_BAR; PG8_MMA(1, 0, At, B0); PG8_MMA(1, 1, At, B1); PG8_BAR; PG8_SCHED;
        }
        if constexpr (ALIGN_EPI) { if (wr == 0) PG8_BAR; }
        E(acc, cur, wr, wc, fr, fq);
        if (!has_next) break;
#pragma unroll
        for (int a = 0; a < 2; ++a)
#pragma unroll
            for (int b = 0; b < 2; ++b)
#pragma unroll
                for (int m = 0; m < 4; ++m)
#pragma unroll
                    for (int n = 0; n < 2; ++n) acc[a][b][m][n] = (f32x4){0.f, 0.f, 0.f, 0.f};
        cur = nxt; cA = nA; cB = nB; ++ui;
        if constexpr (ALIGN_EPI) { if (wr == 1) PG8_BAR; }
    }
    PG8_WAIT_V(0);
    if constexpr (!ALIGN_EPI) { if (wr == 0) PG8_BAR; }
    PG8_BAR;
#undef PG8_SA
#undef PG8_SB
#undef PG8_STAGE
#undef PG8_LDA
#undef PG8_LDB
#undef PG8_MMA
#undef PG8_WAIT_V
#undef PG8_WAIT_L
#undef PG8_BAR
#undef PG8_SCHED
}
}
using pg8::bf16x8;
constexpr int NWAVES = 8;
constexpr int D = 1024, NB = 8, SEQ = 2048, NMETA = 16, NS = 128;
constexpr int RT = 16640;
constexpr int SEQP = 2064, R_SAMP = 16512;
__device__ __forceinline__ int seq_of(int r) { return (int)__umulhi((unsigned)r, 2080903u); }
constexpr int HD = 512;
constexpr int INC = 2560, DFF = 2816, UPC = 5632;
constexpr float EPS = 1e-6f;
constexpr size_t OFF_YP = 0, OFF_YS = 16777216, OFF_S5RP = 16908288, OFF_S5IP = 16924672, OFF_HGP = 16941056, OFF_CVP = 17465344,
                 OFF_S5RS = 17510400, OFF_S5IS = 17772544, OFF_HGS = 18034688, OFF_CVS = 26423296, OUT_TOTAL = 27144192;
constexpr size_t KiB = 1024, MiB = 1u << 20;
constexpr size_t WS_CTL = 0, CTL_ZERO_BYTES = 1 * MiB;
constexpr int CW_BAR = 4096;
constexpr size_t CB_SS2 = 64 * KiB, CB_SS3 = 192 * KiB, CB_HSS = 512 * KiB;
constexpr size_t WS_WIN = 2 * MiB, WS_WGLU = 7 * MiB, WS_WOUT = 7 * MiB + 512 * KiB, WS_WUP = 9 * MiB + 512 * KiB, WS_WDN = 20 * MiB + 512 * KiB;
constexpr size_t WS_S5W1 = 26 * MiB, WS_S5W2 = 32 * MiB, WS_S5F = 34 * MiB;
constexpr size_t S5F_A1 = 0, S5F_A16 = 16 * KiB, S5F_BB = 64 * KiB, S5F_LB = 384 * KiB;
constexpr size_t WS_H1META = 35 * MiB;
constexpr size_t WS_XN = 36 * MiB;
constexpr size_t ROWS512_BF16 = (size_t)RT * 512 * 2;
constexpr size_t WS_U = 68 * MiB + 512 * KiB, WS_Q = WS_U + ROWS512_BF16, WS_V = WS_Q + ROWS512_BF16, WS_G = WS_V + ROWS512_BF16, WS_LF = WS_G + ROWS512_BF16,
                 WS_Y5 = WS_LF + 2 * ROWS512_BF16, WS_OH = WS_Y5 + ROWS512_BF16, WS_MIX = WS_OH + ROWS512_BF16, WS_ZEND = WS_MIX + 2 * ROWS512_BF16;
constexpr size_t WS_GATED = WS_U;
constexpr size_t WS_END = 256 * MiB;
static_assert(WS_ZEND <= WS_END && WS_GATED + (size_t)RT * DFF * 2 <= WS_MIX && WS_XN + (size_t)RT * D * 2 <= WS_U, "d_ws map");
static_assert(CB_HSS + (size_t)RT * 4 * 4 <= CTL_ZERO_BYTES && CB_SS3 + RT * 4 <= CB_HSS && CB_SS2 + RT * 4 <= CB_SS3 && (CW_BAR + 3456) * 4 <= (int)CB_SS2, "ctl map");

constexpr int LDS_BYTES = 163840;
constexpr int RING_OFF = 0, XCH_OFF = 131072, MISC_OFF = 163840 - 256;

#define GAS __attribute__((address_space(1)))
#define LAS __attribute__((address_space(3)))
typedef unsigned short bf16;
typedef unsigned v4u __attribute__((ext_vector_type(4)));
typedef unsigned v2u __attribute__((ext_vector_type(2)));
typedef float f32x4 __attribute__((ext_vector_type(4)));
typedef short bf16x8 __attribute__((ext_vector_type(8)));
typedef GAS unsigned gu32;
#define RLX_AGENT __ATOMIC_RELAXED, __HIP_MEMORY_SCOPE_AGENT
#define LDS_WAIT() asm volatile("s_waitcnt lgkmcnt(0)" ::: "memory")
#define VM_WAIT() asm volatile("s_waitcnt vmcnt(0)" ::: "memory")
__device__ __forceinline__ unsigned f2bf(float f) { unsigned u = __builtin_bit_cast(unsigned, f); return (u + 0x7fffu + ((u >> 16) & 1u)) >> 16; }
__device__ __forceinline__ unsigned pk2(float lo, float hi) { return f2bf(lo) | (f2bf(hi) << 16); }
__device__ __forceinline__ float bf2f(unsigned short b) { return __builtin_bit_cast(float, (unsigned)b << 16); }
__device__ __forceinline__ float bflo(unsigned w) { return __builtin_bit_cast(float, w << 16); }
__device__ __forceinline__ float bfhi(unsigned w) { return __builtin_bit_cast(float, w & 0xffff0000u); }
__device__ __forceinline__ float sigmoidf_(float x) { return __builtin_amdgcn_rcpf(1.0f + __expf(-x)); }
__device__ __forceinline__ float siluf_(float x) { return x * sigmoidf_(x); }
__device__ __forceinline__ float gelu_tanh(float y) { const float uu = 1.5957691216057308f * (y + 0.044715f * y * y * y); return y * sigmoidf_(uu); }
__device__ __forceinline__ float ld_agent(const float* p) { return __builtin_bit_cast(float, __hip_atomic_load((const unsigned*)p, RLX_AGENT)); }
__device__ __forceinline__ void atomic_addf(float* p, float v) { (void)__hip_atomic_fetch_add(p, v, RLX_AGENT); }
__device__ __forceinline__ f32x4 mfma16(bf16x8 a, bf16x8 b, f32x4 c) { return __builtin_amdgcn_mfma_f32_16x16x32_bf16(a, b, c, 0, 0, 0); }
__device__ __forceinline__ float wave_sum(float v) {
#pragma unroll
    for (int o = 1; o < 64; o <<= 1) v += __shfl_xor(v, o);
    return v;
}

#define XB_TMO      128
#define XB_XCNT(j)  (256  + 64 * (j))
#define XB_XSUB(j)  (1280 + 64 * (j))
#define XB_XGEN(j)  (2304 + 64 * (j))
#define XB_TOP      3328
#define XB_TOPGEN   3392
#define XCD_BAR_WORDS 3456
#define XB_SPIN_CAP (1u << 18)
__device__ __forceinline__ unsigned xb_ld(unsigned* p)              { return __hip_atomic_load(p, __ATOMIC_RELAXED, __HIP_MEMORY_SCOPE_AGENT); }
__device__ __forceinline__ unsigned xb_add(unsigned* p, unsigned v) { return __hip_atomic_fetch_add(p, v, __ATOMIC_RELAXED, __HIP_MEMORY_SCOPE_AGENT); }
__device__ __forceinline__ unsigned xb_xcc_id() { return (unsigned)__builtin_amdgcn_s_getreg((3 << 11) | 20) & 0xFu; }
#define XB_SPIN(cond, bar) do { unsigned _sp = 0; while (cond) { __builtin_amdgcn_s_sleep(1); \
    if ((++_sp & 255u) == 0u) { if (xb_ld(&(bar)[XB_TMO])) break; if (_sp > XB_SPIN_CAP) { atomicAdd(&(bar)[XB_TMO], 1u); break; } } } } while (0)
struct XcdBarrier { unsigned* bar; unsigned x; volatile LAS unsigned* st; };
__device__ __forceinline__ XcdBarrier xcd_barrier_post(unsigned* bar, volatile LAS unsigned* st) {
    XcdBarrier b; b.bar = bar; b.x = xb_xcc_id(); b.st = st;
    if (threadIdx.x == 0) (void)xb_add(&bar[XB_XCNT(b.x)], 1u);
    return b;
}
__device__ __forceinline__ void xcd_barrier_complete(unsigned* bar, unsigned x, unsigned& nloc, unsigned& nx) {
    const unsigned G = gridDim.x * gridDim.y * gridDim.z;
    unsigned sum, cnt, mine, sp = 0u;
    for (;;) {
        sum = 0u; cnt = 0u; mine = 0u;
#pragma unroll
        for (unsigned j = 0; j < 16; ++j) { const unsigned c = xb_ld(&bar[XB_XCNT(j)]); sum += c; cnt += (c > 0u) ? 1u : 0u; mine = (j == x) ? c : mine; }
        if (sum == G) break;
        __builtin_amdgcn_s_sleep(1);
        if ((++sp & 255u) == 0u) { if (xb_ld(&bar[XB_TMO])) break; if (sp > XB_SPIN_CAP) { atomicAdd(&bar[XB_TMO], 1u); break; } }
    }
    nloc = mine > 0u ? mine : 1u; nx = cnt > 0u ? cnt : 1u;
}
__device__ __forceinline__ void xcd_barrier(const XcdBarrier& b) {
    asm volatile("s_waitcnt vmcnt(0)" ::: "memory");
    __syncthreads();
    if (threadIdx.x == 0) {
        unsigned* bar = b.bar;
        __builtin_amdgcn_s_waitcnt(0);
        unsigned nloc = b.st[0], nx = b.st[1];
        if (nloc == 0u) { xcd_barrier_complete(bar, b.x, nloc, nx); b.st[0] = nloc; b.st[1] = nx; }
        const unsigned old = xb_add(&bar[XB_XSUB(b.x)], 1u);
        const unsigned gen = old / nloc;
        if (old + 1u == (gen + 1u) * nloc) {
            __builtin_amdgcn_fence(__ATOMIC_RELEASE, "agent");
            asm volatile("s_waitcnt vmcnt(0)" ::: "memory");
            const unsigned og = xb_add(&bar[XB_TOP], 1u);
            const unsigned tg = og / nx;
            if (og + 1u == (tg + 1u) * nx) xb_add(&bar[XB_TOPGEN], 1u);
            else XB_SPIN(xb_ld(&bar[XB_TOPGEN]) == tg, bar);
            __builtin_amdgcn_fence(__ATOMIC_ACQUIRE, "agent");
            xb_add(&bar[XB_XGEN(b.x)], 1u);
            asm volatile("s_waitcnt vmcnt(0)" ::: "memory");
        } else {
            XB_SPIN(xb_ld(&bar[XB_XGEN(b.x)]) == gen, bar);
            __builtin_amdgcn_fence(__ATOMIC_ACQUIRE, "agent");
            asm volatile("s_waitcnt vmcnt(0)" ::: "memory");
        }
    }
    __syncthreads();
}

struct Frame {
    LAS unsigned char* lds;
    volatile LAS unsigned* MISC;
    gu32* ctl;
    int tid, lane, wave;
    int vcu, G;
    unsigned char* ws; float* out;
    const float *x_prompt, *x_sample, *st_s5r, *st_s5i, *st_hg, *st_cv, *meta, *g_mix, *w_in, *lam_re, *lam_im, *log_dt, *b_re, *b_im, *c_re, *c_im, *s5_d,
                *w_glu, *b_glu, *hg_lb, *hg_ng, *w_out, *g_ffn, *w_up, *conv_w, *conv_b, *w_down, *g_final;
};
#define EPI_ARGS const f32x4 (&acc)[2][2][4][2], const pg8::Unit& u, int wr, int wc, int fr, int fq

__device__ __forceinline__ const float* h0_src(int row, const float* xp, const float* meta, const float* xs) {
    if (row >= R_SAMP) return xs + (size_t)(row - R_SAMP) * D;
    const int n = seq_of(row), s = row - n * SEQP;
    return s < NMETA ? meta + (size_t)s * D : xp + (size_t)(n * SEQ + s - NMETA) * D;
}
__device__ __forceinline__ float* h1_dst(int row, float* out, float* h1meta) {
    if (row >= R_SAMP) return out + OFF_YS + (size_t)(row - R_SAMP) * D;
    const int n = seq_of(row), s = row - n * SEQP;
    return s < NMETA ? h1meta + (size_t)(n * NMETA + s) * D : out + (size_t)(n * SEQ + s - NMETA) * D;
}
struct EpiIn {
    bf16 *U, *Q, *V, *G; float* LF; const float* lb;
    __device__ __forceinline__ void operator()(EPI_ARGS) const {
        const int seg = u.pn >> 1, cb = (u.pn & 1) * 256 + wc * 32 + 8 * fq, row0 = u.pm * 256 + wr * 64 + fr;
        bf16* dstb = seg == 0 ? U : (seg == 1 ? Q : (seg == 3 ? V : G));
#pragma unroll
        for (int ai = 0; ai < 2; ++ai)
#pragma unroll
            for (int m = 0; m < 4; ++m) { const size_t row = (size_t)(row0 + ai * 128 + m * 16);
#pragma unroll
                for (int bj = 0; bj < 2; ++bj) { const int col = cb + bj * 128; f32x4 v0 = acc[ai][bj][m][0], v1 = acc[ai][bj][m][1];
                    if (seg == 2) {
                        const f32x4 l0 = *(const f32x4*)(lb + col), l1 = *(const f32x4*)(lb + col + 4); f32x4 o0, o1;
#pragma unroll
                        for (int j = 0; j < 4; ++j) { o0[j] = __logf(l0[j] + (1.f - l0[j]) * sigmoidf_(v0[j])); o1[j] = __logf(l1[j] + (1.f - l1[j]) * sigmoidf_(v1[j])); }
                        *(f32x4*)(LF + row * HD + col) = o0; *(f32x4*)(LF + row * HD + col + 4) = o1;
                    } else {
                        if (seg == 4) {
#pragma unroll
                            for (int j = 0; j < 4; ++j) { v0[j] = siluf_(v0[j]); v1[j] = siluf_(v1[j]); } }
                        v4u w; w.x = pk2(v0[0], v0[1]); w.y = pk2(v0[2], v0[3]); w.z = pk2(v1[0], v1[1]); w.w = pk2(v1[2], v1[3]);
                        *(v4u*)(dstb + row * HD + col) = w;
                    } } }
    }
};
struct EpiGlu {
    const bf16* Y5; const float* bias; bf16* MIX;
    __device__ __forceinline__ void operator()(EPI_ARGS) const {
        const int col0 = u.pn * 256 + wc * 32 + 8 * fq, row0 = u.pm * 256 + wr * 64 + fr;
#pragma unroll
        for (int ai = 0; ai < 2; ++ai)
#pragma unroll
            for (int m = 0; m < 4; ++m) { const size_t row = (size_t)(row0 + ai * 128 + m * 16);
#pragma unroll
                for (int bj = 0; bj < 2; ++bj) { const int col = col0 + bj * 128; const f32x4 v0 = acc[ai][bj][m][0], v1 = acc[ai][bj][m][1];
                    const f32x4 b0 = *(const f32x4*)(bias + col), b1 = *(const f32x4*)(bias + col + 4);
                    const v4u y = *(const v4u*)(Y5 + row * HD + col);
                    v4u w;
                    w.x = pk2(bflo(y.x) * sigmoidf_(v0[0] + b0[0]), bfhi(y.x) * sigmoidf_(v0[1] + b0[1]));
                    w.y = pk2(bflo(y.y) * sigmoidf_(v0[2] + b0[2]), bfhi(y.y) * sigmoidf_(v0[3] + b0[3]));
                    w.z = pk2(bflo(y.z) * sigmoidf_(v1[0] + b1[0]), bfhi(y.z) * sigmoidf_(v1[1] + b1[1]));
                    w.w = pk2(bflo(y.w) * sigmoidf_(v1[2] + b1[2]), bfhi(y.w) * sigmoidf_(v1[3] + b1[3]));
                    *(v4u*)(MIX + row * D + col) = w; } }
    }
};
struct EpiOut {
    const float *xp, *meta, *xs; float *out, *h1meta; bf16* H1B; float* ss;
    __device__ __forceinline__ void operator()(EPI_ARGS) const {
        const int col0 = u.pn * 256 + wc * 32 + 8 * fq, row0 = u.pm * 256 + wr * 64 + fr;
#pragma unroll
        for (int ai = 0; ai < 2; ++ai)
#pragma unroll
            for (int m = 0; m < 4; ++m) { const int row = row0 + ai * 128 + m * 16;
                const float* src = h0_src(row, xp, meta, xs);
                float* dst = h1_dst(row, out, h1meta);
                float s = 0.f;
#pragma unroll
                for (int bj = 0; bj < 2; ++bj) { const int col = col0 + bj * 128;
                    const f32x4 h0 = *(const f32x4*)(src + col) + acc[ai][bj][m][0], h1 = *(const f32x4*)(src + col + 4) + acc[ai][bj][m][1];
                    *(f32x4*)(dst + col) = h0; *(f32x4*)(dst + col + 4) = h1;
                    v4u w; w.x = pk2(h0[0], h0[1]); w.y = pk2(h0[2], h0[3]); w.z = pk2(h1[0], h1[1]); w.w = pk2(h1[2], h1[3]);
                    *(v4u*)(H1B + (size_t)row * D + col) = w;
                    s += (h0[0] * h0[0] + h0[1] * h0[1]) + (h0[2] * h0[2] + h0[3] * h0[3]) + (h1[0] * h1[0] + h1[1] * h1[1]) + (h1[2] * h1[2] + h1[3] * h1[3]); }
                s += __shfl_xor(s, 16); s += __shfl_xor(s, 32);
                if (fq == 0 && ss) atomic_addf(ss + row, s); }
    }
};
struct EpiUpGate {
    const float* ss; bf16* GATED; float* out; const float *conv_w, *conv_b, *st_cv; LAS float* xch;
    __device__ __forceinline__ void operator()(EPI_ARGS) const {
        const int lane = fq * 16 + fr, cl = wc * 32 + 8 * fq, col = u.pn * 128 + cl;
        const int rbase = u.pm * 254 - 2 + wr * 64 + fr;
        f32x4 cb[2], w0[2], w1[2], w2[2];
#pragma unroll
        for (int n = 0; n < 2; ++n) { cb[n] = *(const f32x4*)(conv_b + col + 4 * n); w0[n] = *(const f32x4*)(conv_w + col + 4 * n); w1[n] = *(const f32x4*)(conv_w + DFF + col + 4 * n); w2[n] = *(const f32x4*)(conv_w + 2 * DFF + col + 4 * n); }
        float rstd[2][4];
#pragma unroll
        for (int ai = 0; ai < 2; ++ai)
#pragma unroll
            for (int m = 0; m < 4; ++m) { int row = rbase + ai * 128 + m * 16; row = row < 0 ? 0 : (row >= RT ? RT - 1 : row); rstd[ai][m] = __builtin_amdgcn_rsqf(ld_agent(ss + row) * (1.0f / D) + EPS); }
        if (fr >= 14) {
#pragma unroll
            for (int ai = 0; ai < 2; ++ai)
#pragma unroll
                for (int n = 0; n < 2; ++n) *(LAS f32x4*)(xch + ((ai * 2 + wr) * 2 + (fr - 14)) * 128 + cl + 4 * n) = acc[ai][0][3][n] * rstd[ai][3];
        }
        asm volatile("s_waitcnt lgkmcnt(0)" ::: "memory"); __builtin_amdgcn_s_barrier(); asm volatile("" ::: "memory");
        const int src1 = (lane & 48) | ((fr - 1) & 15), src2 = (lane & 48) | ((fr - 2) & 15);
#pragma unroll
        for (int ai = 0; ai < 2; ++ai) {
            int pb = ai * 2 + wr - 1; pb = pb < 0 ? 0 : pb;
            f32x4 r1p[2], r2p[2];
#pragma unroll
            for (int n = 0; n < 2; ++n) { r1p[n] = *(const LAS f32x4*)(xch + (pb * 2 + 1) * 128 + cl + 4 * n); r2p[n] = *(const LAS f32x4*)(xch + (pb * 2 + (fr & 1)) * 128 + cl + 4 * n); }
#pragma unroll
            for (int m = 0; m < 4; ++m) {
                const int i = ai * 128 + wr * 64 + m * 16 + fr, row = rbase + ai * 128 + m * 16;
                f32x4 a[2], v[2], p1[2], p2[2], c1[2], c2[2];
#pragma unroll
                for (int n = 0; n < 2; ++n) { a[n] = acc[ai][0][m][n] * rstd[ai][m]; v[n] = acc[ai][1][m][n] * rstd[ai][m];
#pragma unroll
                    for (int j = 0; j < 4; ++j) { c1[n][j] = __shfl(a[n][j], src1); c2[n][j] = __shfl(a[n][j], src2); }
                    p1[n] = fr == 0 ? r1p[n] : c1[n]; p2[n] = fr < 2 ? r2p[n] : c2[n];
                    r1p[n] = c1[n]; r2p[n] = c2[n]; }
                if (i >= 2 && row < RT) {
                    float* cv = nullptr;
                    if (row >= R_SAMP) { const int sm = row - R_SAMP; const float* st = st_cv + (size_t)(sm * 2) * DFF + col;
#pragma unroll
                        for (int n = 0; n < 2; ++n) { p2[n] = *(const f32x4*)(st + 4 * n); p1[n] = *(const f32x4*)(st + DFF + 4 * n); *(f32x4*)(out + OFF_CVS + (size_t)(sm * 2) * DFF + col + 4 * n) = p1[n]; }
                        cv = out + OFF_CVS + (size_t)(sm * 2 + 1) * DFF + col;
                    } else { const int nn = seq_of(row), sq = row - nn * SEQP;
                        if (sq == 0) { p1[0] = (f32x4){0.f, 0.f, 0.f, 0.f}; p1[1] = p1[0]; }
                        if (sq <= 1) { p2[0] = (f32x4){0.f, 0.f, 0.f, 0.f}; p2[1] = p2[0]; }
                        if (sq >= SEQP - 2) cv = out + OFF_CVP + (size_t)(nn * 2 + sq - (SEQP - 2)) * DFF + col; }
                    if (cv) { *(f32x4*)cv = a[0]; *(f32x4*)(cv + 4) = a[1]; }
                    float o[8];
#pragma unroll
                    for (int n = 0; n < 2; ++n)
#pragma unroll
                        for (int j = 0; j < 4; ++j) { const float cc = cb[n][j] + w0[n][j] * p2[n][j] + w1[n][j] * p1[n][j] + w2[n][j] * a[n][j]; o[4 * n + j] = siluf_(cc) * v[n][j]; }
                    v4u w; w.x = pk2(o[0], o[1]); w.y = pk2(o[2], o[3]); w.z = pk2(o[4], o[5]); w.w = pk2(o[6], o[7]);
                    *(v4u*)(GATED + (size_t)row * DFF + col) = w; }
            }
        }
    }
};
struct EpiDown {
    float *out, *h1meta; float* ss; float* dry;
    __device__ __forceinline__ void operator()(EPI_ARGS) const {
        const int col0 = u.pn * 256 + wc * 32 + 8 * fq, row0 = u.pm * 256 + wr * 64 + fr;
#pragma unroll
        for (int ai = 0; ai < 2; ++ai)
#pragma unroll
            for (int m = 0; m < 4; ++m) { const int row = row0 + ai * 128 + m * 16;
                float* dst = h1_dst(row, out, h1meta);
                float s = 0.f;
#pragma unroll
                for (int bj = 0; bj < 2; ++bj) { const int col = col0 + bj * 128;
                    const f32x4 h0 = *(const f32x4*)(dst + col) + acc[ai][bj][m][0], h1 = *(const f32x4*)(dst + col + 4) + acc[ai][bj][m][1];
                    float* wp = dry ? dry + (((size_t)row * D + col) & 0x7FFFF8u) : dst + col;
                    *(f32x4*)(wp) = h0; *(f32x4*)(wp + 4) = h1;
                    s += (h0[0] * h0[0] + h0[1] * h0[1]) + (h0[2] * h0[2] + h0[3] * h0[3]) + (h1[0] * h1[0] + h1[1] * h1[1]) + (h1[2] * h1[2] + h1[3] * h1[3]); }
                s += __shfl_xor(s, 16); s += __shfl_xor(s, 32);
                if (fq == 0 && !dry) atomic_addf(ss + row, s); }
    }
};
__device__ __forceinline__ void p0_transpose_item(const float* W, int K, int N, bf16* WT, const float* ksc, LAS float* scr, int item, int lane, bool upmap = false) {
    const int nblk = N / 64, kb = item / nblk, nb = item % nblk, k0 = 64 * kb, n0 = 64 * nb;
    const int d0 = !upmap ? n0 : (n0 < DFF ? 256 * (n0 >> 7) + (n0 & 127) : 256 * ((n0 - DFF) >> 7) + 128 + ((n0 - DFF) & 127));
    const int ks = lane >> 4, n4 = (lane & 15) * 4;
    f32x4 v[16]; float sc[16];
#pragma unroll
    for (int i = 0; i < 16; ++i) { const int kk = 4 * i + ks; v[i] = *(const GAS f32x4*)(W + (size_t)(k0 + kk) * N + n0 + n4); sc[i] = ksc ? ksc[k0 + kk] : 1.0f; }
#pragma unroll
    for (int i = 0; i < 16; ++i) { const int kk = 4 * i + ks; LAS float* d = scr + kk * 65 + n4; d[0] = v[i].x * sc[i]; d[1] = v[i].y * sc[i]; d[2] = v[i].z * sc[i]; d[3] = v[i].w * sc[i]; }
    LDS_WAIT(); asm volatile("" ::: "memory");
    const int c = lane & 7;
#pragma unroll
    for (int j = 0; j < 8; ++j) { const int n = (lane >> 3) + 8 * j; const LAS float* q = scr + (8 * c) * 65 + n;
        v4u o; o.x = pk2(q[0 * 65], q[1 * 65]); o.y = pk2(q[2 * 65], q[3 * 65]); o.z = pk2(q[4 * 65], q[5 * 65]); o.w = pk2(q[6 * 65], q[7 * 65]);
        *(GAS v4u*)(WT + (size_t)(d0 + n) * K + k0 + 8 * c) = o; }
    LDS_WAIT(); asm volatile("" ::: "memory");
}
template <int NR>
__device__ __forceinline__ void rms_rows_to_bf16(int lane, const float* const (&xrow)[NR], bf16* const (&orow)[NR]) {
    f32x4 v[NR][4]; float s[NR];
#pragma unroll
    for (int r = 0; r < NR; ++r) { const GAS f32x4* xr = (const GAS f32x4*)xrow[r] + lane;
#pragma unroll
        for (int j = 0; j < 4; ++j) v[r][j] = xr[64 * j]; }
#pragma unroll
    for (int r = 0; r < NR; ++r) { s[r] = 0.f;
#pragma unroll
        for (int j = 0; j < 4; ++j) s[r] += (v[r][j].x * v[r][j].x + v[r][j].y * v[r][j].y) + (v[r][j].z * v[r][j].z + v[r][j].w * v[r][j].w); }
#pragma unroll
    for (int o = 1; o < 64; o <<= 1) {
#pragma unroll
        for (int r = 0; r < NR; ++r) s[r] += __shfl_xor(s[r], o); }
#pragma unroll
    for (int r = 0; r < NR; ++r) { const float rstd = 1.0f / sqrtf(s[r] * (1.f / D) + EPS);
        GAS unsigned long long* o8 = (GAS unsigned long long*)orow[r] + lane;
#pragma unroll
        for (int j = 0; j < 4; ++j) o8[64 * j] = (unsigned long long)pk2(v[r][j].x * rstd, v[r][j].y * rstd) | ((unsigned long long)pk2(v[r][j].z * rstd, v[r][j].w * rstd) << 32); }
}
__device__ __forceinline__ void s5_precompute_item(Frame& F, int item) {
    const int g = item >> 3, b = item & 7;
    LAS float* Ap = (LAS float*)F.lds;
    LAS float* Bb = Ap + 2176;
    LAS float* Cc = Bb + 2048;
    LAS float* Kt = Cc + 2048;
    const int tid = F.tid;
    float* A1 = (float*)(F.ws + WS_S5F + S5F_A1); float* A16 = (float*)(F.ws + WS_S5F + S5F_A16); float* BBf = (float*)(F.ws + WS_S5F + S5F_BB);
    const float dt = expf(F.log_dt[g]);
    for (int idx = tid; idx < 17 * 64; idx += 512) { const int j = idx >> 6, p = idx & 63; const float lr = F.lam_re[g * 64 + p], li = F.lam_im[g * 64 + p];
        const double TWO_PI = 6.283185307179586476925286766559;
        const float mag = expf(lr * dt * (float)j);
        double rev = ((double)li * (double)dt * (double)j) / TWO_PI; rev -= rint(rev);
        const float ang = (float)(rev * TWO_PI);
        Ap[idx * 2] = mag * cosf(ang); Ap[idx * 2 + 1] = mag * sinf(ang); }
    for (int idx = tid; idx < 1024; idx += 512) { const int co = idx >> 6, p = idx & 63; Cc[idx * 2] = F.c_re[(g * 16 + co) * 64 + p]; Cc[idx * 2 + 1] = F.c_im[(g * 16 + co) * 64 + p]; }
    __syncthreads();
    for (int idx = tid; idx < 1024; idx += 512) { const int p = idx >> 4, c = idx & 15; const float lr = F.lam_re[g * 64 + p], li = F.lam_im[g * 64 + p];
        const float ar = Ap[(64 + p) * 2], ai = Ap[(64 + p) * 2 + 1];
        const float nr = ar - 1.0f, den = lr * lr + li * li, cr = (nr * lr + ai * li) / den, ci = (ai * lr - nr * li) / den;
        const float bre = F.b_re[(g * 64 + p) * 16 + c], bim = F.b_im[(g * 64 + p) * 16 + c];
        const float xr = cr * bre - ci * bim, xi = cr * bim + ci * bre;
        Bb[idx * 2] = xr; Bb[idx * 2 + 1] = xi;
        if (b == 0) { BBf[((g * 64 + p) * 16 + c) * 2] = xr; BBf[((g * 64 + p) * 16 + c) * 2 + 1] = xi;
            if (c == 0) { A1[(g * 64 + p) * 2] = ar; A1[(g * 64 + p) * 2 + 1] = ai; A16[(g * 64 + p) * 2] = Ap[(16 * 64 + p) * 2]; A16[(g * 64 + p) * 2 + 1] = Ap[(16 * 64 + p) * 2 + 1]; } } }
    __syncthreads();
    { const int jl = tid >> 8, co = (tid >> 4) & 15, ci = tid & 15, j = 2 * b + jl; float kv = 0.f;
        for (int p = 0; p < 64; ++p) { const float cr = Cc[(co * 64 + p) * 2], cim = Cc[(co * 64 + p) * 2 + 1], ar = Ap[(j * 64 + p) * 2], ai = Ap[(j * 64 + p) * 2 + 1];
            const float car = cr * ar - cim * ai, cai = cr * ai + cim * ar; kv += car * Bb[(p * 16 + ci) * 2] - cai * Bb[(p * 16 + ci) * 2 + 1]; }
        if (j == 0 && co == ci) kv += F.s5_d[g * 16 + co];
        Kt[tid] = kv; }
    __syncthreads();
    bf16* W1 = (bf16*)(F.ws + WS_S5W1) + (size_t)g * 384 * 256; bf16* W2 = (bf16*)(F.ws + WS_S5W2) + (size_t)g * 256 * 128;
    for (int idx = tid; idx < 2 * 16 * 128; idx += 512) { const int jl = idx >> 11, d = (idx >> 7) & 15, co = (idx >> 3) & 15, cp = idx & 7, j = 2 * b + jl;
        if (d + j < 16) { const int s = d, t = d + j;
            *(unsigned*)(W1 + (size_t)(t * 16 + co) * 256 + s * 16 + 2 * cp) = pk2(Kt[jl * 256 + co * 16 + 2 * cp], Kt[jl * 256 + co * 16 + 2 * cp + 1]);
            if (j >= 1) *(unsigned*)(W1 + (size_t)(s * 16 + co) * 256 + t * 16 + 2 * cp) = 0u; } }
    for (int idx = tid; idx < 16 * 128; idx += 512) { const int pp = 16 * b + (idx >> 7), k = (idx & 127) * 2, s = k >> 4, ci = k & 15, p = pp & 63;
        const float ar = Ap[((15 - s) * 64 + p) * 2], ai = Ap[((15 - s) * 64 + p) * 2 + 1];
        const float b0r = Bb[(p * 16 + ci) * 2], b0i = Bb[(p * 16 + ci) * 2 + 1], b1r = Bb[(p * 16 + ci + 1) * 2], b1i = Bb[(p * 16 + ci + 1) * 2 + 1];
        const float v0 = pp < 64 ? ar * b0r - ai * b0i : ar * b0i + ai * b0r, v1 = pp < 64 ? ar * b1r - ai * b1i : ar * b1i + ai * b1r;
        *(unsigned*)(W1 + (size_t)(256 + pp) * 256 + k) = pk2(v0, v1); }
    for (int idx = tid; idx < 32 * 64; idx += 512) { const int n = 32 * b + (idx >> 6), kq = (idx & 63) * 2, t = n >> 4, co = n & 15; float v[2];
#pragma unroll
        for (int e = 0; e < 2; ++e) { const int pp = kq + e, p = pp & 63; const float cr = Cc[(co * 64 + p) * 2], cim = Cc[(co * 64 + p) * 2 + 1], ar = Ap[((t + 1) * 64 + p) * 2], ai = Ap[((t + 1) * 64 + p) * 2 + 1];
            v[e] = pp < 64 ? (cr * ar - cim * ai) : -(cr * ai + cim * ar); }
        *(unsigned*)(W2 + (size_t)n * 128 + kq) = pk2(v[0], v[1]); }
    __syncthreads();
}
__device__ __forceinline__ void p0_prologue(Frame& F) {
    for (int it = F.vcu; it < 256; it += F.G) s5_precompute_item(F, it);
    if (F.vcu == 32 % F.G) {
        float* LB = (float*)(F.ws + WS_S5F + S5F_LB); const float a0 = F.hg_lb[F.tid], a1 = F.hg_lb[512 + F.tid], mx = fmaxf(a0, a1), e0 = expf(a0 - mx), e1 = expf(a1 - mx); LB[F.tid] = e0 / (e0 + e1); }
    LAS float* scr = (LAS float*)(F.lds + RING_OFF + F.wave * 16896);
    const int gw = F.vcu * NWAVES + F.wave, NGW = F.G * NWAVES;
    constexpr int I_IN = (D / 64) * (INC / 64), I_GLU = (HD / 64) * (HD / 64), I_OUT = (D / 64) * (D / 64), I_UP = (D / 64) * (UPC / 64), I_DN = (DFF / 64) * (D / 64);
    constexpr int NITEMS = I_IN + I_GLU + I_OUT + I_UP + I_DN;
    for (int it = gw; it < NITEMS; it += NGW) {
        int r = it;
        if (r < I_IN) { p0_transpose_item(F.w_in, D, INC, (bf16*)(F.ws + WS_WIN), F.g_mix, scr, r, F.lane); continue; } r -= I_IN;
        if (r < I_GLU) { p0_transpose_item(F.w_glu, HD, HD, (bf16*)(F.ws + WS_WGLU), nullptr, scr, r, F.lane); continue; } r -= I_GLU;
        if (r < I_OUT) { p0_transpose_item(F.w_out, D, D, (bf16*)(F.ws + WS_WOUT), nullptr, scr, r, F.lane); continue; } r -= I_OUT;
        if (r < I_UP) { p0_transpose_item(F.w_up, D, UPC, (bf16*)(F.ws + WS_WUP), F.g_ffn, scr, r, F.lane, true); continue; } r -= I_UP;
        p0_transpose_item(F.w_down, DFF, D, (bf16*)(F.ws + WS_WDN), nullptr, scr, r, F.lane);
    }
    bf16* XN = (bf16*)(F.ws + WS_XN);
    for (int m0 = gw * 4; m0 < RT; m0 += NGW * 4) {
        const float* src[4]; bf16* dst[4];
#pragma unroll
        for (int r = 0; r < 4; ++r) { const int m = m0 + r;
            src[r] = h0_src(m, F.x_prompt, F.meta, F.x_sample);
            dst[r] = XN + (size_t)m * D; }
        rms_rows_to_bf16<4>(F.lane, src, dst);
    }
}

__device__ __forceinline__ void s5_prompt_item(Frame& F, int item) {
    const int g = item & 31, n = item >> 5;
    LAS unsigned char* R1 = F.lds;
    LAS float* R2 = (LAS float*)(F.lds + 76032);
    int tid = F.tid; asm volatile("" : "+v"(tid));
    const int lane = tid & 63, w = F.wave, r = lane & 15, q = lane >> 4;
    const bf16* U = (const bf16*)(F.ws + WS_U);
#pragma unroll
    for (int i = 0; i < 9; ++i) { const int idx = tid + 512 * i, c = idx >> 5, pc = idx & 31, s = pc >> 1, half = pc & 1, cc = c < 128 ? c : 128;
        const int grow = SEQP * n + 16 * cc + s;
        const v4u val = *(const v4u*)(U + (size_t)grow * HD + 16 * g + 8 * half);
        *(LAS v4u*)(R1 + c * 528 + pc * 16) = val; }
    __syncthreads();
    const bf16* W1 = (const bf16*)(F.ws + WS_S5W1) + (size_t)g * 384 * 256; const bf16* W2 = (const bf16*)(F.ws + WS_S5W2) + (size_t)g * 256 * 128;
    f32x4 acc0[9], acc1[9], acc2[9];
#pragma unroll
    for (int mt = 0; mt < 9; ++mt) { acc0[mt] = (f32x4){0.f, 0.f, 0.f, 0.f}; acc1[mt] = acc0[mt]; acc2[mt] = acc0[mt]; }
#pragma unroll 1
    for (int kk = 0; kk < 8; ++kk) {
        const bool need0 = (2 * kk <= w);
        const bool need1 = (2 * kk <= w + 8);
        const bf16x8 b2 = *(const bf16x8*)(W1 + (size_t)(16 * (16 + w) + r) * 256 + 32 * kk + 8 * q);
        bf16x8 b0 = b2, b1 = b2;
        if (need0) b0 = *(const bf16x8*)(W1 + (size_t)(16 * w + r) * 256 + 32 * kk + 8 * q);
        if (need1) b1 = *(const bf16x8*)(W1 + (size_t)(16 * (w + 8) + r) * 256 + 32 * kk + 8 * q);
#pragma unroll
        for (int mt = 0; mt < 9; ++mt) { const bf16x8 a = *(const LAS bf16x8*)(R1 + (16 * mt + r) * 528 + (32 * kk + 8 * q) * 2);
            acc2[mt] = mfma16(a, b2, acc2[mt]);
            if (need0) acc0[mt] = mfma16(a, b0, acc0[mt]);
            if (need1) acc1[mt] = mfma16(a, b1, acc1[mt]); }
    }
#pragma unroll
    for (int mt = 0; mt < 9; ++mt)
#pragma unroll
        for (int i = 0; i < 4; ++i) R2[(16 * mt + 4 * q + i) * 132 + 16 * w + r] = acc2[mt][i];
    __syncthreads();
    if (w == 0) {
        const float* A16 = (const float*)(F.ws + WS_S5F + S5F_A16); const float ar = A16[(g * 64 + lane) * 2], ai = A16[(g * 64 + lane) * 2 + 1];
        float hr = 0.f, hi = 0.f;
        for (int c0 = 0; c0 < 136; c0 += 8) {
            float lr[8], li[8];
#pragma unroll
            for (int j = 0; j < 8; ++j) { lr[j] = R2[(c0 + j) * 132 + lane]; li[j] = R2[(c0 + j) * 132 + 64 + lane]; }
#pragma unroll
            for (int j = 0; j < 8; ++j) { const int c = c0 + j;
                if (c <= 128) {
                    *(LAS bf16*)(R1 + c * 272 + lane * 2) = (bf16)f2bf(hr); *(LAS bf16*)(R1 + c * 272 + 128 + lane * 2) = (bf16)f2bf(hi);
                    const float nr = ar * hr - ai * hi + lr[j], ni = ar * hi + ai * hr + li[j]; hr = nr; hi = ni;
                } else { *(LAS bf16*)(R1 + c * 272 + lane * 2) = 0; *(LAS bf16*)(R1 + c * 272 + 128 + lane * 2) = 0; } }
        }
#pragma unroll
        for (int c = 136; c < 144; ++c) { *(LAS bf16*)(R1 + c * 272 + lane * 2) = 0; *(LAS bf16*)(R1 + c * 272 + 128 + lane * 2) = 0; }
        F.out[OFF_S5RP + (size_t)(n * 32 + g) * 64 + lane] = hr; F.out[OFF_S5IP + (size_t)(n * 32 + g) * 64 + lane] = hi;
    }
    __syncthreads();
#pragma unroll 1
    for (int kk = 0; kk < 4; ++kk) {
        const bf16x8 b0 = *(const bf16x8*)(W2 + (size_t)(16 * w + r) * 128 + 32 * kk + 8 * q), b1 = *(const bf16x8*)(W2 + (size_t)(16 * (w + 8) + r) * 128 + 32 * kk + 8 * q);
#pragma unroll
        for (int mt = 0; mt < 9; ++mt) { const bf16x8 a = *(const LAS bf16x8*)(R1 + (16 * mt + r) * 272 + (32 * kk + 8 * q) * 2);
            acc0[mt] = mfma16(a, b0, acc0[mt]); acc1[mt] = mfma16(a, b1, acc1[mt]); }
    }
    bf16* Y5 = (bf16*)(F.ws + WS_Y5);
#pragma unroll
    for (int mt = 0; mt < 9; ++mt)
#pragma unroll
        for (int i = 0; i < 4; ++i) { const int c = 16 * mt + 4 * q + i;
            if (c <= 128) { const int rb = SEQP * n + 16 * c;
                Y5[(size_t)(rb + w) * HD + 16 * g + r] = (bf16)f2bf(gelu_tanh(acc0[mt][i]));
                Y5[(size_t)(rb + w + 8) * HD + 16 * g + r] = (bf16)f2bf(gelu_tanh(acc1[mt][i])); } }
    __syncthreads();
}
__device__ __forceinline__ void s5_sample_item(Frame& F, int item) {
    const int g = item & 31, s = item >> 5, lane = F.lane, row = R_SAMP + s;
    const bf16* U = (const bf16*)(F.ws + WS_U); bf16* Y5 = (bf16*)(F.ws + WS_Y5);
    const float* A1 = (const float*)(F.ws + WS_S5F + S5F_A1); const float* BBf = (const float*)(F.ws + WS_S5F + S5F_BB);
    const v4u u0 = *(const v4u*)(U + (size_t)row * HD + 16 * g), u1 = *(const v4u*)(U + (size_t)row * HD + 16 * g + 8);
    float uu[16]; uu[0] = bflo(u0.x); uu[1] = bfhi(u0.x); uu[2] = bflo(u0.y); uu[3] = bfhi(u0.y); uu[4] = bflo(u0.z); uu[5] = bfhi(u0.z); uu[6] = bflo(u0.w); uu[7] = bfhi(u0.w);
    uu[8] = bflo(u1.x); uu[9] = bfhi(u1.x); uu[10] = bflo(u1.y); uu[11] = bfhi(u1.y); uu[12] = bflo(u1.z); uu[13] = bfhi(u1.z); uu[14] = bflo(u1.w); uu[15] = bfhi(u1.w);
    float xr = 0.f, xi = 0.f; const float* bb = BBf + (size_t)(g * 64 + lane) * 32;
#pragma unroll
    for (int c = 0; c < 16; ++c) { xr += bb[2 * c] * uu[c]; xi += bb[2 * c + 1] * uu[c]; }
    const float ar = A1[(g * 64 + lane) * 2], ai = A1[(g * 64 + lane) * 2 + 1];
    const float h0r = F.st_s5r[(size_t)(s * 32 + g) * 64 + lane], h0i = F.st_s5i[(size_t)(s * 32 + g) * 64 + lane];
    const float hr = ar * h0r - ai * h0i + xr, hi = ar * h0i + ai * h0r + xi;
    F.out[OFF_S5RS + (size_t)(s * 32 + g) * 64 + lane] = hr; F.out[OFF_S5IS + (size_t)(s * 32 + g) * 64 + lane] = hi;
    float yk = 0.f;
#pragma unroll
    for (int co = 0; co < 16; ++co) { const float part = hr * F.c_re[(g * 16 + co) * 64 + lane] - hi * F.c_im[(g * 16 + co) * 64 + lane]; const float tot = wave_sum(part); if (lane == co) yk = tot; }
    if (lane < 16) { float uc = 0.f;
#pragma unroll
        for (int c = 0; c < 16; ++c) uc = (lane == c) ? uu[c] : uc;
        const float y = yk + F.s5_d[g * 16 + lane] * uc; Y5[(size_t)row * HD + 16 * g + lane] = (bf16)f2bf(gelu_tanh(y)); }
}
#define HG_O_QD 0
#define HG_O_KD 17408
#define HG_O_KT 34816
#define HG_O_VT 53248
#define HG_O_ATT 55552
#define HG_O_ST 64768
#define HG_O_SEG 69120
#define HG_O_DEC 71168
constexpr size_t WS_HQD = WS_XN, WS_HATT = WS_XN + (size_t)1056 * 64 * 128 * 2, WS_HKT = WS_ZEND, WS_HDEC = WS_ZEND + (size_t)1056 * 128 * 64 * 2;
static_assert(WS_HATT + (size_t)1056 * 64 * 64 * 2 <= WS_U && WS_HDEC + (size_t)1056 * 128 * 4 <= WS_END, "hgrn operand buffers");
__device__ __forceinline__ void hgrn_pre_items(Frame& F) {
    LAS unsigned char* L = F.lds;
    int tid = F.tid; asm volatile("" : "+v"(tid));
    const int lane = tid & 63, w = F.wave, r = lane & 15, q = lane >> 4;
    const bf16* Qb = (const bf16*)(F.ws + WS_Q); const float* LF = (const float*)(F.ws + WS_LF);
    bf16* QDg = (bf16*)(F.ws + WS_HQD); bf16* ATTg = (bf16*)(F.ws + WS_HATT); bf16* KTg = (bf16*)(F.ws + WS_HKT); float* DECg = (float*)(F.ws + WS_HDEC);
    for (int i = tid; i < 9216 / 4; i += 512) ((LAS unsigned*)(L + HG_O_ATT))[i] = 0u;
    const int k = tid & 127, s4 = tid >> 7;
    float lf[16]; unsigned short qv[16];
#define HG_LOAD(item) do { const int c_ = (item) % 33, nh_ = (item) / 33, n_ = nh_ >> 2, h_ = nh_ & 3; \
        _Pragma("unroll") for (int i = 0; i < 16; ++i) { const int t = 16 * s4 + i; const int row = c_ == 0 ? (t < 16 ? SEQP * n_ + t : -1) : SEQP * n_ + 16 + 64 * (c_ - 1) + t; \
            if (row >= 0) { lf[i] = LF[(size_t)row * HD + 128 * h_ + k]; qv[i] = Qb[(size_t)row * HD + 128 * h_ + k]; } else { lf[i] = 0.f; qv[i] = 0; } } } while (0)
    int item = F.vcu;
    if (item < 1056) HG_LOAD(item);
    for (; item < 1056; item += F.G) {
        float bc[16]; float run = 0.f;
#pragma unroll
        for (int i = 0; i < 16; ++i) { run += lf[i]; bc[i] = run; }
        ((LAS float*)(L + HG_O_SEG))[s4 * 128 + k] = run;
        __syncthreads();
        float off = 0.f, bl = 0.f;
#pragma unroll
        for (int s = 0; s < 4; ++s) { const float v = ((LAS float*)(L + HG_O_SEG))[s * 128 + k]; bl += v; off += (s < s4) ? v : 0.f; }
        if (s4 == 0) DECg[(size_t)item * 128 + k] = __expf(bl);
        unsigned kp[8];
#pragma unroll
        for (int i = 0; i < 16; i += 2) { float kdl2[2];
#pragma unroll
            for (int e = 0; e < 2; ++e) { const int ii = i + e; const float b = off + bc[ii], f = __expf(lf[ii]), kk = 1.0f - f, eb = __expf(b), enb = __expf(-b);
                *(LAS bf16*)(L + HG_O_QD + (16 * s4 + ii) * 272 + k * 2) = (bf16)f2bf(bf2f(qv[ii]) * eb);
                *(LAS bf16*)(L + HG_O_KD + (16 * s4 + ii) * 272 + k * 2) = (bf16)f2bf(kk * enb);
                kdl2[e] = kk * __expf(bl - b); }
            kp[i >> 1] = pk2(kdl2[0], kdl2[1]); }
        *(v4u*)(KTg + ((size_t)item * 128 + k) * 64 + 16 * s4) = (v4u){kp[0], kp[1], kp[2], kp[3]};
        *(v4u*)(KTg + ((size_t)item * 128 + k) * 64 + 16 * s4 + 8) = (v4u){kp[4], kp[5], kp[6], kp[7]};
        __syncthreads();
        if (item + F.G < 1056) HG_LOAD(item + F.G);
#pragma unroll
        for (int j = 0; j < 2; ++j) { const int idx = tid + 512 * j, t = idx >> 4, pc = idx & 15; *(v4u*)(QDg + ((size_t)item * 64 + t) * 128 + pc * 8) = *(const LAS v4u*)(L + HG_O_QD + t * 272 + pc * 16); }
#pragma unroll
        for (int rep = 0; rep < 2; ++rep) { const int idx = w + 8 * rep;
            if (idx < 10) { const int ti = idx < 1 ? 0 : (idx < 3 ? 1 : (idx < 6 ? 2 : 3)), sj = idx - (ti * (ti + 1)) / 2;
                f32x4 at = (f32x4){0.f, 0.f, 0.f, 0.f};
#pragma unroll
                for (int kk = 0; kk < 4; ++kk) { const bf16x8 a = *(const LAS bf16x8*)(L + HG_O_QD + (16 * ti + r) * 272 + (32 * kk + 8 * q) * 2), b = *(const LAS bf16x8*)(L + HG_O_KD + (16 * sj + r) * 272 + (32 * kk + 8 * q) * 2); at = mfma16(a, b, at); }
#pragma unroll
                for (int i = 0; i < 4; ++i) { const int t = 16 * ti + 4 * q + i, s = 16 * sj + r; *(LAS bf16*)(L + HG_O_ATT + t * 144 + s * 2) = (bf16)f2bf(s <= t ? at[i] : 0.f); } } }
        __syncthreads();
        { const int t = tid >> 3, pc = tid & 7; *(v4u*)(ATTg + ((size_t)item * 64 + t) * 64 + pc * 8) = *(const LAS v4u*)(L + HG_O_ATT + t * 144 + pc * 16); }
    }
#undef HG_LOAD
    __syncthreads();
}
__device__ __forceinline__ void hgrn_seq_item(Frame& F, int item, bool atom = true) {
    const int vs = item & 7, h = (item >> 3) & 3, n = item >> 5;
    LAS unsigned char* L = F.lds;
    int tid = F.tid; asm volatile("" : "+v"(tid));
    const int lane = tid & 63, w = F.wave, r = lane & 15, q = lane >> 4;
    const bf16* Vb = (const bf16*)(F.ws + WS_V);
    const bf16* QDg = (const bf16*)(F.ws + WS_HQD); const bf16* ATTg = (const bf16*)(F.ws + WS_HATT); const bf16* KTg = (const bf16*)(F.ws + WS_HKT); const float* DECg = (const float*)(F.ws + WS_HDEC);
    bf16* OH = (bf16*)(F.ws + WS_OH); float* HSS = (float*)(F.ws + WS_CTL + CB_HSS);
    for (int i = tid; i < 4352 / 4; i += 512) ((LAS unsigned*)(L + HG_O_ST))[i] = 0u;
    f32x4 Sreg = (f32x4){0.f, 0.f, 0.f, 0.f};
    const int tv = tid >> 3, pr = tid & 7;
    v4u pq[2], pk[2], pa; unsigned vv; float dc;
#define HG_LOAD(c) do { const size_t it_ = (size_t)((n * 4 + h) * 33 + (c)); \
        _Pragma("unroll") for (int j = 0; j < 2; ++j) { const int idx = tid + 512 * j; pq[j] = *(const v4u*)(QDg + it_ * 8192 + (size_t)idx * 8); pk[j] = *(const v4u*)(KTg + it_ * 8192 + (size_t)idx * 8); } \
        pa = *(const v4u*)(ATTg + it_ * 4096 + (size_t)tid * 8); dc = DECg[it_ * 128 + (tid & 127)]; \
        { const int row = (c) == 0 ? (tv < 16 ? SEQP * n + tv : -1) : SEQP * n + 16 + 64 * ((c) - 1) + tv; \
          vv = row >= 0 ? *(const unsigned*)(Vb + (size_t)row * HD + 128 * h + 16 * vs + 2 * pr) : 0u; } } while (0)
    HG_LOAD(0);
    for (int c = 0; c <= 32; ++c) {
#pragma unroll
        for (int j = 0; j < 2; ++j) { const int idx = tid + 512 * j;
            *(LAS v4u*)(L + HG_O_QD + (idx >> 4) * 272 + (idx & 15) * 16) = pq[j];
            *(LAS v4u*)(L + HG_O_KT + (idx >> 3) * 144 + (idx & 7) * 16) = pk[j]; }
        *(LAS v4u*)(L + HG_O_ATT + (tid >> 3) * 144 + (tid & 7) * 16) = pa;
        if (tid < 128) ((LAS float*)(L + HG_O_DEC))[tid] = dc;
        *(LAS bf16*)(L + HG_O_VT + (2 * pr) * 144 + tv * 2) = (bf16)(vv & 0xffffu); *(LAS bf16*)(L + HG_O_VT + (2 * pr + 1) * 144 + tv * 2) = (bf16)(vv >> 16);
        __syncthreads();
        if (c < 32) HG_LOAD(c + 1);
        f32x4 accS;
#pragma unroll
        for (int i = 0; i < 4; ++i) accS[i] = ((LAS float*)(L + HG_O_DEC))[16 * w + 4 * q + i] * Sreg[i];
#pragma unroll
        for (int kk = 0; kk < 2; ++kk) { const bf16x8 a = *(const LAS bf16x8*)(L + HG_O_KT + (16 * w + r) * 144 + (32 * kk + 8 * q) * 2), b = *(const LAS bf16x8*)(L + HG_O_VT + r * 144 + (32 * kk + 8 * q) * 2); accS = mfma16(a, b, accS); }
        if (w < 4) {
            f32x4 o = (f32x4){0.f, 0.f, 0.f, 0.f};
#pragma unroll
            for (int kk = 0; kk < 4; ++kk) { const bf16x8 a = *(const LAS bf16x8*)(L + HG_O_QD + (16 * w + r) * 272 + (32 * kk + 8 * q) * 2), b = *(const LAS bf16x8*)(L + HG_O_ST + r * 272 + (32 * kk + 8 * q) * 2); o = mfma16(a, b, o); }
#pragma unroll
            for (int kk = 0; kk < 2; ++kk) { const bf16x8 a = *(const LAS bf16x8*)(L + HG_O_ATT + (16 * w + r) * 144 + (32 * kk + 8 * q) * 2), b = *(const LAS bf16x8*)(L + HG_O_VT + r * 144 + (32 * kk + 8 * q) * 2); o = mfma16(a, b, o); }
#pragma unroll
            for (int i = 0; i < 4; ++i) { const int t = 16 * w + 4 * q + i; const int row = c == 0 ? (t < 16 ? SEQP * n + t : -1) : SEQP * n + 16 + 64 * (c - 1) + t;
                float ss = o[i] * o[i]; ss += __shfl_xor(ss, 1); ss += __shfl_xor(ss, 2); ss += __shfl_xor(ss, 4); ss += __shfl_xor(ss, 8);
                if (row >= 0) { OH[(size_t)row * HD + 128 * h + 16 * vs + r] = (bf16)f2bf(o[i]); if (r == 0 && atom) atomic_addf(HSS + (size_t)row * 4 + h, ss); } } }
        __syncthreads();
        Sreg = accS;
        *(LAS v2u*)(L + HG_O_ST + r * 272 + (16 * w + 4 * q) * 2) = (v2u){pk2(Sreg[0], Sreg[1]), pk2(Sreg[2], Sreg[3])};
    }
#undef HG_LOAD
#pragma unroll
    for (int i = 0; i < 4; ++i) F.out[OFF_HGP + ((size_t)(n * 4 + h) * 128 + 16 * w + 4 * q + i) * 128 + 16 * vs + r] = Sreg[i];
    __syncthreads();
}
__device__ __forceinline__ void hgrn_sample_item(Frame& F, int item, bool atom = true) {
    const int h = item & 3, s = item >> 2, row = R_SAMP + s, tid = F.tid, vq = tid & 31, kg = tid >> 5;
    const bf16* Qb = (const bf16*)(F.ws + WS_Q); const bf16* Vb = (const bf16*)(F.ws + WS_V); const float* LF = (const float*)(F.ws + WS_LF);
    bf16* OH = (bf16*)(F.ws + WS_OH); float* HSS = (float*)(F.ws + WS_CTL + CB_HSS);
    LAS float* red = (LAS float*)F.lds;
    const v2u vw = *(const v2u*)(Vb + (size_t)row * HD + 128 * h + 4 * vq);
    const f32x4 v4 = (f32x4){bflo(vw.x), bfhi(vw.x), bflo(vw.y), bfhi(vw.y)};
    f32x4 o4 = (f32x4){0.f, 0.f, 0.f, 0.f};
#pragma unroll
    for (int i = 0; i < 8; ++i) { const int k = 8 * kg + i; const float f = __expf(LF[(size_t)row * HD + 128 * h + k]), kk = 1.0f - f, qk = bf2f(Qb[(size_t)row * HD + 128 * h + k]);
        const size_t off = ((size_t)(s * 4 + h) * 128 + k) * 128 + 4 * vq;
        const f32x4 sn = *(const f32x4*)(F.st_hg + off) * f + v4 * kk;
        *(f32x4*)(F.out + OFF_HGS + off) = sn; o4 += sn * qk; }
    *(LAS f32x4*)(red + kg * 128 + 4 * vq) = o4;
    __syncthreads();
    if (tid < 128) { float o = 0.f;
#pragma unroll
        for (int j = 0; j < 16; ++j) o += red[j * 128 + tid];
        OH[(size_t)row * HD + 128 * h + tid] = (bf16)f2bf(o);
        const float ss = wave_sum(o * o); if (F.lane == 0 && atom) atomic_addf(HSS + (size_t)row * 4 + h, ss); }
    __syncthreads();
}
__device__ __forceinline__ void hgrn_finalize(Frame& F) {
    const bf16* OH = (const bf16*)(F.ws + WS_OH); const bf16* G = (const bf16*)(F.ws + WS_G); const float* HSS = (const float*)(F.ws + WS_CTL + CB_HSS); bf16* MIX = (bf16*)(F.ws + WS_MIX);
    const int gt = F.vcu * 512 + F.tid, NT = F.G * 512;
    for (int idx = gt; idx < RT * 64; idx += NT) { const int row = idx >> 6, c8 = (idx & 63) * 8;
        const float rstd = __builtin_amdgcn_rsqf(ld_agent(HSS + (size_t)row * 4 + (c8 >> 7)) * (1.0f / 128.0f) + EPS);
        const v4u o = *(const v4u*)(OH + (size_t)row * HD + c8), gg = *(const v4u*)(G + (size_t)row * HD + c8);
        const f32x4 n0 = *(const f32x4*)(F.hg_ng + c8), n1 = *(const f32x4*)(F.hg_ng + c8 + 4);
        v4u w;
        w.x = pk2(bflo(o.x) * rstd * n0[0] * bflo(gg.x), bfhi(o.x) * rstd * n0[1] * bfhi(gg.x));
        w.y = pk2(bflo(o.y) * rstd * n0[2] * bflo(gg.y), bfhi(o.y) * rstd * n0[3] * bfhi(gg.y));
        w.z = pk2(bflo(o.z) * rstd * n1[0] * bflo(gg.z), bfhi(o.z) * rstd * n1[1] * bfhi(gg.z));
        w.w = pk2(bflo(o.w) * rstd * n1[2] * bflo(gg.w), bfhi(o.w) * rstd * n1[3] * bfhi(gg.w));
        *(v4u*)(MIX + (size_t)row * D + 512 + c8) = w; }
}
__device__ __forceinline__ void final_norm(Frame& F) {
    const float* SS3 = (const float*)(F.ws + WS_CTL + CB_SS3);
    const int gw = F.vcu * NWAVES + F.wave, NGW = F.G * NWAVES;
    f32x4 gg[4];
#pragma unroll
    for (int j = 0; j < 4; ++j) gg[j] = *(const f32x4*)(F.g_final + 4 * F.lane + 256 * j);
    for (int i0 = gw * 4; i0 < NB * SEQ + NS; i0 += NGW * 4) {
        float* p[4]; float rs[4]; f32x4 v[4][4];
#pragma unroll
        for (int r = 0; r < 4; ++r) { const int i = i0 + r; const int row = i < NB * SEQ ? (i >> 11) * SEQP + NMETA + (i & 2047) : R_SAMP + (i - NB * SEQ);
            p[r] = i < NB * SEQ ? F.out + (size_t)i * D : F.out + OFF_YS + (size_t)(i - NB * SEQ) * D; rs[r] = ld_agent(SS3 + row);
#pragma unroll
            for (int j = 0; j < 4; ++j) v[r][j] = *(const f32x4*)(p[r] + 4 * F.lane + 256 * j); }
#pragma unroll
        for (int r = 0; r < 4; ++r) { const float rstd = __builtin_amdgcn_rsqf(rs[r] * (1.0f / D) + EPS);
#pragma unroll
            for (int j = 0; j < 4; ++j) *(f32x4*)(p[r] + 4 * F.lane + 256 * j) = v[r][j] * rstd * gg[j]; } }
}
#ifndef PROBE_DUP
#define PROBE_DUP 0x0f
#endif
#define PD(k) (((PROBE_DUP & 0x0f) == (k)) || ((PROBE_DUP & 0x1000) && (k) != 8))
#ifndef MK_N_LAUNCHES
#define MK_N_LAUNCHES 1
#endif
constexpr int N_LAUNCHES = MK_N_LAUNCHES;
constexpr int PER_PHASE = 9;
struct Args { const float* in[28]; float* out; unsigned char* ws; int ph_lo, ph_hi, li, pad; };
__global__ void __launch_bounds__(NWAVES * 64, 2) hymba_fwd(Args args) {
    extern __shared__ __attribute__((aligned(16))) unsigned char lds[];
    Frame F;
    F.lds = (LAS unsigned char*)lds;
    F.MISC = (volatile LAS unsigned*)(F.lds + MISC_OFF);
    F.tid = threadIdx.x; F.lane = F.tid & 63; F.wave = __builtin_amdgcn_readfirstlane(F.tid >> 6);
    F.G = gridDim.x; { const int bx = blockIdx.x; F.vcu = (F.G % 8 == 0) ? (bx % 8) * (F.G / 8) + bx / 8 : bx; }
    F.ws = args.ws; F.out = args.out; F.ctl = (gu32*)(args.ws + WS_CTL);
    F.x_prompt = args.in[0]; F.x_sample = args.in[1]; F.st_s5r = args.in[2]; F.st_s5i = args.in[3]; F.st_hg = args.in[4]; F.st_cv = args.in[5]; F.meta = args.in[6];
    F.g_mix = args.in[7]; F.w_in = args.in[8]; F.lam_re = args.in[9]; F.lam_im = args.in[10]; F.log_dt = args.in[11]; F.b_re = args.in[12]; F.b_im = args.in[13];
    F.c_re = args.in[14]; F.c_im = args.in[15]; F.s5_d = args.in[16]; F.w_glu = args.in[17]; F.b_glu = args.in[18]; F.hg_lb = args.in[19]; F.hg_ng = args.in[20];
    F.w_out = args.in[21]; F.g_ffn = args.in[22]; F.w_up = args.in[23]; F.conv_w = args.in[24]; F.conv_b = args.in[25]; F.w_down = args.in[26]; F.g_final = args.in[27];
    for (int u = F.tid; u < 64; u += NWAVES * 64) ((LAS unsigned*)(F.lds + MISC_OFF))[u] = 0u;
    __syncthreads();
    XcdBarrier bar; bar.bar = (unsigned*)(F.ctl + CW_BAR); bar.x = 0; bar.st = nullptr;
    if (N_LAUNCHES != PER_PHASE) bar = xcd_barrier_post((unsigned*)(F.ctl + CW_BAR), F.MISC + 8);
#define GRID_BAR() do { if (N_LAUNCHES != PER_PHASE) xcd_barrier(bar); } while (0)
#define GRID_BAR2() xcd_barrier(bar)
    static_assert(N_LAUNCHES == 1, "this build keeps a grid barrier inside phase 2: one launch only");
    const int lo = args.ph_lo, hi = args.ph_hi;
#ifndef P2_MASK
#define P2_MASK 15
#endif
#ifndef PH_MASK
#define PH_MASK 0x1ff
#endif
#define IN(k) (((PH_MASK >> (k)) & 1) && lo <= (k) && (k) < hi)
#define BOTH(k) (IN(k) && IN((k) + 1))
    const int gw = F.vcu * NWAVES + F.wave, NGW = F.G * NWAVES;
    bf16* XN = (bf16*)(F.ws + WS_XN);

#if PD(0)
    if (IN(0)) { p0_prologue(F); __syncthreads(); }
#endif
    if (IN(0)) { p0_prologue(F); if (BOTH(0)) GRID_BAR(); }
    if (IN(1)) {
        pg8::Gemm g{XN, (const bf16*)(F.ws + WS_WIN), RT, INC, D, D, 256}; pg8::StaticOrder S; S.init(RT, INC, F.G, (int)blockIdx.x);
        EpiIn E{(bf16*)(F.ws + WS_U), (bf16*)(F.ws + WS_Q), (bf16*)(F.ws + WS_V), (bf16*)(F.ws + WS_G), (float*)(F.ws + WS_LF), (const float*)(F.ws + WS_S5F + S5F_LB)};
#if PD(1)
        pg8::gemm_phase<EpiIn, true>(F.lds + RING_OFF, g, S, E);
#endif
        pg8::gemm_phase<EpiIn, true>(F.lds + RING_OFF, g, S, E);
        if (BOTH(1)) GRID_BAR();
    }
    if (IN(2)) {
        for (int it = F.vcu; it < NB * 32; it += F.G) s5_prompt_item(F, it);
        hgrn_pre_items(F);
        for (int it = gw; it < NS * 32; it += NGW) s5_sample_item(F, it);
        for (int it = F.vcu; it < NS * 4; it += F.G) hgrn_sample_item(F, it);
        GRID_BAR2();
#if PD(2)
        for (int it = F.vcu; it < NB * 4 * 8; it += F.G) hgrn_seq_item(F, it, false);
#endif
        for (int it = F.vcu; it < NB * 4 * 8; it += F.G) hgrn_seq_item(F, it);
        if (BOTH(2)) GRID_BAR();
    }
    if (IN(3)) {
        hgrn_finalize(F);
        pg8::Gemm g{(const bf16*)(F.ws + WS_Y5), (const bf16*)(F.ws + WS_WGLU), RT, HD, HD, HD, 256}; pg8::StaticOrder S; S.init(RT, HD, F.G, (int)blockIdx.x);
        EpiGlu E{(const bf16*)(F.ws + WS_Y5), F.b_glu, (bf16*)(F.ws + WS_MIX)};
#if PD(3)
        hgrn_finalize(F);
        pg8::gemm_phase<EpiGlu, true>(F.lds + RING_OFF, g, S, E);
#endif
        pg8::gemm_phase<EpiGlu, true>(F.lds + RING_OFF, g, S, E);
        if (BOTH(3)) GRID_BAR();
    }
    if (IN(4)) {
        pg8::Gemm g{(const bf16*)(F.ws + WS_MIX), (const bf16*)(F.ws + WS_WOUT), RT, D, D, D, 256}; pg8::StaticOrder S; S.init(RT, D, F.G, (int)blockIdx.x);
        EpiOut E{F.x_prompt, F.meta, F.x_sample, F.out, (float*)(F.ws + WS_H1META), XN, (float*)(F.ws + WS_CTL + CB_SS2)};
#if PD(4)
        { EpiOut E2 = E; E2.ss = nullptr; pg8::gemm_phase<EpiOut, true>(F.lds + RING_OFF, g, S, E2); }
#endif
        pg8::gemm_phase<EpiOut, true>(F.lds + RING_OFF, g, S, E);
        if (BOTH(4)) GRID_BAR();
    }
    if (IN(5)) {
        pg8::Gemm g{XN - 2 * D, (const bf16*)(F.ws + WS_WUP), 66 * 256, UPC, D, D, 254}; pg8::StaticOrder S; S.init(66 * 256, UPC, F.G, (int)blockIdx.x);
        EpiUpGate E{(const float*)(F.ws + WS_CTL + CB_SS2), (bf16*)(F.ws + WS_GATED), F.out, F.conv_w, F.conv_b, F.st_cv, (LAS float*)(F.lds + XCH_OFF)};
#if PD(5)
        pg8::gemm_phase<EpiUpGate, true>(F.lds + RING_OFF, g, S, E);
#endif
        pg8::gemm_phase<EpiUpGate, true>(F.lds + RING_OFF, g, S, E);
        if (BOTH(5)) GRID_BAR();
    }
    if (IN(6)) { }
    if (IN(7)) {
        pg8::Gemm g{(const bf16*)(F.ws + WS_GATED), (const bf16*)(F.ws + WS_WDN), RT, D, DFF, DFF, 256}; pg8::StaticOrder S; S.init(RT, D, F.G, (int)blockIdx.x);
        EpiDown E{F.out, (float*)(F.ws + WS_H1META), (float*)(F.ws + WS_CTL + CB_SS3), nullptr};
#if PD(7)
        { EpiDown E2 = E; E2.dry = (float*)(F.ws + WS_XN); pg8::gemm_phase<EpiDown, true>(F.lds + RING_OFF, g, S, E2); }
#endif
#if PD(8)
        for (int i = 0; i < 8; ++i) GRID_BAR();
#endif
        pg8::gemm_phase<EpiDown, true>(F.lds + RING_OFF, g, S, E);
        if (BOTH(7)) GRID_BAR();
    }
    if (IN(8)) final_norm(F);
#undef IN
#undef BOTH
#undef GRID_BAR
}

extern "C" void kernel_launch(void* const* d_in, const int* in_sizes, int n_in, void* d_out, int out_size, void* d_ws, size_t ws_size, hipStream_t stream) {
    static int grid = 0;
    if (grid == 0) {
        if (n_in != 28 || out_size != (int)OUT_TOTAL || ws_size < WS_END) { fprintf(stderr, "kernel_launch: unexpected problem (n_in %d, out %d, ws %zu); nothing launched\n", n_in, out_size, ws_size); grid = -1; return; }
        int dev = 0, cus = 0, per_cu = 0;
        if (hipGetDevice(&dev) != hipSuccess || hipDeviceGetAttribute(&cus, hipDeviceAttributeMultiprocessorCount, dev) != hipSuccess) { fprintf(stderr, "kernel_launch: device query failed\n"); grid = -1; return; }
        if (hipFuncSetAttribute((const void*)hymba_fwd, hipFuncAttributeMaxDynamicSharedMemorySize, LDS_BYTES) != hipSuccess) { fprintf(stderr, "kernel_launch: hipFuncSetAttribute failed\n"); grid = -1; return; }
        if (hipOccupancyMaxActiveBlocksPerMultiprocessor(&per_cu, (const void*)hymba_fwd, NWAVES * 64, LDS_BYTES) != hipSuccess || per_cu < 1)
            fprintf(stderr, "kernel_launch: note: occupancy query reports %d workgroups per CU\n", per_cu);
        (void)hipGetLastError();
        grid = cus;
    }
    if (grid < 0) return;
    if (hipMemsetAsync((char*)d_ws + WS_CTL, 0, CTL_ZERO_BYTES, stream) != hipSuccess) { fprintf(stderr, "kernel_launch: hipMemsetAsync failed\n"); return; }
    Args a{};
    for (int i = 0; i < 28; ++i) a.in[i] = (const float*)d_in[i];
    a.out = (float*)d_out; a.ws = (unsigned char*)d_ws;
    for (int li = 0; li < N_LAUNCHES; ++li) {
        a.ph_lo = (N_LAUNCHES == PER_PHASE) ? li : 0; a.ph_hi = (N_LAUNCHES == PER_PHASE) ? li + 1 : PER_PHASE; a.li = li;
        hipLaunchKernelGGL(hymba_fwd, dim3(grid), dim3(NWAVES * 64), LDS_BYTES, stream, a);
        const hipError_t le = hipPeekAtLastError();
        if (le != hipSuccess) { fprintf(stderr, "kernel_launch: launch %d failed: %s\n", li, hipGetErrorName(le)); break; }
    }
}
```

```cpp
#include <hip/hip_runtime.h>
#include <cstdio>
#include <cstdint>
#define MK_N_LAUNCHES 1
namespace pg8 {
#define PG8_LAS __attribute__((address_space(3)))
typedef unsigned short bf16_t;
typedef short bf16x8 __attribute__((ext_vector_type(8)));
typedef float f32x4 __attribute__((ext_vector_type(4)));
typedef unsigned u32x4 __attribute__((ext_vector_type(4)));
typedef unsigned u32x2 __attribute__((ext_vector_type(2)));
constexpr int BM = 256, BK = 64, HALF = 128, HTB = HALF * BK * 2  , STAGE_BYTES = 8 * HTB, NXCD = 8, WGM = 8;

__host__ __device__ __forceinline__ int lds_byte(int r, int c) { const int st = (r >> 4) * 2 + (c >> 5), rr = r & 15, cc = c & 31, ob = rr * 64 + cc * 2; return st * 1024 + (ob ^ (((ob >> 9) & 1) << 5)); }
__host__ __device__ __forceinline__ void stage_rc(int b, int& R, int& C) { const int st = b / 1024, sb = b % 1024, swz = sb ^ (((sb >> 9) & 1) << 5); R = (st >> 1) * 16 + swz / 64; C = (st & 1) * 32 + (swz % 64) / 2; }
__host__ __device__ __forceinline__ int perm32(int rho) { const int n = rho >> 4, i = rho & 15; return 8 * (i >> 2) + 4 * n + (i & 3); }

struct Unit { int pm, pn; };
struct Gemm { const bf16_t* A; const bf16_t* Bt; int M, N, K, lda, a_tile_rows; };

struct StaticOrder {
    int nM, nN, nwg, G, c;
    __host__ __device__ void init(int M, int N, int G_, int c_) { nM = M / BM; nN = N / BM; nwg = nM * nN; G = G_; c = c_; }
    __host__ __device__ bool next(int i, Unit& u) const {
        const long L = (long)i * G + c; if (L >= nwg) return false;
        int wgid = (int)L; { const int q = nwg / NXCD, r = nwg % NXCD, xcd = wgid % NXCD, off = wgid / NXCD; wgid = (xcd < r ? xcd * (q + 1) : r * (q + 1) + (xcd - r) * q) + off; }
        const int nig = WGM * nN, gid = wgid / nig, fm = gid * WGM, gsz = (nM - fm) < WGM ? (nM - fm) : WGM;
        u.pm = fm + ((wgid % nig) % gsz); u.pn = (wgid % nig) / gsz; return true;
    }
};

__device__ __forceinline__ unsigned cvt_pk_bf16(float lo, float hi) { unsigned r; asm volatile("v_cvt_pk_bf16_f32 %0, %1, %2" : "=v"(r) : "v"(lo), "v"(hi)); return r; }

template <class Epi, bool ALIGN_EPI>
__device__ __forceinline__ void gemm_phase(PG8_LAS unsigned char* lds, const Gemm g, const StaticOrder& S, const Epi& E) {
    const int tid = threadIdx.x, wid = __builtin_amdgcn_readfirstlane(tid >> 6), lane = tid & 63, wr = wid >> 2, wc = wid & 3, fr = lane & 15, fq = lane >> 4;
    const int K = g.K, nt = K / BK, lda = g.lda;
    unsigned voffA[2], voffB[2];
#pragma unroll
    for (int i = 0; i < 2; ++i) { int R, C; stage_rc(tid * 16 + i * 8192, R, C); const int Rb = (R & ~31) + perm32(R & 31);
        voffA[i] = (unsigned)(R * lda + C) * 2u; voffB[i] = (unsigned)(Rb * K + C) * 2u; }
    const size_t kstep = (size_t)(BK * 2);
    const size_t hstepA = (size_t)HALF * lda * 2, hstepB = (size_t)HALF * K * 2;
    const size_t tstepA = (size_t)g.a_tile_rows * lda * 2, tstepB = 2 * hstepB;
    const unsigned ldsw = (unsigned)wid * 1024u;
    const int aoff = lds_byte(wr * 64 + fr, fq * 8), boff = lds_byte(wc * 32 + fr, fq * 8);
#define PG8_SA(b, h) (((b) * 2 + (h)) * HTB)
#define PG8_SB(b, h) ((4 + (b) * 2 + (h)) * HTB)
#define PG8_STAGE(bufoff, gbase, voff) do { _Pragma("unroll") for (int _i = 0; _i < 2; ++_i) \
        __builtin_amdgcn_global_load_lds((const unsigned*)((const char*)(gbase) + (voff)[_i]), (PG8_LAS unsigned*)(lds + (bufoff) + ldsw + _i * 8192), 16, 0, 0); } while (0)
#define PG8_LDA(dst, b, h) do { _Pragma("unroll") for (int m = 0; m < 4; ++m) _Pragma("unroll") for (int k = 0; k < 2; ++k) dst[m][k] = *(const PG8_LAS bf16x8*)(lds + PG8_SA(b, h) + aoff + m * 2048 + k * 1024); } while (0)
#define PG8_LDB(dst, b, h) do { _Pragma("unroll") for (int n = 0; n < 2; ++n) _Pragma("unroll") for (int k = 0; k < 2; ++k) dst[n][k] = *(const PG8_LAS bf16x8*)(lds + PG8_SB(b, h) + boff + n * 2048 + k * 1024); } while (0)
#define PG8_MMA(ai, bj, At, Bt) do { __builtin_amdgcn_s_setprio(1); _Pragma("unroll") for (int m = 0; m < 4; ++m) _Pragma("unroll") for (int n = 0; n < 2; ++n) _Pragma("unroll") for (int k = 0; k < 2; ++k) \
        acc[ai][bj][m][n] = __builtin_amdgcn_mfma_f32_16x16x32_bf16(Bt[n][k], At[m][k], acc[ai][bj][m][n], 0, 0, 0); __builtin_amdgcn_s_setprio(0); } while (0)
#define PG8_WAIT_V(n) asm volatile("s_waitcnt vmcnt(" #n ")" ::: "memory")
#define PG8_WAIT_L(n) asm volatile("s_waitcnt lgkmcnt(" #n ")" ::: "memory")
#define PG8_BAR __builtin_amdgcn_s_barrier()
#define PG8_SCHED __builtin_amdgcn_sched_barrier(0)
    Unit cur, nxt; int ui = 0;
    if (!S.next(0, cur)) return;
    f32x4 acc[2][2][4][2];
#pragma unroll
    for (int a = 0; a < 2; ++a)
#pragma unroll
        for (int b = 0; b < 2; ++b)
#pragma unroll
            for (int m = 0; m < 4; ++m)
#pragma unroll
                for (int n = 0; n < 2; ++n) acc[a][b][m][n] = (f32x4){0.f, 0.f, 0.f, 0.f};
    bf16x8 At[4][2], B0[2][2], B1[2][2];
    const char* cA = (const char*)g.A + (size_t)cur.pm * tstepA; const char* cB = (const char*)g.Bt + (size_t)cur.pn * tstepB;
    PG8_STAGE(PG8_SB(0, 0), cB, voffB); PG8_STAGE(PG8_SB(0, 1), cB + hstepB, voffB); PG8_STAGE(PG8_SA(0, 0), cA, voffA); PG8_STAGE(PG8_SA(0, 1), cA + hstepA, voffA);
    if (wr == 1) PG8_BAR;
    PG8_WAIT_V(2); PG8_BAR;
    PG8_STAGE(PG8_SB(1, 0), cB + kstep, voffB); PG8_STAGE(PG8_SA(1, 0), cA + kstep, voffA); PG8_STAGE(PG8_SB(1, 1), cB + hstepB + kstep, voffB);
    PG8_WAIT_V(6); PG8_BAR;
    for (;;) {
        const bool has_next = S.next(ui + 1, nxt);
        const char* nA = has_next ? (const char*)g.A + (size_t)nxt.pm * tstepA : cA; const char* nB = has_next ? (const char*)g.Bt + (size_t)nxt.pn * tstepB : cB;
        for (int t = 0; t < nt; t += 2) {
            const bool last = (t == nt - 2);
            const char* a1 = cA + (size_t)(t + 1) * kstep;
            const char* a2 = last ? nA : cA + (size_t)(t + 2) * kstep; const char* b2 = last ? nB : cB + (size_t)(t + 2) * kstep;
            const char* a3 = a2 + kstep; const char* b3 = b2 + kstep;
            PG8_LDB(B0, 0, 0); PG8_LDB(B1, 0, 1); PG8_SCHED; PG8_LDA(At, 0, 0); PG8_STAGE(PG8_SA(1, 1), a1 + hstepA, voffA);
            PG8_WAIT_V(8); PG8_WAIT_L(0); PG8_BAR; PG8_MMA(0, 0, At, B0); PG8_MMA(0, 1, At, B1); PG8_BAR; PG8_SCHED;
            PG8_LDA(At, 0, 1); PG8_STAGE(PG8_SB(0, 0), b2, voffB); PG8_STAGE(PG8_SB(0, 1), b2 + hstepB, voffB); PG8_STAGE(PG8_SA(0, 0), a2, voffA);
            PG8_WAIT_V(8); PG8_WAIT_L(0); PG8_BAR; PG8_MMA(1, 0, At, B0); PG8_MMA(1, 1, At, B1); PG8_BAR; PG8_SCHED;
            PG8_LDB(B0, 1, 0); PG8_LDB(B1, 1, 1); PG8_SCHED; PG8_LDA(At, 1, 0); PG8_STAGE(PG8_SA(0, 1), a2 + hstepA, voffA);
            PG8_WAIT_V(8); PG8_WAIT_L(0); PG8_BAR; PG8_MMA(0, 0, At, B0); PG8_MMA(0, 1, At, B1); PG8_BAR; PG8_SCHED;
            PG8_LDA(At, 1, 1); PG8_STAGE(PG8_SB(1, 0), b3, voffB); PG8_STAGE(PG8_SB(1, 1), b3 + hstepB, voffB); PG8_STAGE(PG8_SA(1, 0), a3, voffA);
            PG8_WAIT_V(8); PG8_WAIT_L(0); PG8_BAR; PG8_MMA(1, 0, At, B0); PG8_MMA(1, 1, At, B1); PG8_BAR; PG8_SCHED;
        }
        if constexpr (ALIGN_EPI) { if (wr == 0) PG8_BAR; }
        E(acc, cur, wr, wc, fr, fq);
        if (!has_next) break;
#pragma unroll
        for (int a = 0; a < 2; ++a)
#pragma unroll
            for (int b = 0; b < 2; ++b)
#pragma unroll
                for (int m = 0; m < 4; ++m)
#pragma unroll
                    for (int n = 0; n < 2; ++n) acc[a][b][m][n] = (f32x4){0.f, 0.f, 0.f, 0.f};
        cur = nxt; cA = nA; cB = nB; ++ui;
        if constexpr (ALIGN_EPI) { if (wr == 1) PG8_BAR; }
    }
    PG8_WAIT_V(0);
    if constexpr (!ALIGN_EPI) { if (wr == 0) PG8_BAR; }
    PG8_BAR;
#undef PG8_SA
#undef PG8_SB
#undef PG8_STAGE
#undef PG8_LDA
#undef PG8_LDB
#undef PG8_MMA
#undef PG8_WAIT_V
#undef PG8_WAIT_L
#undef PG8_BAR
#undef PG8_SCHED
}
}
using pg8::bf16x8;
constexpr int NWAVES = 8;
constexpr int D = 1024, NB = 8, SEQ = 2048, NMETA = 16, NS = 128;
constexpr int RT = 16640;
constexpr int SEQP = 2064, R_SAMP = 16512;
__device__ __forceinline__ int seq_of(int r) { return (int)__umulhi((unsigned)r, 2080903u); }
constexpr int HD = 512;
constexpr int INC = 2560, DFF = 2816, UPC = 5632;
constexpr float EPS = 1e-6f;
constexpr size_t OFF_YP = 0, OFF_YS = 16777216, OFF_S5RP = 16908288, OFF_S5IP = 16924672, OFF_HGP = 16941056, OFF_CVP = 17465344,
                 OFF_S5RS = 17510400, OFF_S5IS = 17772544, OFF_HGS = 18034688, OFF_CVS = 26423296, OUT_TOTAL = 27144192;
constexpr size_t KiB = 1024, MiB = 1u << 20;
constexpr size_t WS_CTL = 0, CTL_ZERO_BYTES = 64 * KiB;
constexpr int CW_BAR = 4096;
constexpr int SST = 16;
constexpr size_t WS_SS2 = 249 * MiB, WS_SS3 = 250 * MiB + 512 * KiB, WS_HSS = 252 * MiB, STAT_BYTES = (size_t)RT * SST * 4;
constexpr size_t WS_WIN = 2 * MiB, WS_WGLU = 7 * MiB, WS_WOUT = 7 * MiB + 512 * KiB, WS_WUP = 9 * MiB + 512 * KiB, WS_WDN = 20 * MiB + 512 * KiB;
constexpr size_t WS_S5W1 = 26 * MiB, WS_S5W2 = 32 * MiB, WS_S5F = 34 * MiB;
constexpr size_t S5F_A1 = 0, S5F_A16 = 16 * KiB, S5F_BB = 64 * KiB, S5F_LB = 384 * KiB;
constexpr size_t WS_H1META = 35 * MiB;
constexpr size_t WS_XN = 36 * MiB;
constexpr size_t ROWS512_BF16 = (size_t)RT * 512 * 2;
constexpr size_t WS_U = 68 * MiB + 512 * KiB, WS_Q = WS_U + ROWS512_BF16, WS_V = WS_Q + ROWS512_BF16, WS_G = WS_V + ROWS512_BF16, WS_LF = WS_G + ROWS512_BF16,
                 WS_Y5 = WS_LF + 2 * ROWS512_BF16, WS_OH = WS_Y5 + ROWS512_BF16, WS_MIX = WS_OH + ROWS512_BF16, WS_ZEND = WS_MIX + 2 * ROWS512_BF16;
constexpr size_t WS_GATED = WS_U;
constexpr size_t WS_END = 256 * MiB;
static_assert(WS_ZEND <= WS_END && WS_GATED + (size_t)RT * DFF * 2 <= WS_MIX && WS_XN + (size_t)RT * D * 2 <= WS_U, "d_ws map");
static_assert((CW_BAR + 3456) * 4 <= (int)CTL_ZERO_BYTES && WS_SS2 + STAT_BYTES <= WS_SS3 && WS_SS3 + STAT_BYTES <= WS_HSS && WS_HSS + STAT_BYTES <= WS_END, "ctl / stat map");

constexpr int LDS_BYTES = 163840;
constexpr int RING_OFF = 0, XCH_OFF = 131072, MISC_OFF = 163840 - 256;

#define GAS __attribute__((address_space(1)))
#define LAS __attribute__((address_space(3)))
typedef unsigned short bf16;
typedef unsigned v4u __attribute__((ext_vector_type(4)));
typedef unsigned v2u __attribute__((ext_vector_type(2)));
typedef float f32x4 __attribute__((ext_vector_type(4)));
typedef short bf16x8 __attribute__((ext_vector_type(8)));
typedef GAS unsigned gu32;
#define RLX_AGENT __ATOMIC_RELAXED, __HIP_MEMORY_SCOPE_AGENT
#define LDS_WAIT() asm volatile("s_waitcnt lgkmcnt(0)" ::: "memory")
#define VM_WAIT() asm volatile("s_waitcnt vmcnt(0)" ::: "memory")
__device__ __forceinline__ unsigned f2bf(float f) { unsigned u = __builtin_bit_cast(unsigned, f); return (u + 0x7fffu + ((u >> 16) & 1u)) >> 16; }
__device__ __forceinline__ unsigned pk2(float lo, float hi) { return f2bf(lo) | (f2bf(hi) << 16); }
__device__ __forceinline__ float bf2f(unsigned short b) { return __builtin_bit_cast(float, (unsigned)b << 16); }
__device__ __forceinline__ float bflo(unsigned w) { return __builtin_bit_cast(float, w << 16); }
__device__ __forceinline__ float bfhi(unsigned w) { return __builtin_bit_cast(float, w & 0xffff0000u); }
__device__ __forceinline__ float sigmoidf_(float x) { return __builtin_amdgcn_rcpf(1.0f + __expf(-x)); }
__device__ __forceinline__ float siluf_(float x) { return x * sigmoidf_(x); }
__device__ __forceinline__ float gelu_tanh(float y) { const float uu = 1.5957691216057308f * (y + 0.044715f * y * y * y); return y * sigmoidf_(uu); }
__device__ __forceinline__ float ld_agent(const float* p) { return __builtin_bit_cast(float, __hip_atomic_load((const unsigned*)p, RLX_AGENT)); }
__device__ __forceinline__ void atomic_addf(float* p, float v) { (void)__hip_atomic_fetch_add(p, v, RLX_AGENT); }
__device__ __forceinline__ f32x4 mfma16(bf16x8 a, bf16x8 b, f32x4 c) { return __builtin_amdgcn_mfma_f32_16x16x32_bf16(a, b, c, 0, 0, 0); }
__device__ __forceinline__ float wave_sum(float v) {
#pragma unroll
    for (int o = 1; o < 64; o <<= 1) v += __shfl_xor(v, o);
    return v;
}

#define XB_TMO      128
#define XB_XCNT(j)  (256  + 64 * (j))
#define XB_XSUB(j)  (1280 + 64 * (j))
#define XB_XGEN(j)  (2304 + 64 * (j))
#define XB_TOP      3328
#define XB_TOPGEN   3392
#define XCD_BAR_WORDS 3456
#define XB_SPIN_CAP (1u << 18)
__device__ __forceinline__ unsigned xb_ld(unsigned* p)              { return __hip_atomic_load(p, __ATOMIC_RELAXED, __HIP_MEMORY_SCOPE_AGENT); }
__device__ __forceinline__ unsigned xb_add(unsigned* p, unsigned v) { return __hip_atomic_fetch_add(p, v, __ATOMIC_RELAXED, __HIP_MEMORY_SCOPE_AGENT); }
__device__ __forceinline__ unsigned xb_xcc_id() { return (unsigned)__builtin_amdgcn_s_getreg((3 << 11) | 20) & 0xFu; }
#define XB_SPIN(cond, bar) do { unsigned _sp = 0; while (cond) { __builtin_amdgcn_s_sleep(1); \
    if ((++_sp & 255u) == 0u) { if (xb_ld(&(bar)[XB_TMO])) break; if (_sp > XB_SPIN_CAP) { atomicAdd(&(bar)[XB_TMO], 1u); break; } } } } while (0)
struct XcdBarrier { unsigned* bar; unsigned x; volatile LAS unsigned* st; };
__device__ __forceinline__ XcdBarrier xcd_barrier_post(unsigned* bar, volatile LAS unsigned* st) {
    XcdBarrier b; b.bar = bar; b.x = xb_xcc_id(); b.st = st;
    if (threadIdx.x == 0) (void)xb_add(&bar[XB_XCNT(b.x)], 1u);
    return b;
}
__device__ __forceinline__ void xcd_barrier_complete(unsigned* bar, unsigned x, unsigned& nloc, unsigned& nx) {
    const unsigned G = gridDim.x * gridDim.y * gridDim.z;
    unsigned sum, cnt, mine, sp = 0u;
    for (;;) {
        sum = 0u; cnt = 0u; mine = 0u;
#pragma unroll
        for (unsigned j = 0; j < 16; ++j) { const unsigned c = xb_ld(&bar[XB_XCNT(j)]); sum += c; cnt += (c > 0u) ? 1u : 0u; mine = (j == x) ? c : mine; }
        if (sum == G) break;
        __builtin_amdgcn_s_sleep(1);
        if ((++sp & 255u) == 0u) { if (xb_ld(&bar[XB_TMO])) break; if (sp > XB_SPIN_CAP) { atomicAdd(&bar[XB_TMO], 1u); break; } }
    }
    nloc = mine > 0u ? mine : 1u; nx = cnt > 0u ? cnt : 1u;
}
__device__ __forceinline__ void xcd_barrier(const XcdBarrier& b) {
    asm volatile("s_waitcnt vmcnt(0)" ::: "memory");
    __syncthreads();
    if (threadIdx.x == 0) {
        unsigned* bar = b.bar;
        __builtin_amdgcn_s_waitcnt(0);
        unsigned nloc = b.st[0], nx = b.st[1];
        if (nloc == 0u) { xcd_barrier_complete(bar, b.x, nloc, nx); b.st[0] = nloc; b.st[1] = nx; }
        const unsigned old = xb_add(&bar[XB_XSUB(b.x)], 1u);
        const unsigned gen = old / nloc;
        if (old + 1u == (gen + 1u) * nloc) {
            __builtin_amdgcn_fence(__ATOMIC_RELEASE, "agent");
            asm volatile("s_waitcnt vmcnt(0)" ::: "memory");
            const unsigned og = xb_add(&bar[XB_TOP], 1u);
            const unsigned tg = og / nx;
            if (og + 1u == (tg + 1u) * nx) xb_add(&bar[XB_TOPGEN], 1u);
            else XB_SPIN(xb_ld(&bar[XB_TOPGEN]) == tg, bar);
            __builtin_amdgcn_fence(__ATOMIC_ACQUIRE, "agent");
            xb_add(&bar[XB_XGEN(b.x)], 1u);
            asm volatile("s_waitcnt vmcnt(0)" ::: "memory");
        } else {
            XB_SPIN(xb_ld(&bar[XB_XGEN(b.x)]) == gen, bar);
            __builtin_amdgcn_fence(__ATOMIC_ACQUIRE, "agent");
            asm volatile("s_waitcnt vmcnt(0)" ::: "memory");
        }
    }
    __syncthreads();
}

struct Frame {
    LAS unsigned char* lds;
    volatile LAS unsigned* MISC;
    gu32* ctl;
    int tid, lane, wave;
    int vcu, G;
    unsigned char* ws; float* out;
    const float *x_prompt, *x_sample, *st_s5r, *st_s5i, *st_hg, *st_cv, *meta, *g_mix, *w_in, *lam_re, *lam_im, *log_dt, *b_re, *b_im, *c_re, *c_im, *s5_d,
                *w_glu, *b_glu, *hg_lb, *hg_ng, *w_out, *g_ffn, *w_up, *conv_w, *conv_b, *w_down, *g_final;
};
#define EPI_ARGS const f32x4 (&acc)[2][2][4][2], const pg8::Unit& u, int wr, int wc, int fr, int fq

__device__ __forceinline__ const float* h0_src(int row, const float* xp, const float* meta, const float* xs) {
    if (row >= R_SAMP) return xs + (size_t)(row - R_SAMP) * D;
    const int n = seq_of(row), s = row - n * SEQP;
    return s < NMETA ? meta + (size_t)s * D : xp + (size_t)(n * SEQ + s - NMETA) * D;
}
__device__ __forceinline__ float* h1_dst(int row, float* out, float* h1meta) {
    if (row >= R_SAMP) return out + OFF_YS + (size_t)(row - R_SAMP) * D;
    const int n = seq_of(row), s = row - n * SEQP;
    return s < NMETA ? h1meta + (size_t)(n * NMETA + s) * D : out + (size_t)(n * SEQ + s - NMETA) * D;
}
struct EpiIn {
    bf16 *U, *Q, *V, *G; float* LF; const float* lb;
    __device__ __forceinline__ void operator()(EPI_ARGS) const {
        const int seg = u.pn >> 1, cb = (u.pn & 1) * 256 + wc * 32 + 8 * fq, row0 = u.pm * 256 + wr * 64 + fr;
        bf16* dstb = seg == 0 ? U : (seg == 1 ? Q : (seg == 3 ? V : G));
#pragma unroll
        for (int ai = 0; ai < 2; ++ai)
#pragma unroll
            for (int m = 0; m < 4; ++m) { const size_t row = (size_t)(row0 + ai * 128 + m * 16);
#pragma unroll
                for (int bj = 0; bj < 2; ++bj) { const int col = cb + bj * 128; f32x4 v0 = acc[ai][bj][m][0], v1 = acc[ai][bj][m][1];
                    if (seg == 2) {
                        const f32x4 l0 = *(const f32x4*)(lb + col), l1 = *(const f32x4*)(lb + col + 4); f32x4 o0, o1;
#pragma unroll
                        for (int j = 0; j < 4; ++j) { o0[j] = __logf(l0[j] + (1.f - l0[j]) * sigmoidf_(v0[j])); o1[j] = __logf(l1[j] + (1.f - l1[j]) * sigmoidf_(v1[j])); }
                        *(f32x4*)(LF + row * HD + col) = o0; *(f32x4*)(LF + row * HD + col + 4) = o1;
                    } else {
                        if (seg == 4) {
#pragma unroll
                            for (int j = 0; j < 4; ++j) { v0[j] = siluf_(v0[j]); v1[j] = siluf_(v1[j]); } }
                        v4u w; w.x = pk2(v0[0], v0[1]); w.y = pk2(v0[2], v0[3]); w.z = pk2(v1[0], v1[1]); w.w = pk2(v1[2], v1[3]);
                        *(v4u*)(dstb + row * HD + col) = w;
                    } } }
    }
};
struct EpiGlu {
    const bf16* Y5; const float* bias; bf16* MIX;
    __device__ __forceinline__ void operator()(EPI_ARGS) const {
        const int col0 = u.pn * 256 + wc * 32 + 8 * fq, row0 = u.pm * 256 + wr * 64 + fr;
#pragma unroll
        for (int ai = 0; ai < 2; ++ai)
#pragma unroll
            for (int m = 0; m < 4; ++m) { const size_t row = (size_t)(row0 + ai * 128 + m * 16);
#pragma unroll
                for (int bj = 0; bj < 2; ++bj) { const int col = col0 + bj * 128; const f32x4 v0 = acc[ai][bj][m][0], v1 = acc[ai][bj][m][1];
                    const f32x4 b0 = *(const f32x4*)(bias + col), b1 = *(const f32x4*)(bias + col + 4);
                    const v4u y = *(const v4u*)(Y5 + row * HD + col);
                    v4u w;
                    w.x = pk2(bflo(y.x) * sigmoidf_(v0[0] + b0[0]), bfhi(y.x) * sigmoidf_(v0[1] + b0[1]));
                    w.y = pk2(bflo(y.y) * sigmoidf_(v0[2] + b0[2]), bfhi(y.y) * sigmoidf_(v0[3] + b0[3]));
                    w.z = pk2(bflo(y.z) * sigmoidf_(v1[0] + b1[0]), bfhi(y.z) * sigmoidf_(v1[1] + b1[1]));
                    w.w = pk2(bflo(y.w) * sigmoidf_(v1[2] + b1[2]), bfhi(y.w) * sigmoidf_(v1[3] + b1[3]));
                    *(v4u*)(MIX + row * D + col) = w; } }
    }
};
struct EpiOut {
    const float *xp, *meta, *xs; float *out, *h1meta; bf16* H1B; float* ss;
    __device__ __forceinline__ void operator()(EPI_ARGS) const {
        const int col0 = u.pn * 256 + wc * 32 + 8 * fq, row0 = u.pm * 256 + wr * 64 + fr;
#pragma unroll
        for (int ai = 0; ai < 2; ++ai)
#pragma unroll
            for (int m = 0; m < 4; ++m) { const int row = row0 + ai * 128 + m * 16;
                const float* src = h0_src(row, xp, meta, xs);
                float* dst = h1_dst(row, out, h1meta);
                float s = 0.f;
#pragma unroll
                for (int bj = 0; bj < 2; ++bj) { const int col = col0 + bj * 128;
                    const f32x4 h0 = *(const f32x4*)(src + col) + acc[ai][bj][m][0], h1 = *(const f32x4*)(src + col + 4) + acc[ai][bj][m][1];
                    *(f32x4*)(dst + col) = h0; *(f32x4*)(dst + col + 4) = h1;
                    v4u w; w.x = pk2(h0[0], h0[1]); w.y = pk2(h0[2], h0[3]); w.z = pk2(h1[0], h1[1]); w.w = pk2(h1[2], h1[3]);
                    *(v4u*)(H1B + (size_t)row * D + col) = w;
                    s += (h0[0] * h0[0] + h0[1] * h0[1]) + (h0[2] * h0[2] + h0[3] * h0[3]) + (h1[0] * h1[0] + h1[1] * h1[1]) + (h1[2] * h1[2] + h1[3] * h1[3]); }
                s += __shfl_xor(s, 16); s += __shfl_xor(s, 32);
                if (fq == 0 && ss) atomic_addf(ss + (size_t)row * SST, s); }
    }
};
struct EpiUpGate {
    const float* ss; bf16* GATED; float* out; const float *conv_w, *conv_b, *st_cv; LAS float* xch;
    __device__ __forceinline__ void operator()(EPI_ARGS) const {
        const int lane = fq * 16 + fr, cl = wc * 32 + 8 * fq, col = u.pn * 128 + cl;
        const int rbase = u.pm * 254 - 2 + wr * 64 + fr;
        f32x4 cb[2], w0[2], w1[2], w2[2];
#pragma unroll
        for (int n = 0; n < 2; ++n) { cb[n] = *(const f32x4*)(conv_b + col + 4 * n); w0[n] = *(const f32x4*)(conv_w + col + 4 * n); w1[n] = *(const f32x4*)(conv_w + DFF + col + 4 * n); w2[n] = *(const f32x4*)(conv_w + 2 * DFF + col + 4 * n); }
        float rstd[2][4];
#pragma unroll
        for (int ai = 0; ai < 2; ++ai)
#pragma unroll
            for (int m = 0; m < 4; ++m) { int row = rbase + ai * 128 + m * 16; row = row < 0 ? 0 : (row >= RT ? RT - 1 : row); rstd[ai][m] = __builtin_amdgcn_rsqf(ld_agent(ss + (size_t)row * SST) * (1.0f / D) + EPS); }
        if (fr >= 14) {
#pragma unroll
            for (int ai = 0; ai < 2; ++ai)
#pragma unroll
                for (int n = 0; n < 2; ++n) *(LAS f32x4*)(xch + ((ai * 2 + wr) * 2 + (fr - 14)) * 128 + cl + 4 * n) = acc[ai][0][3][n] * rstd[ai][3];
        }
        asm volatile("s_waitcnt lgkmcnt(0)" ::: "memory"); __builtin_amdgcn_s_barrier(); asm volatile("" ::: "memory");
        const int src1 = (lane & 48) | ((fr - 1) & 15), src2 = (lane & 48) | ((fr - 2) & 15);
#pragma unroll
        for (int ai = 0; ai < 2; ++ai) {
            int pb = ai * 2 + wr - 1; pb = pb < 0 ? 0 : pb;
            f32x4 r1p[2], r2p[2];
#pragma unroll
            for (int n = 0; n < 2; ++n) { r1p[n] = *(const LAS f32x4*)(xch + (pb * 2 + 1) * 128 + cl + 4 * n); r2p[n] = *(const LAS f32x4*)(xch + (pb * 2 + (fr & 1)) * 128 + cl + 4 * n); }
#pragma unroll
            for (int m = 0; m < 4; ++m) {
                const int i = ai * 128 + wr * 64 + m * 16 + fr, row = rbase + ai * 128 + m * 16;
                f32x4 a[2], v[2], p1[2], p2[2], c1[2], c2[2];
#pragma unroll
                for (int n = 0; n < 2; ++n) { a[n] = acc[ai][0][m][n] * rstd[ai][m]; v[n] = acc[ai][1][m][n] * rstd[ai][m];
#pragma unroll
                    for (int j = 0; j < 4; ++j) { c1[n][j] = __shfl(a[n][j], src1); c2[n][j] = __shfl(a[n][j], src2); }
                    p1[n] = fr == 0 ? r1p[n] : c1[n]; p2[n] = fr < 2 ? r2p[n] : c2[n];
                    r1p[n] = c1[n]; r2p[n] = c2[n]; }
                if (i >= 2 && row < RT) {
                    float* cv = nullptr;
                    if (row >= R_SAMP) { const int sm = row - R_SAMP; const float* st = st_cv + (size_t)(sm * 2) * DFF + col;
#pragma unroll
                        for (int n = 0; n < 2; ++n) { p2[n] = *(const f32x4*)(st + 4 * n); p1[n] = *(const f32x4*)(st + DFF + 4 * n); *(f32x4*)(out + OFF_CVS + (size_t)(sm * 2) * DFF + col + 4 * n) = p1[n]; }
                        cv = out + OFF_CVS + (size_t)(sm * 2 + 1) * DFF + col;
                    } else { const int nn = seq_of(row), sq = row - nn * SEQP;
                        if (sq == 0) { p1[0] = (f32x4){0.f, 0.f, 0.f, 0.f}; p1[1] = p1[0]; }
                        if (sq <= 1) { p2[0] = (f32x4){0.f, 0.f, 0.f, 0.f}; p2[1] = p2[0]; }
                        if (sq >= SEQP - 2) cv = out + OFF_CVP + (size_t)(nn * 2 + sq - (SEQP - 2)) * DFF + col; }
                    if (cv) { *(f32x4*)cv = a[0]; *(f32x4*)(cv + 4) = a[1]; }
                    float o[8];
#pragma unroll
                    for (int n = 0; n < 2; ++n)
#pragma unroll
                        for (int j = 0; j < 4; ++j) { const float cc = cb[n][j] + w0[n][j] * p2[n][j] + w1[n][j] * p1[n][j] + w2[n][j] * a[n][j]; o[4 * n + j] = siluf_(cc) * v[n][j]; }
                    v4u w; w.x = pk2(o[0], o[1]); w.y = pk2(o[2], o[3]); w.z = pk2(o[4], o[5]); w.w = pk2(o[6], o[7]);
                    *(v4u*)(GATED + (size_t)row * DFF + col) = w; }
            }
        }
    }
};
struct EpiDown {
    float *out, *h1meta; float* ss; float* dry;
    __device__ __forceinline__ void operator()(EPI_ARGS) const {
        const int col0 = u.pn * 256 + wc * 32 + 8 * fq, row0 = u.pm * 256 + wr * 64 + fr;
#pragma unroll
        for (int ai = 0; ai < 2; ++ai)
#pragma unroll
            for (int m = 0; m < 4; ++m) { const int row = row0 + ai * 128 + m * 16;
                float* dst = h1_dst(row, out, h1meta);
                float s = 0.f;
#pragma unroll
                for (int bj = 0; bj < 2; ++bj) { const int col = col0 + bj * 128;
                    const f32x4 h0 = *(const f32x4*)(dst + col) + acc[ai][bj][m][0], h1 = *(const f32x4*)(dst + col + 4) + acc[ai][bj][m][1];
                    float* wp = dry ? dry + (((size_t)row * D + col) & 0x7FFFF8u) : dst + col;
                    *(f32x4*)(wp) = h0; *(f32x4*)(wp + 4) = h1;
                    s += (h0[0] * h0[0] + h0[1] * h0[1]) + (h0[2] * h0[2] + h0[3] * h0[3]) + (h1[0] * h1[0] + h1[1] * h1[1]) + (h1[2] * h1[2] + h1[3] * h1[3]); }
                s += __shfl_xor(s, 16); s += __shfl_xor(s, 32);
                if (fq == 0 && !dry) atomic_addf(ss + (size_t)row * SST, s); }
    }
};
__device__ __forceinline__ void p0_transpose_item(const float* W, int K, int N, bf16* WT, const float* ksc, LAS float* scr, int item, int lane, bool upmap = false) {
    const int nblk = N / 64, kb = item / nblk, nb = item % nblk, k0 = 64 * kb, n0 = 64 * nb;
    const int d0 = !upmap ? n0 : (n0 < DFF ? 256 * (n0 >> 7) + (n0 & 127) : 256 * ((n0 - DFF) >> 7) + 128 + ((n0 - DFF) & 127));
    const int ks = lane >> 4, n4 = (lane & 15) * 4;
    f32x4 v[16]; float sc[16];
#pragma unroll
    for (int i = 0; i < 16; ++i) { const int kk = 4 * i + ks; v[i] = *(const GAS f32x4*)(W + (size_t)(k0 + kk) * N + n0 + n4); sc[i] = ksc ? ksc[k0 + kk] : 1.0f; }
#pragma unroll
    for (int i = 0; i < 16; ++i) { const int kk = 4 * i + ks; LAS float* d = scr + kk * 65 + n4; d[0] = v[i].x * sc[i]; d[1] = v[i].y * sc[i]; d[2] = v[i].z * sc[i]; d[3] = v[i].w * sc[i]; }
    LDS_WAIT(); asm volatile("" ::: "memory");
    const int c = lane & 7;
#pragma unroll
    for (int j = 0; j < 8; ++j) { const int n = (lane >> 3) + 8 * j; const LAS float* q = scr + (8 * c) * 65 + n;
        v4u o; o.x = pk2(q[0 * 65], q[1 * 65]); o.y = pk2(q[2 * 65], q[3 * 65]); o.z = pk2(q[4 * 65], q[5 * 65]); o.w = pk2(q[6 * 65], q[7 * 65]);
        *(GAS v4u*)(WT + (size_t)(d0 + n) * K + k0 + 8 * c) = o; }
    LDS_WAIT(); asm volatile("" ::: "memory");
}
template <int NR>
__device__ __forceinline__ void rms_rows_to_bf16(int lane, const float* const (&xrow)[NR], bf16* const (&orow)[NR]) {
    f32x4 v[NR][4]; float s[NR];
#pragma unroll
    for (int r = 0; r < NR; ++r) { const GAS f32x4* xr = (const GAS f32x4*)xrow[r] + lane;
#pragma unroll
        for (int j = 0; j < 4; ++j) v[r][j] = xr[64 * j]; }
#pragma unroll
    for (int r = 0; r < NR; ++r) { s[r] = 0.f;
#pragma unroll
        for (int j = 0; j < 4; ++j) s[r] += (v[r][j].x * v[r][j].x + v[r][j].y * v[r][j].y) + (v[r][j].z * v[r][j].z + v[r][j].w * v[r][j].w); }
#pragma unroll
    for (int o = 1; o < 64; o <<= 1) {
#pragma unroll
        for (int r = 0; r < NR; ++r) s[r] += __shfl_xor(s[r], o); }
#pragma unroll
    for (int r = 0; r < NR; ++r) { const float rstd = 1.0f / sqrtf(s[r] * (1.f / D) + EPS);
        GAS unsigned long long* o8 = (GAS unsigned long long*)orow[r] + lane;
#pragma unroll
        for (int j = 0; j < 4; ++j) o8[64 * j] = (unsigned long long)pk2(v[r][j].x * rstd, v[r][j].y * rstd) | ((unsigned long long)pk2(v[r][j].z * rstd, v[r][j].w * rstd) << 32); }
}
__device__ __forceinline__ void s5_precompute_item(Frame& F, int item) {
    const int g = item >> 3, b = item & 7;
    LAS float* Ap = (LAS float*)F.lds;
    LAS float* Bb = Ap + 2176;
    LAS float* Cc = Bb + 2048;
    LAS float* Kt = Cc + 2048;
    const int tid = F.tid;
    float* A1 = (float*)(F.ws + WS_S5F + S5F_A1); float* A16 = (float*)(F.ws + WS_S5F + S5F_A16); float* BBf = (float*)(F.ws + WS_S5F + S5F_BB);
    const float dt = expf(F.log_dt[g]);
    for (int idx = tid; idx < 17 * 64; idx += 512) { const int j = idx >> 6, p = idx & 63; const float lr = F.lam_re[g * 64 + p], li = F.lam_im[g * 64 + p];
        const double TWO_PI = 6.283185307179586476925286766559;
        const float mag = expf(lr * dt * (float)j);
        double rev = ((double)li * (double)dt * (double)j) / TWO_PI; rev -= rint(rev);
        const float ang = (float)(rev * TWO_PI);
        Ap[idx * 2] = mag * cosf(ang); Ap[idx * 2 + 1] = mag * sinf(ang); }
    for (int idx = tid; idx < 1024; idx += 512) { const int co = idx >> 6, p = idx & 63; Cc[idx * 2] = F.c_re[(g * 16 + co) * 64 + p]; Cc[idx * 2 + 1] = F.c_im[(g * 16 + co) * 64 + p]; }
    __syncthreads();
    for (int idx = tid; idx < 1024; idx += 512) { const int p = idx >> 4, c = idx & 15; const float lr = F.lam_re[g * 64 + p], li = F.lam_im[g * 64 + p];
        const float ar = Ap[(64 + p) * 2], ai = Ap[(64 + p) * 2 + 1];
        const float nr = ar - 1.0f, den = lr * lr + li * li, cr = (nr * lr + ai * li) / den, ci = (ai * lr - nr * li) / den;
        const float bre = F.b_re[(g * 64 + p) * 16 + c], bim = F.b_im[(g * 64 + p) * 16 + c];
        const float xr = cr * bre - ci * bim, xi = cr * bim + ci * bre;
        Bb[idx * 2] = xr; Bb[idx * 2 + 1] = xi;
        if (b == 0) { BBf[((g * 64 + p) * 16 + c) * 2] = xr; BBf[((g * 64 + p) * 16 + c) * 2 + 1] = xi;
            if (c == 0) { A1[(g * 64 + p) * 2] = ar; A1[(g * 64 + p) * 2 + 1] = ai; A16[(g * 64 + p) * 2] = Ap[(16 * 64 + p) * 2]; A16[(g * 64 + p) * 2 + 1] = Ap[(16 * 64 + p) * 2 + 1]; } } }
    __syncthreads();
    { const int jl = tid >> 8, co = (tid >> 4) & 15, ci = tid & 15, j = 2 * b + jl; float kv = 0.f;
        for (int p = 0; p < 64; ++p) { const float cr = Cc[(co * 64 + p) * 2], cim = Cc[(co * 64 + p) * 2 + 1], ar = Ap[(j * 64 + p) * 2], ai = Ap[(j * 64 + p) * 2 + 1];
            const float car = cr * ar - cim * ai, cai = cr * ai + cim * ar; kv += car * Bb[(p * 16 + ci) * 2] - cai * Bb[(p * 16 + ci) * 2 + 1]; }
        if (j == 0 && co == ci) kv += F.s5_d[g * 16 + co];
        Kt[tid] = kv; }
    __syncthreads();
    bf16* W1 = (bf16*)(F.ws + WS_S5W1) + (size_t)g * 384 * 256; bf16* W2 = (bf16*)(F.ws + WS_S5W2) + (size_t)g * 256 * 128;
    for (int idx = tid; idx < 2 * 16 * 128; idx += 512) { const int jl = idx >> 11, d = (idx >> 7) & 15, co = (idx >> 3) & 15, cp = idx & 7, j = 2 * b + jl;
        if (d + j < 16) { const int s = d, t = d + j;
            *(unsigned*)(W1 + (size_t)(t * 16 + co) * 256 + s * 16 + 2 * cp) = pk2(Kt[jl * 256 + co * 16 + 2 * cp], Kt[jl * 256 + co * 16 + 2 * cp + 1]);
            if (j >= 1) *(unsigned*)(W1 + (size_t)(s * 16 + co) * 256 + t * 16 + 2 * cp) = 0u; } }
    for (int idx = tid; idx < 16 * 128; idx += 512) { const int pp = 16 * b + (idx >> 7), k = (idx & 127) * 2, s = k >> 4, ci = k & 15, p = pp & 63;
        const float ar = Ap[((15 - s) * 64 + p) * 2], ai = Ap[((15 - s) * 64 + p) * 2 + 1];
        const float b0r = Bb[(p * 16 + ci) * 2], b0i = Bb[(p * 16 + ci) * 2 + 1], b1r = Bb[(p * 16 + ci + 1) * 2], b1i = Bb[(p * 16 + ci + 1) * 2 + 1];
        const float v0 = pp < 64 ? ar * b0r - ai * b0i : ar * b0i + ai * b0r, v1 = pp < 64 ? ar * b1r - ai * b1i : ar * b1i + ai * b1r;
        *(unsigned*)(W1 + (size_t)(256 + pp) * 256 + k) = pk2(v0, v1); }
    for (int idx = tid; idx < 32 * 64; idx += 512) { const int n = 32 * b + (idx >> 6), kq = (idx & 63) * 2, t = n >> 4, co = n & 15; float v[2];
#pragma unroll
        for (int e = 0; e < 2; ++e) { const int pp = kq + e, p = pp & 63; const float cr = Cc[(co * 64 + p) * 2], cim = Cc[(co * 64 + p) * 2 + 1], ar = Ap[((t + 1) * 64 + p) * 2], ai = Ap[((t + 1) * 64 + p) * 2 + 1];
            v[e] = pp < 64 ? (cr * ar - cim * ai) : -(cr * ai + cim * ar); }
        *(unsigned*)(W2 + (size_t)n * 128 + kq) = pk2(v[0], v[1]); }
    __syncthreads();
}
__device__ __forceinline__ void p0_prologue(Frame& F) {
    { v4u* z = (v4u*)(F.ws + WS_SS2); const v4u zero = (v4u){0u, 0u, 0u, 0u};
      for (size_t i = (size_t)F.vcu * 512 + F.tid; i < (WS_HSS + STAT_BYTES - WS_SS2) / 16; i += (size_t)F.G * 512) z[i] = zero; }
    for (int it = F.vcu; it < 256; it += F.G) s5_precompute_item(F, it);
    if (F.vcu == 32 % F.G) {
        float* LB = (float*)(F.ws + WS_S5F + S5F_LB); const float a0 = F.hg_lb[F.tid], a1 = F.hg_lb[512 + F.tid], mx = fmaxf(a0, a1), e0 = expf(a0 - mx), e1 = expf(a1 - mx); LB[F.tid] = e0 / (e0 + e1); }
    LAS float* scr = (LAS float*)(F.lds + RING_OFF + F.wave * 16896);
    const int gw = F.vcu * NWAVES + F.wave, NGW = F.G * NWAVES;
    constexpr int I_IN = (D / 64) * (INC / 64), I_GLU = (HD / 64) * (HD / 64), I_OUT = (D / 64) * (D / 64), I_UP = (D / 64) * (UPC / 64), I_DN = (DFF / 64) * (D / 64);
    constexpr int NITEMS = I_IN + I_GLU + I_OUT + I_UP + I_DN;
    for (int it = gw; it < NITEMS; it += NGW) {
        int r = it;
        if (r < I_IN) { p0_transpose_item(F.w_in, D, INC, (bf16*)(F.ws + WS_WIN), F.g_mix, scr, r, F.lane); continue; } r -= I_IN;
        if (r < I_GLU) { p0_transpose_item(F.w_glu, HD, HD, (bf16*)(F.ws + WS_WGLU), nullptr, scr, r, F.lane); continue; } r -= I_GLU;
        if (r < I_OUT) { p0_transpose_item(F.w_out, D, D, (bf16*)(F.ws + WS_WOUT), nullptr, scr, r, F.lane); continue; } r -= I_OUT;
        if (r < I_UP) { p0_transpose_item(F.w_up, D, UPC, (bf16*)(F.ws + WS_WUP), F.g_ffn, scr, r, F.lane, true); continue; } r -= I_UP;
        p0_transpose_item(F.w_down, DFF, D, (bf16*)(F.ws + WS_WDN), nullptr, scr, r, F.lane);
    }
    bf16* XN = (bf16*)(F.ws + WS_XN);
    for (int m0 = gw * 4; m0 < RT; m0 += NGW * 4) {
        const float* src[4]; bf16* dst[4];
#pragma unroll
        for (int r = 0; r < 4; ++r) { const int m = m0 + r;
            src[r] = h0_src(m, F.x_prompt, F.meta, F.x_sample);
            dst[r] = XN + (size_t)m * D; }
        rms_rows_to_bf16<4>(F.lane, src, dst);
    }
}

__device__ __forceinline__ void s5_prompt_item(Frame& F, int item) {
    const int g = item & 31, n = item >> 5;
    LAS unsigned char* R1 = F.lds;
    LAS float* R2 = (LAS float*)(F.lds + 76032);
    int tid = F.tid; asm volatile("" : "+v"(tid));
    const int lane = tid & 63, w = F.wave, r = lane & 15, q = lane >> 4;
    const bf16* U = (const bf16*)(F.ws + WS_U);
#pragma unroll
    for (int i = 0; i < 9; ++i) { const int idx = tid + 512 * i, c = idx >> 5, pc = idx & 31, s = pc >> 1, half = pc & 1, cc = c < 128 ? c : 128;
        const int grow = SEQP * n + 16 * cc + s;
        const v4u val = *(const v4u*)(U + (size_t)grow * HD + 16 * g + 8 * half);
        *(LAS v4u*)(R1 + c * 528 + pc * 16) = val; }
    __syncthreads();
    const bf16* W1 = (const bf16*)(F.ws + WS_S5W1) + (size_t)g * 384 * 256; const bf16* W2 = (const bf16*)(F.ws + WS_S5W2) + (size_t)g * 256 * 128;
    f32x4 acc0[9], acc1[9], acc2[9];
#pragma unroll
    for (int mt = 0; mt < 9; ++mt) { acc0[mt] = (f32x4){0.f, 0.f, 0.f, 0.f}; acc1[mt] = acc0[mt]; acc2[mt] = acc0[mt]; }
#pragma unroll 1
    for (int kk = 0; kk < 8; ++kk) {
        const bool need0 = (2 * kk <= w);
        const bool need1 = (2 * kk <= w + 8);
        const bf16x8 b2 = *(const bf16x8*)(W1 + (size_t)(16 * (16 + w) + r) * 256 + 32 * kk + 8 * q);
        bf16x8 b0 = b2, b1 = b2;
        if (need0) b0 = *(const bf16x8*)(W1 + (size_t)(16 * w + r) * 256 + 32 * kk + 8 * q);
        if (need1) b1 = *(const bf16x8*)(W1 + (size_t)(16 * (w + 8) + r) * 256 + 32 * kk + 8 * q);
#pragma unroll
        for (int mt = 0; mt < 9; ++mt) { const bf16x8 a = *(const LAS bf16x8*)(R1 + (16 * mt + r) * 528 + (32 * kk + 8 * q) * 2);
            acc2[mt] = mfma16(a, b2, acc2[mt]);
            if (need0) acc0[mt] = mfma16(a, b0, acc0[mt]);
            if (need1) acc1[mt] = mfma16(a, b1, acc1[mt]); }
    }
#pragma unroll
    for (int mt = 0; mt < 9; ++mt)
#pragma unroll
        for (int i = 0; i < 4; ++i) R2[(16 * mt + 4 * q + i) * 132 + 16 * w + r] = acc2[mt][i];
    __syncthreads();
    if (w == 0) {
        const float* A16 = (const float*)(F.ws + WS_S5F + S5F_A16); const float ar = A16[(g * 64 + lane) * 2], ai = A16[(g * 64 + lane) * 2 + 1];
        float hr = 0.f, hi = 0.f;
        for (int c0 = 0; c0 < 136; c0 += 8) {
            float lr[8], li[8];
#pragma unroll
            for (int j = 0; j < 8; ++j) { lr[j] = R2[(c0 + j) * 132 + lane]; li[j] = R2[(c0 + j) * 132 + 64 + lane]; }
#pragma unroll
            for (int j = 0; j < 8; ++j) { const int c = c0 + j;
                if (c <= 128) {
                    *(LAS bf16*)(R1 + c * 272 + lane * 2) = (bf16)f2bf(hr); *(LAS bf16*)(R1 + c * 272 + 128 + lane * 2) = (bf16)f2bf(hi);
                    const float nr = ar * hr - ai * hi + lr[j], ni = ar * hi + ai * hr + li[j]; hr = nr; hi = ni;
                } else { *(LAS bf16*)(R1 + c * 272 + lane * 2) = 0; *(LAS bf16*)(R1 + c * 272 + 128 + lane * 2) = 0; } }
        }
#pragma unroll
        for (int c = 136; c < 144; ++c) { *(LAS bf16*)(R1 + c * 272 + lane * 2) = 0; *(LAS bf16*)(R1 + c * 272 + 128 + lane * 2) = 0; }
        F.out[OFF_S5RP + (size_t)(n * 32 + g) * 64 + lane] = hr; F.out[OFF_S5IP + (size_t)(n * 32 + g) * 64 + lane] = hi;
    }
    __syncthreads();
#pragma unroll 1
    for (int kk = 0; kk < 4; ++kk) {
        const bf16x8 b0 = *(const bf16x8*)(W2 + (size_t)(16 * w + r) * 128 + 32 * kk + 8 * q), b1 = *(const bf16x8*)(W2 + (size_t)(16 * (w + 8) + r) * 128 + 32 * kk + 8 * q);
#pragma unroll
        for (int mt = 0; mt < 9; ++mt) { const bf16x8 a = *(const LAS bf16x8*)(R1 + (16 * mt + r) * 272 + (32 * kk + 8 * q) * 2);
            acc0[mt] = mfma16(a, b0, acc0[mt]); acc1[mt] = mfma16(a, b1, acc1[mt]); }
    }
    bf16* Y5 = (bf16*)(F.ws + WS_Y5);
#pragma unroll
    for (int mt = 0; mt < 9; ++mt)
#pragma unroll
        for (int i = 0; i < 4; ++i) { const int c = 16 * mt + 4 * q + i;
            if (c <= 128) { const int rb = SEQP * n + 16 * c;
                Y5[(size_t)(rb + w) * HD + 16 * g + r] = (bf16)f2bf(gelu_tanh(acc0[mt][i]));
                Y5[(size_t)(rb + w + 8) * HD + 16 * g + r] = (bf16)f2bf(gelu_tanh(acc1[mt][i])); } }
    __syncthreads();
}
__device__ __forceinline__ void s5_sample_item(Frame& F, int item) {
    const int g = item & 31, s = item >> 5, lane = F.lane, row = R_SAMP + s;
    const bf16* U = (const bf16*)(F.ws + WS_U); bf16* Y5 = (bf16*)(F.ws + WS_Y5);
    const float* A1 = (const float*)(F.ws + WS_S5F + S5F_A1); const float* BBf = (const float*)(F.ws + WS_S5F + S5F_BB);
    const v4u u0 = *(const v4u*)(U + (size_t)row * HD + 16 * g), u1 = *(const v4u*)(U + (size_t)row * HD + 16 * g + 8);
    float uu[16]; uu[0] = bflo(u0.x); uu[1] = bfhi(u0.x); uu[2] = bflo(u0.y); uu[3] = bfhi(u0.y); uu[4] = bflo(u0.z); uu[5] = bfhi(u0.z); uu[6] = bflo(u0.w); uu[7] = bfhi(u0.w);
    uu[8] = bflo(u1.x); uu[9] = bfhi(u1.x); uu[10] = bflo(u1.y); uu[11] = bfhi(u1.y); uu[12] = bflo(u1.z); uu[13] = bfhi(u1.z); uu[14] = bflo(u1.w); uu[15] = bfhi(u1.w);
    float xr = 0.f, xi = 0.f; const float* bb = BBf + (size_t)(g * 64 + lane) * 32;
#pragma unroll
    for (int c = 0; c < 16; ++c) { xr += bb[2 * c] * uu[c]; xi += bb[2 * c + 1] * uu[c]; }
    const float ar = A1[(g * 64 + lane) * 2], ai = A1[(g * 64 + lane) * 2 + 1];
    const float h0r = F.st_s5r[(size_t)(s * 32 + g) * 64 + lane], h0i = F.st_s5i[(size_t)(s * 32 + g) * 64 + lane];
    const float hr = ar * h0r - ai * h0i + xr, hi = ar * h0i + ai * h0r + xi;
    F.out[OFF_S5RS + (size_t)(s * 32 + g) * 64 + lane] = hr; F.out[OFF_S5IS + (size_t)(s * 32 + g) * 64 + lane] = hi;
    float yk = 0.f;
#pragma unroll
    for (int co = 0; co < 16; ++co) { const float part = hr * F.c_re[(g * 16 + co) * 64 + lane] - hi * F.c_im[(g * 16 + co) * 64 + lane]; const float tot = wave_sum(part); if (lane == co) yk = tot; }
    if (lane < 16) { float uc = 0.f;
#pragma unroll
        for (int c = 0; c < 16; ++c) uc = (lane == c) ? uu[c] : uc;
        const float y = yk + F.s5_d[g * 16 + lane] * uc; Y5[(size_t)row * HD + 16 * g + lane] = (bf16)f2bf(gelu_tanh(y)); }
}
#define HG_O_QD 0
#define HG_O_KD 17408
#define HG_O_KT 34816
#define HG_O_VT 53248
#define HG_O_ATT 55552
#define HG_O_ST 64768
#define HG_O_SEG 69120
#define HG_O_DEC 71168
constexpr size_t WS_HQD = WS_XN, WS_HATT = WS_XN + (size_t)1056 * 64 * 128 * 2, WS_HKT = WS_ZEND, WS_HDEC = WS_ZEND + (size_t)1056 * 128 * 64 * 2;
static_assert(WS_HATT + (size_t)1056 * 64 * 64 * 2 <= WS_U && WS_HDEC + (size_t)1056 * 128 * 4 <= WS_END, "hgrn operand buffers");
__device__ __forceinline__ void hgrn_pre_items(Frame& F) {
    LAS unsigned char* L = F.lds;
    int tid = F.tid; asm volatile("" : "+v"(tid));
    const int lane = tid & 63, w = F.wave, r = lane & 15, q = lane >> 4;
    const bf16* Qb = (const bf16*)(F.ws + WS_Q); const float* LF = (const float*)(F.ws + WS_LF);
    bf16* QDg = (bf16*)(F.ws + WS_HQD); bf16* ATTg = (bf16*)(F.ws + WS_HATT); bf16* KTg = (bf16*)(F.ws + WS_HKT); float* DECg = (float*)(F.ws + WS_HDEC);
    for (int i = tid; i < 9216 / 4; i += 512) ((LAS unsigned*)(L + HG_O_ATT))[i] = 0u;
    const int k = tid & 127, s4 = tid >> 7;
    float lf[16]; unsigned short qv[16];
#define HG_LOAD(item) do { const int c_ = (item) % 33, nh_ = (item) / 33, n_ = nh_ >> 2, h_ = nh_ & 3; \
        _Pragma("unroll") for (int i = 0; i < 16; ++i) { const int t = 16 * s4 + i; const int row = c_ == 0 ? (t < 16 ? SEQP * n_ + t : -1) : SEQP * n_ + 16 + 64 * (c_ - 1) + t; \
            if (row >= 0) { lf[i] = LF[(size_t)row * HD + 128 * h_ + k]; qv[i] = Qb[(size_t)row * HD + 128 * h_ + k]; } else { lf[i] = 0.f; qv[i] = 0; } } } while (0)
    int item = F.vcu;
    if (item < 1056) HG_LOAD(item);
    for (; item < 1056; item += F.G) {
        float bc[16]; float run = 0.f;
#pragma unroll
        for (int i = 0; i < 16; ++i) { run += lf[i]; bc[i] = run; }
        ((LAS float*)(L + HG_O_SEG))[s4 * 128 + k] = run;
        __syncthreads();
        float off = 0.f, bl = 0.f;
#pragma unroll
        for (int s = 0; s < 4; ++s) { const float v = ((LAS float*)(L + HG_O_SEG))[s * 128 + k]; bl += v; off += (s < s4) ? v : 0.f; }
        if (s4 == 0) DECg[(size_t)item * 128 + k] = __expf(bl);
        unsigned kp[8];
#pragma unroll
        for (int i = 0; i < 16; i += 2) { float kdl2[2];
#pragma unroll
            for (int e = 0; e < 2; ++e) { const int ii = i + e; const float b = off + bc[ii], f = __expf(lf[ii]), kk = 1.0f - f, eb = __expf(b), enb = __expf(-b);
                *(LAS bf16*)(L + HG_O_QD + (16 * s4 + ii) * 272 + k * 2) = (bf16)f2bf(bf2f(qv[ii]) * eb);
                *(LAS bf16*)(L + HG_O_KD + (16 * s4 + ii) * 272 + k * 2) = (bf16)f2bf(kk * enb);
                kdl2[e] = kk * __expf(bl - b); }
            kp[i >> 1] = pk2(kdl2[0], kdl2[1]); }
        *(v4u*)(KTg + ((size_t)item * 128 + k) * 64 + 16 * s4) = (v4u){kp[0], kp[1], kp[2], kp[3]};
        *(v4u*)(KTg + ((size_t)item * 128 + k) * 64 + 16 * s4 + 8) = (v4u){kp[4], kp[5], kp[6], kp[7]};
        __syncthreads();
        if (item + F.G < 1056) HG_LOAD(item + F.G);
#pragma unroll
        for (int j = 0; j < 2; ++j) { const int idx = tid + 512 * j, t = idx >> 4, pc = idx & 15; *(v4u*)(QDg + ((size_t)item * 64 + t) * 128 + pc * 8) = *(const LAS v4u*)(L + HG_O_QD + t * 272 + pc * 16); }
#pragma unroll
        for (int rep = 0; rep < 2; ++rep) { const int idx = w + 8 * rep;
            if (idx < 10) { const int ti = idx < 1 ? 0 : (idx < 3 ? 1 : (idx < 6 ? 2 : 3)), sj = idx - (ti * (ti + 1)) / 2;
                f32x4 at = (f32x4){0.f, 0.f, 0.f, 0.f};
#pragma unroll
                for (int kk = 0; kk < 4; ++kk) { const bf16x8 a = *(const LAS bf16x8*)(L + HG_O_QD + (16 * ti + r) * 272 + (32 * kk + 8 * q) * 2), b = *(const LAS bf16x8*)(L + HG_O_KD + (16 * sj + r) * 272 + (32 * kk + 8 * q) * 2); at = mfma16(a, b, at); }
#pragma unroll
                for (int i = 0; i < 4; ++i) { const int t = 16 * ti + 4 * q + i, s = 16 * sj + r; *(LAS bf16*)(L + HG_O_ATT + t * 144 + s * 2) = (bf16)f2bf(s <= t ? at[i] : 0.f); } } }
        __syncthreads();
        { const int t = tid >> 3, pc = tid & 7; *(v4u*)(ATTg + ((size_t)item * 64 + t) * 64 + pc * 8) = *(const LAS v4u*)(L + HG_O_ATT + t * 144 + pc * 16); }
    }
#undef HG_LOAD
    __syncthreads();
}
__device__ __forceinline__ void hgrn_seq_item(Frame& F, int item, bool atom = true) {
    const int vs = item & 7, h = (item >> 3) & 3, n = item >> 5;
    LAS unsigned char* L = F.lds;
    int tid = F.tid; asm volatile("" : "+v"(tid));
    const int lane = tid & 63, w = F.wave, r = lane & 15, q = lane >> 4;
    const bf16* Vb = (const bf16*)(F.ws + WS_V);
    const bf16* QDg = (const bf16*)(F.ws + WS_HQD); const bf16* ATTg = (const bf16*)(F.ws + WS_HATT); const bf16* KTg = (const bf16*)(F.ws + WS_HKT); const float* DECg = (const float*)(F.ws + WS_HDEC);
    bf16* OH = (bf16*)(F.ws + WS_OH); float* HSS = (float*)(F.ws + WS_HSS);
    for (int i = tid; i < 4352 / 4; i += 512) ((LAS unsigned*)(L + HG_O_ST))[i] = 0u;
    f32x4 Sreg = (f32x4){0.f, 0.f, 0.f, 0.f};
    const int tv = tid >> 3, pr = tid & 7;
    v4u pq[2], pk[2], pa; unsigned vv; float dc;
#define HG_LOAD(c) do { const size_t it_ = (size_t)((n * 4 + h) * 33 + (c)); \
        _Pragma("unroll") for (int j = 0; j < 2; ++j) { const int idx = tid + 512 * j; pq[j] = *(const v4u*)(QDg + it_ * 8192 + (size_t)idx * 8); pk[j] = *(const v4u*)(KTg + it_ * 8192 + (size_t)idx * 8); } \
        pa = *(const v4u*)(ATTg + it_ * 4096 + (size_t)tid * 8); dc = DECg[it_ * 128 + (tid & 127)]; \
        { const int row = (c) == 0 ? (tv < 16 ? SEQP * n + tv : -1) : SEQP * n + 16 + 64 * ((c) - 1) + tv; \
          vv = row >= 0 ? *(const unsigned*)(Vb + (size_t)row * HD + 128 * h + 16 * vs + 2 * pr) : 0u; } } while (0)
    HG_LOAD(0);
    for (int c = 0; c <= 32; ++c) {
#pragma unroll
        for (int j = 0; j < 2; ++j) { const int idx = tid + 512 * j;
            *(LAS v4u*)(L + HG_O_QD + (idx >> 4) * 272 + (idx & 15) * 16) = pq[j];
            *(LAS v4u*)(L + HG_O_KT + (idx >> 3) * 144 + (idx & 7) * 16) = pk[j]; }
        *(LAS v4u*)(L + HG_O_ATT + (tid >> 3) * 144 + (tid & 7) * 16) = pa;
        if (tid < 128) ((LAS float*)(L + HG_O_DEC))[tid] = dc;
        *(LAS bf16*)(L + HG_O_VT + (2 * pr) * 144 + tv * 2) = (bf16)(vv & 0xffffu); *(LAS bf16*)(L + HG_O_VT + (2 * pr + 1) * 144 + tv * 2) = (bf16)(vv >> 16);
        __syncthreads();
        if (c < 32) HG_LOAD(c + 1);
        f32x4 accS;
#pragma unroll
        for (int i = 0; i < 4; ++i) accS[i] = ((LAS float*)(L + HG_O_DEC))[16 * w + 4 * q + i] * Sreg[i];
#pragma unroll
        for (int kk = 0; kk < 2; ++kk) { const bf16x8 a = *(const LAS bf16x8*)(L + HG_O_KT + (16 * w + r) * 144 + (32 * kk + 8 * q) * 2), b = *(const LAS bf16x8*)(L + HG_O_VT + r * 144 + (32 * kk + 8 * q) * 2); accS = mfma16(a, b, accS); }
        if (w < 4) {
            f32x4 o = (f32x4){0.f, 0.f, 0.f, 0.f};
#pragma unroll
            for (int kk = 0; kk < 4; ++kk) { const bf16x8 a = *(const LAS bf16x8*)(L + HG_O_QD + (16 * w + r) * 272 + (32 * kk + 8 * q) * 2), b = *(const LAS bf16x8*)(L + HG_O_ST + r * 272 + (32 * kk + 8 * q) * 2); o = mfma16(a, b, o); }
#pragma unroll
            for (int kk = 0; kk < 2; ++kk) { const bf16x8 a = *(const LAS bf16x8*)(L + HG_O_ATT + (16 * w + r) * 144 + (32 * kk + 8 * q) * 2), b = *(const LAS bf16x8*)(L + HG_O_VT + r * 144 + (32 * kk + 8 * q) * 2); o = mfma16(a, b, o); }
#pragma unroll
            for (int i = 0; i < 4; ++i) { const int t = 16 * w + 4 * q + i; const int row = c == 0 ? (t < 16 ? SEQP * n + t : -1) : SEQP * n + 16 + 64 * (c - 1) + t;
                float ss = o[i] * o[i]; ss += __shfl_xor(ss, 1); ss += __shfl_xor(ss, 2); ss += __shfl_xor(ss, 4); ss += __shfl_xor(ss, 8);
                if (row >= 0) { OH[(size_t)row * HD + 128 * h + 16 * vs + r] = (bf16)f2bf(o[i]); if (r == 0 && atom) atomic_addf(HSS + (size_t)row * SST + h, ss); } } }
        __syncthreads();
        Sreg = accS;
        *(LAS v2u*)(L + HG_O_ST + r * 272 + (16 * w + 4 * q) * 2) = (v2u){pk2(Sreg[0], Sreg[1]), pk2(Sreg[2], Sreg[3])};
    }
#undef HG_LOAD
#pragma unroll
    for (int i = 0; i < 4; ++i) F.out[OFF_HGP + ((size_t)(n * 4 + h) * 128 + 16 * w + 4 * q + i) * 128 + 16 * vs + r] = Sreg[i];
    __syncthreads();
}
__device__ __forceinline__ void hgrn_sample_item(Frame& F, int item, bool atom = true) {
    const int h = item & 3, s = item >> 2, row = R_SAMP + s, tid = F.tid, vq = tid & 31, kg = tid >> 5;
    const bf16* Qb = (const bf16*)(F.ws + WS_Q); const bf16* Vb = (const bf16*)(F.ws + WS_V); const float* LF = (const float*)(F.ws + WS_LF);
    bf16* OH = (bf16*)(F.ws + WS_OH); float* HSS = (float*)(F.ws + WS_HSS);
    LAS float* red = (LAS float*)F.lds;
    const v2u vw = *(const v2u*)(Vb + (size_t)row * HD + 128 * h + 4 * vq);
    const f32x4 v4 = (f32x4){bflo(vw.x), bfhi(vw.x), bflo(vw.y), bfhi(vw.y)};
    f32x4 o4 = (f32x4){0.f, 0.f, 0.f, 0.f};
#pragma unroll
    for (int i = 0; i < 8; ++i) { const int k = 8 * kg + i; const float f = __expf(LF[(size_t)row * HD + 128 * h + k]), kk = 1.0f - f, qk = bf2f(Qb[(size_t)row * HD + 128 * h + k]);
        const size_t off = ((size_t)(s * 4 + h) * 128 + k) * 128 + 4 * vq;
        const f32x4 sn = *(const f32x4*)(F.st_hg + off) * f + v4 * kk;
        *(f32x4*)(F.out + OFF_HGS + off) = sn; o4 += sn * qk; }
    *(LAS f32x4*)(red + kg * 128 + 4 * vq) = o4;
    __syncthreads();
    if (tid < 128) { float o = 0.f;
#pragma unroll
        for (int j = 0; j < 16; ++j) o += red[j * 128 + tid];
        OH[(size_t)row * HD + 128 * h + tid] = (bf16)f2bf(o);
        const float ss = wave_sum(o * o); if (F.lane == 0 && atom) atomic_addf(HSS + (size_t)row * SST + h, ss); }
    __syncthreads();
}

constexpr int TAIL_ROW0 = 16384;
template <class Epi>
__device__ __forceinline__ void tail_gemm(Frame& F, const bf16* A, int lda, const bf16* Bt, int K, const Epi& E) {
    int tid = F.tid; asm volatile("" : "+v"(tid));
    const int lane = tid & 63, w = F.wave, r = lane & 15, q = lane >> 4;
    LAS float* red = (LAS float*)F.lds;
    const int kw = K >> 3, nks = kw >> 5;
    for (int su = F.vcu; su < 256; su += F.G) {
        const int rb = su >> 5, cb = su & 31;
        const bf16* Ap = A + (size_t)(TAIL_ROW0 + 32 * rb + r) * lda + w * kw + 8 * q;
        const bf16* Bp = Bt + (size_t)(32 * cb + r) * K + w * kw + 8 * q;
        f32x4 acc[2][2];
#pragma unroll
        for (int mi = 0; mi < 2; ++mi)
#pragma unroll
            for (int ni = 0; ni < 2; ++ni) acc[mi][ni] = (f32x4){0.f, 0.f, 0.f, 0.f};
#pragma unroll 4
        for (int kk = 0; kk < nks; ++kk) {
            const bf16x8 a0 = *(const bf16x8*)(Ap + 32 * kk), a1 = *(const bf16x8*)(Ap + (size_t)16 * lda + 32 * kk);
            const bf16x8 b0 = *(const bf16x8*)(Bp + 32 * kk), b1 = *(const bf16x8*)(Bp + (size_t)16 * K + 32 * kk);
            acc[0][0] = mfma16(a0, b0, acc[0][0]); acc[0][1] = mfma16(a0, b1, acc[0][1]); acc[1][0] = mfma16(a1, b0, acc[1][0]); acc[1][1] = mfma16(a1, b1, acc[1][1]);
        }
#pragma unroll
        for (int mi = 0; mi < 2; ++mi)
#pragma unroll
            for (int ni = 0; ni < 2; ++ni)
#pragma unroll
                for (int i = 0; i < 4; ++i) red[(w * 32 + 16 * mi + 4 * q + i) * 32 + 16 * ni + r] = acc[mi][ni][i];
        __syncthreads();
        { const int row = tid >> 4, col = (tid & 15) * 2; float v0 = 0.f, v1 = 0.f;
#pragma unroll
            for (int ww = 0; ww < 8; ++ww) { v0 += red[(ww * 32 + row) * 32 + col]; v1 += red[(ww * 32 + row) * 32 + col + 1]; }
            E(TAIL_ROW0 + 32 * rb + row, 32 * cb + col, v0, v1); }
        __syncthreads();
    }
}
struct TailOut {
    const float *xp, *meta, *xs; float *out, *h1meta; bf16* H1B; float* ss;
    __device__ __forceinline__ void operator()(int row, int col, float v0, float v1) const {
        const float* src = h0_src(row, xp, meta, xs); float* dst = h1_dst(row, out, h1meta);
        const float a = src[col] + v0, b = src[col + 1] + v1; dst[col] = a; dst[col + 1] = b;
        *(unsigned*)(H1B + (size_t)row * D + col) = pk2(a, b);
        float q2 = a * a + b * b; q2 += __shfl_xor(q2, 1); q2 += __shfl_xor(q2, 2); q2 += __shfl_xor(q2, 4); q2 += __shfl_xor(q2, 8);
        if ((col & 31) == 0) atomic_addf(ss + (size_t)row * SST, q2);
    }
};
struct TailDown {
    float *out, *h1meta; float* ss;
    __device__ __forceinline__ void operator()(int row, int col, float v0, float v1) const {
        float* dst = h1_dst(row, out, h1meta);
        const float a = dst[col] + v0, b = dst[col + 1] + v1; dst[col] = a; dst[col + 1] = b;
        float q2 = a * a + b * b; q2 += __shfl_xor(q2, 1); q2 += __shfl_xor(q2, 2); q2 += __shfl_xor(q2, 4); q2 += __shfl_xor(q2, 8);
        if ((col & 31) == 0) atomic_addf(ss + (size_t)row * SST, q2);
    }
};
__device__ __forceinline__ void hgrn_finalize(Frame& F) {
    const bf16* OH = (const bf16*)(F.ws + WS_OH); const bf16* G = (const bf16*)(F.ws + WS_G); const float* HSS = (const float*)(F.ws + WS_HSS); bf16* MIX = (bf16*)(F.ws + WS_MIX);
    const int gt = F.vcu * 512 + F.tid, NT = F.G * 512;
    for (int idx = gt; idx < RT * 64; idx += NT) { const int row = idx >> 6, c8 = (idx & 63) * 8;
        const float rstd = __builtin_amdgcn_rsqf(ld_agent(HSS + (size_t)row * SST + (c8 >> 7)) * (1.0f / 128.0f) + EPS);
        const v4u o = *(const v4u*)(OH + (size_t)row * HD + c8), gg = *(const v4u*)(G + (size_t)row * HD + c8);
        const f32x4 n0 = *(const f32x4*)(F.hg_ng + c8), n1 = *(const f32x4*)(F.hg_ng + c8 + 4);
        v4u w;
        w.x = pk2(bflo(o.x) * rstd * n0[0] * bflo(gg.x), bfhi(o.x) * rstd * n0[1] * bfhi(gg.x));
        w.y = pk2(bflo(o.y) * rstd * n0[2] * bflo(gg.y), bfhi(o.y) * rstd * n0[3] * bfhi(gg.y));
        w.z = pk2(bflo(o.z) * rstd * n1[0] * bflo(gg.z), bfhi(o.z) * rstd * n1[1] * bfhi(gg.z));
        w.w = pk2(bflo(o.w) * rstd * n1[2] * bflo(gg.w), bfhi(o.w) * rstd * n1[3] * bfhi(gg.w));
        *(v4u*)(MIX + (size_t)row * D + 512 + c8) = w; }
}
__device__ __forceinline__ void final_norm(Frame& F) {
    const float* SS3 = (const float*)(F.ws + WS_SS3);
    const int gw = F.vcu * NWAVES + F.wave, NGW = F.G * NWAVES;
    f32x4 gg[4];
#pragma unroll
    for (int j = 0; j < 4; ++j) gg[j] = *(const f32x4*)(F.g_final + 4 * F.lane + 256 * j);
    for (int i0 = gw * 4; i0 < NB * SEQ + NS; i0 += NGW * 4) {
        float* p[4]; float rs[4]; f32x4 v[4][4];
#pragma unroll
        for (int r = 0; r < 4; ++r) { const int i = i0 + r; const int row = i < NB * SEQ ? (i >> 11) * SEQP + NMETA + (i & 2047) : R_SAMP + (i - NB * SEQ);
            p[r] = i < NB * SEQ ? F.out + (size_t)i * D : F.out + OFF_YS + (size_t)(i - NB * SEQ) * D; rs[r] = ld_agent(SS3 + (size_t)row * SST);
#pragma unroll
            for (int j = 0; j < 4; ++j) v[r][j] = *(const f32x4*)(p[r] + 4 * F.lane + 256 * j); }
#pragma unroll
        for (int r = 0; r < 4; ++r) { const float rstd = __builtin_amdgcn_rsqf(rs[r] * (1.0f / D) + EPS);
#pragma unroll
            for (int j = 0; j < 4; ++j) *(f32x4*)(p[r] + 4 * F.lane + 256 * j) = v[r][j] * rstd * gg[j]; } }
}
#ifndef PROBE_DUP
#define PROBE_DUP 0x0f
#endif
#define PD(k) (((PROBE_DUP & 0x0f) == (k)) || ((PROBE_DUP & 0x1000) && (k) != 8))
#ifndef MK_N_LAUNCHES
#define MK_N_LAUNCHES 1
#endif
constexpr int N_LAUNCHES = MK_N_LAUNCHES;
constexpr int PER_PHASE = 9;
struct Args { const float* in[28]; float* out; unsigned char* ws; int ph_lo, ph_hi, li, pad; };
__global__ void __launch_bounds__(NWAVES * 64, 2) hymba_fwd(Args args) {
    extern __shared__ __attribute__((aligned(16))) unsigned char lds[];
    Frame F;
    F.lds = (LAS unsigned char*)lds;
    F.MISC = (volatile LAS unsigned*)(F.lds + MISC_OFF);
    F.tid = threadIdx.x; F.lane = F.tid & 63; F.wave = __builtin_amdgcn_readfirstlane(F.tid >> 6);
    F.G = gridDim.x; { const int bx = blockIdx.x; F.vcu = (F.G % 8 == 0) ? (bx % 8) * (F.G / 8) + bx / 8 : bx; }
    F.ws = args.ws; F.out = args.out; F.ctl = (gu32*)(args.ws + WS_CTL);
    F.x_prompt = args.in[0]; F.x_sample = args.in[1]; F.st_s5r = args.in[2]; F.st_s5i = args.in[3]; F.st_hg = args.in[4]; F.st_cv = args.in[5]; F.meta = args.in[6];
    F.g_mix = args.in[7]; F.w_in = args.in[8]; F.lam_re = args.in[9]; F.lam_im = args.in[10]; F.log_dt = args.in[11]; F.b_re = args.in[12]; F.b_im = args.in[13];
    F.c_re = args.in[14]; F.c_im = args.in[15]; F.s5_d = args.in[16]; F.w_glu = args.in[17]; F.b_glu = args.in[18]; F.hg_lb = args.in[19]; F.hg_ng = args.in[20];
    F.w_out = args.in[21]; F.g_ffn = args.in[22]; F.w_up = args.in[23]; F.conv_w = args.in[24]; F.conv_b = args.in[25]; F.w_down = args.in[26]; F.g_final = args.in[27];
    for (int u = F.tid; u < 64; u += NWAVES * 64) ((LAS unsigned*)(F.lds + MISC_OFF))[u] = 0u;
    __syncthreads();
    XcdBarrier bar; bar.bar = (unsigned*)(F.ctl + CW_BAR); bar.x = 0; bar.st = nullptr;
    if (N_LAUNCHES != PER_PHASE) bar = xcd_barrier_post((unsigned*)(F.ctl + CW_BAR), F.MISC + 8);
#define GRID_BAR() do { if (N_LAUNCHES != PER_PHASE) xcd_barrier(bar); } while (0)
#define GRID_BAR2() xcd_barrier(bar)
    static_assert(N_LAUNCHES == 1, "this build keeps a grid barrier inside phase 2: one launch only");
    const int lo = args.ph_lo, hi = args.ph_hi;
#ifndef P2_MASK
#define P2_MASK 15
#endif
#ifndef PH_MASK
#define PH_MASK 0x1ff
#endif
#define IN(k) (((PH_MASK >> (k)) & 1) && lo <= (k) && (k) < hi)
#define BOTH(k) (IN(k) && IN((k) + 1))
    const int gw = F.vcu * NWAVES + F.wave, NGW = F.G * NWAVES;
    bf16* XN = (bf16*)(F.ws + WS_XN);

#if PD(0)
    if (IN(0)) { p0_prologue(F); __syncthreads(); }
#endif
    if (IN(0)) { p0_prologue(F); if (BOTH(0)) GRID_BAR(); }
    if (IN(1)) {
        pg8::Gemm g{XN, (const bf16*)(F.ws + WS_WIN), RT, INC, D, D, 256}; pg8::StaticOrder S; S.init(RT, INC, F.G, (int)blockIdx.x);
        EpiIn E{(bf16*)(F.ws + WS_U), (bf16*)(F.ws + WS_Q), (bf16*)(F.ws + WS_V), (bf16*)(F.ws + WS_G), (float*)(F.ws + WS_LF), (const float*)(F.ws + WS_S5F + S5F_LB)};
#if PD(1)
        pg8::gemm_phase<EpiIn, true>(F.lds + RING_OFF, g, S, E);
#endif
        pg8::gemm_phase<EpiIn, true>(F.lds + RING_OFF, g, S, E);
        if (BOTH(1)) GRID_BAR();
    }
    if (IN(2)) {
        for (int it = F.vcu; it < NB * 32; it += F.G) s5_prompt_item(F, it);
        hgrn_pre_items(F);
        for (int it = gw; it < NS * 32; it += NGW) s5_sample_item(F, it);
        for (int it = F.vcu; it < NS * 4; it += F.G) hgrn_sample_item(F, it);
        GRID_BAR2();
#if PD(2)
        for (int it = F.vcu; it < NB * 4 * 8; it += F.G) hgrn_seq_item(F, it, false);
#endif
        for (int it = F.vcu; it < NB * 4 * 8; it += F.G) hgrn_seq_item(F, it);
        if (BOTH(2)) GRID_BAR();
    }
    if (IN(3)) {
        hgrn_finalize(F);
        pg8::Gemm g{(const bf16*)(F.ws + WS_Y5), (const bf16*)(F.ws + WS_WGLU), RT, HD, HD, HD, 256}; pg8::StaticOrder S; S.init(RT, HD, F.G, (int)blockIdx.x);
        EpiGlu E{(const bf16*)(F.ws + WS_Y5), F.b_glu, (bf16*)(F.ws + WS_MIX)};
#if PD(3)
        hgrn_finalize(F);
        pg8::gemm_phase<EpiGlu, true>(F.lds + RING_OFF, g, S, E);
#endif
        pg8::gemm_phase<EpiGlu, true>(F.lds + RING_OFF, g, S, E);
        if (BOTH(3)) GRID_BAR();
    }
    if (IN(4)) {
        pg8::Gemm g{(const bf16*)(F.ws + WS_MIX), (const bf16*)(F.ws + WS_WOUT), TAIL_ROW0, D, D, D, 256}; pg8::StaticOrder S; S.init(TAIL_ROW0, D, F.G, (int)blockIdx.x);
        EpiOut E{F.x_prompt, F.meta, F.x_sample, F.out, (float*)(F.ws + WS_H1META), XN, (float*)(F.ws + WS_SS2)};
#if PD(4)
        { EpiOut E2 = E; E2.ss = nullptr; pg8::gemm_phase<EpiOut, true>(F.lds + RING_OFF, g, S, E2); }
#endif
        pg8::gemm_phase<EpiOut, true>(F.lds + RING_OFF, g, S, E);
        { TailOut T{F.x_prompt, F.meta, F.x_sample, F.out, (float*)(F.ws + WS_H1META), XN, (float*)(F.ws + WS_SS2)}; tail_gemm(F, (const bf16*)(F.ws + WS_MIX), D, (const bf16*)(F.ws + WS_WOUT), D, T); }
        if (BOTH(4)) GRID_BAR();
    }
    if (IN(5)) {
        pg8::Gemm g{XN - 2 * D, (const bf16*)(F.ws + WS_WUP), 66 * 256, UPC, D, D, 254}; pg8::StaticOrder S; S.init(66 * 256, UPC, F.G, (int)blockIdx.x);
        EpiUpGate E{(const float*)(F.ws + WS_SS2), (bf16*)(F.ws + WS_GATED), F.out, F.conv_w, F.conv_b, F.st_cv, (LAS float*)(F.lds + XCH_OFF)};
#if PD(5)
        pg8::gemm_phase<EpiUpGate, true>(F.lds + RING_OFF, g, S, E);
#endif
        pg8::gemm_phase<EpiUpGate, true>(F.lds + RING_OFF, g, S, E);
        if (BOTH(5)) GRID_BAR();
    }
    if (IN(6)) { }
    if (IN(7)) {
        pg8::Gemm g{(const bf16*)(F.ws + WS_GATED), (const bf16*)(F.ws + WS_WDN), TAIL_ROW0, D, DFF, DFF, 256}; pg8::StaticOrder S; S.init(TAIL_ROW0, D, F.G, (int)blockIdx.x);
        EpiDown E{F.out, (float*)(F.ws + WS_H1META), (float*)(F.ws + WS_SS3), nullptr};
#if PD(7)
        { EpiDown E2 = E; E2.dry = (float*)(F.ws + WS_XN); pg8::gemm_phase<EpiDown, true>(F.lds + RING_OFF, g, S, E2); }
#endif
#if PD(8)
        for (int i = 0; i < 8; ++i) GRID_BAR();
#endif
        pg8::gemm_phase<EpiDown, true>(F.lds + RING_OFF, g, S, E);
        { TailDown T{F.out, (float*)(F.ws + WS_H1META), (float*)(F.ws + WS_SS3)}; tail_gemm(F, (const bf16*)(F.ws + WS_GATED), DFF, (const bf16*)(F.ws + WS_WDN), DFF, T); }
        if (BOTH(7)) GRID_BAR();
    }
    if (IN(8)) final_norm(F);
#undef IN
#undef BOTH
#undef GRID_BAR
}

extern "C" void kernel_launch(void* const* d_in, const int* in_sizes, int n_in, void* d_out, int out_size, void* d_ws, size_t ws_size, hipStream_t stream) {
    static int grid = 0;
    if (grid == 0) {
        if (n_in != 28 || out_size != (int)OUT_TOTAL || ws_size < WS_END) { fprintf(stderr, "kernel_launch: unexpected problem (n_in %d, out %d, ws %zu); nothing launched\n", n_in, out_size, ws_size); grid = -1; return; }
        int dev = 0, cus = 0, per_cu = 0;
        if (hipGetDevice(&dev) != hipSuccess || hipDeviceGetAttribute(&cus, hipDeviceAttributeMultiprocessorCount, dev) != hipSuccess) { fprintf(stderr, "kernel_launch: device query failed\n"); grid = -1; return; }
        if (hipFuncSetAttribute((const void*)hymba_fwd, hipFuncAttributeMaxDynamicSharedMemorySize, LDS_BYTES) != hipSuccess) { fprintf(stderr, "kernel_launch: hipFuncSetAttribute failed\n"); grid = -1; return; }
        if (hipOccupancyMaxActiveBlocksPerMultiprocessor(&per_cu, (const void*)hymba_fwd, NWAVES * 64, LDS_BYTES) != hipSuccess || per_cu < 1)
            fprintf(stderr, "kernel_launch: note: occupancy query reports %d workgroups per CU\n", per_cu);
        (void)hipGetLastError();
        grid = cus;
    }
    if (grid < 0) return;
    if (hipMemsetAsync((char*)d_ws + WS_CTL, 0, CTL_ZERO_BYTES, stream) != hipSuccess) { fprintf(stderr, "kernel_launch: hipMemsetAsync failed\n"); return; }
    Args a{};
    for (int i = 0; i < 28; ++i) a.in[i] = (const float*)d_in[i];
    a.out = (float*)d_out; a.ws = (unsigned char*)d_ws;
    for (int li = 0; li < N_LAUNCHES; ++li) {
        a.ph_lo = (N_LAUNCHES == PER_PHASE) ? li : 0; a.ph_hi = (N_LAUNCHES == PER_PHASE) ? li + 1 : PER_PHASE; a.li = li;
        hipLaunchKernelGGL(hymba_fwd, dim3(grid), dim3(NWAVES * 64), LDS_BYTES, stream, a);
        const hipError_t le = hipPeekAtLastError();
        if (le != hipSuccess) { fprintf(stderr, "kernel_launch: launch %d failed: %s\n", li, hipGetErrorName(le)); break; }
    }
}
```

```cpp
#include <hip/hip_runtime.h>
#include <cstdio>
#include <cstdint>
#define MK_N_LAUNCHES 1
namespace pg8 {
#define PG8_LAS __attribute__((address_space(3)))
typedef unsigned short bf16_t;
typedef short bf16x8 __attribute__((ext_vector_type(8)));
typedef float f32x4 __attribute__((ext_vector_type(4)));
typedef unsigned u32x4 __attribute__((ext_vector_type(4)));
typedef unsigned u32x2 __attribute__((ext_vector_type(2)));
constexpr int BM = 256, BK = 64, HALF = 128, HTB = HALF * BK * 2  , STAGE_BYTES = 8 * HTB, NXCD = 8, WGM = 8;

__host__ __device__ __forceinline__ int lds_byte(int r, int c) { const int st = (r >> 4) * 2 + (c >> 5), rr = r & 15, cc = c & 31, ob = rr * 64 + cc * 2; return st * 1024 + (ob ^ (((ob >> 9) & 1) << 5)); }
__host__ __device__ __forceinline__ void stage_rc(int b, int& R, int& C) { const int st = b / 1024, sb = b % 1024, swz = sb ^ (((sb >> 9) & 1) << 5); R = (st >> 1) * 16 + swz / 64; C = (st & 1) * 32 + (swz % 64) / 2; }
__host__ __device__ __forceinline__ int perm32(int rho) { const int n = rho >> 4, i = rho & 15; return 8 * (i >> 2) + 4 * n + (i & 3); }

struct Unit { int pm, pn; };
struct Gemm { const bf16_t* A; const bf16_t* Bt; int M, N, K, lda, a_tile_rows; };

struct StaticOrder {
    int nM, nN, nwg, G, c;
    __host__ __device__ void init(int M, int N, int G_, int c_) { nM = M / BM; nN = N / BM; nwg = nM * nN; G = G_; c = c_; }
    __host__ __device__ bool next(int i, Unit& u) const {
        const long L = (long)i * G + c; if (L >= nwg) return false;
        int wgid = (int)L; { const int q = nwg / NXCD, r = nwg % NXCD, xcd = wgid % NXCD, off = wgid / NXCD; wgid = (xcd < r ? xcd * (q + 1) : r * (q + 1) + (xcd - r) * q) + off; }
        const int nig = WGM * nN, gid = wgid / nig, fm = gid * WGM, gsz = (nM - fm) < WGM ? (nM - fm) : WGM;
        u.pm = fm + ((wgid % nig) % gsz); u.pn = (wgid % nig) / gsz; return true;
    }
};

__device__ __forceinline__ unsigned cvt_pk_bf16(float lo, float hi) { unsigned r; asm volatile("v_cvt_pk_bf16_f32 %0, %1, %2" : "=v"(r) : "v"(lo), "v"(hi)); return r; }

template <class Epi, bool ALIGN_EPI, int EPI_REP = 1>
__device__ __forceinline__ void gemm_phase(PG8_LAS unsigned char* lds, const Gemm g, const StaticOrder& S, const Epi& E) {
    int tid = threadIdx.x; asm volatile("" : "+v"(tid));
    const int wid = __builtin_amdgcn_readfirstlane(tid >> 6), lane = tid & 63, wr = wid >> 2, wc = wid & 3, fr = lane & 15, fq = lane >> 4;
    const int K = g.K, nt = K / BK, lda = g.lda;
    unsigned voffA[2], voffB[2];
#pragma unroll
    for (int i = 0; i < 2; ++i) { int R, C; stage_rc(tid * 16 + i * 8192, R, C); const int Rb = (R & ~31) + perm32(R & 31);
        voffA[i] = (unsigned)(R * lda + C) * 2u; voffB[i] = (unsigned)(Rb * K + C) * 2u; }
    const size_t kstep = (size_t)(BK * 2);
    const size_t hstepA = (size_t)HALF * lda * 2, hstepB = (size_t)HALF * K * 2;
    const size_t tstepA = (size_t)g.a_tile_rows * lda * 2, tstepB = 2 * hstepB;
    const unsigned ldsw = (unsigned)wid * 1024u;
    const int aoff = lds_byte(wr * 64 + fr, fq * 8), boff = lds_byte(wc * 32 + fr, fq * 8);
#define PG8_SA(b, h) (((b) * 2 + (h)) * HTB)
#define PG8_SB(b, h) ((4 + (b) * 2 + (h)) * HTB)
#define PG8_STAGE(bufoff, gbase, voff) do { _Pragma("unroll") for (int _i = 0; _i < 2; ++_i) \
        __builtin_amdgcn_global_load_lds((const unsigned*)((const char*)(gbase) + (voff)[_i]), (PG8_LAS unsigned*)(lds + (bufoff) + ldsw + _i * 8192), 16, 0, 0); } while (0)
#define PG8_LDA(dst, b, h) do { _Pragma("unroll") for (int m = 0; m < 4; ++m) _Pragma("unroll") for (int k = 0; k < 2; ++k) dst[m][k] = *(const PG8_LAS bf16x8*)(lds + PG8_SA(b, h) + aoff + m * 2048 + k * 1024); } while (0)
#define PG8_LDB(dst, b, h) do { _Pragma("unroll") for (int n = 0; n < 2; ++n) _Pragma("unroll") for (int k = 0; k < 2; ++k) dst[n][k] = *(const PG8_LAS bf16x8*)(lds + PG8_SB(b, h) + boff + n * 2048 + k * 1024); } while (0)
#define PG8_MMA(ai, bj, At, Bt) do { __builtin_amdgcn_s_setprio(1); _Pragma("unroll") for (int m = 0; m < 4; ++m) _Pragma("unroll") for (int n = 0; n < 2; ++n) _Pragma("unroll") for (int k = 0; k < 2; ++k) \
        acc[ai][bj][m][n] = __builtin_amdgcn_mfma_f32_16x16x32_bf16(Bt[n][k], At[m][k], acc[ai][bj][m][n], 0, 0, 0); __builtin_amdgcn_s_setprio(0); } while (0)
#define PG8_WAIT_V(n) asm volatile("s_waitcnt vmcnt(" #n ")" ::: "memory")
#define PG8_WAIT_L(n) asm volatile("s_waitcnt lgkmcnt(" #n ")" ::: "memory")
#define PG8_BAR __builtin_amdgcn_s_barrier()
#define PG8_SCHED __builtin_amdgcn_sched_barrier(0)
    Unit cur, nxt; int ui = 0;
    if (!S.next(0, cur)) return;
    f32x4 acc[2][2][4][2];
#pragma unroll
    for (int a = 0; a < 2; ++a)
#pragma unroll
        for (int b = 0; b < 2; ++b)
#pragma unroll
            for (int m = 0; m < 4; ++m)
#pragma unroll
                for (int n = 0; n < 2; ++n) acc[a][b][m][n] = (f32x4){0.f, 0.f, 0.f, 0.f};
    bf16x8 At[4][2], B0[2][2], B1[2][2];
    const char* cA = (const char*)g.A + (size_t)cur.pm * tstepA; const char* cB = (const char*)g.Bt + (size_t)cur.pn * tstepB;
    PG8_STAGE(PG8_SB(0, 0), cB, voffB); PG8_STAGE(PG8_SB(0, 1), cB + hstepB, voffB); PG8_STAGE(PG8_SA(0, 0), cA, voffA); PG8_STAGE(PG8_SA(0, 1), cA + hstepA, voffA);
    if (wr == 1) PG8_BAR;
    PG8_WAIT_V(2); PG8_BAR;
    PG8_STAGE(PG8_SB(1, 0), cB + kstep, voffB); PG8_STAGE(PG8_SA(1, 0), cA + kstep, voffA); PG8_STAGE(PG8_SB(1, 1), cB + hstepB + kstep, voffB);
    PG8_WAIT_V(6); PG8_BAR;
    for (;;) {
        const bool has_next = S.next(ui + 1, nxt);
        const char* nA = has_next ? (const char*)g.A + (size_t)nxt.pm * tstepA : cA; const char* nB = has_next ? (const char*)g.Bt + (size_t)nxt.pn * tstepB : cB;
        for (int t = 0; t < nt; t += 2) {
            const bool last = (t == nt - 2);
            const char* a1 = cA + (size_t)(t + 1) * kstep;
            const char* a2 = last ? nA : cA + (size_t)(t + 2) * kstep; const char* b2 = last ? nB : cB + (size_t)(t + 2) * kstep;
            const char* a3 = a2 + kstep; const char* b3 = b2 + kstep;
            PG8_LDB(B0, 0, 0); PG8_LDB(B1, 0, 1); PG8_SCHED; PG8_LDA(At, 0, 0); PG8_STAGE(PG8_SA(1, 1), a1 + hstepA, voffA);
            PG8_WAIT_V(8); PG8_WAIT_L(0); PG8_BAR; PG8_MMA(0, 0, At, B0); PG8_MMA(0, 1, At, B1); PG8_BAR; PG8_SCHED;
            PG8_LDA(At, 0, 1); PG8_STAGE(PG8_SB(0, 0), b2, voffB); PG8_STAGE(PG8_SB(0, 1), b2 + hstepB, voffB); PG8_STAGE(PG8_SA(0, 0), a2, voffA);
            PG8_WAIT_V(8); PG8_WAIT_L(0); PG8_BAR; PG8_MMA(1, 0, At, B0); PG8_MMA(1, 1, At, B1); PG8_BAR; PG8_SCHED;
            PG8_LDB(B0, 1, 0); PG8_LDB(B1, 1, 1); PG8_SCHED; PG8_LDA(At, 1, 0); PG8_STAGE(PG8_SA(0, 1), a2 + hstepA, voffA);
            PG8_WAIT_V(8); PG8_WAIT_L(0); PG8_BAR; PG8_MMA(0, 0, At, B0); PG8_MMA(0, 1, At, B1); PG8_BAR; PG8_SCHED;
            PG8_LDA(At, 1, 1); PG8_STAGE(PG8_SB(1, 0), b3, voffB); PG8_STAGE(PG8_SB(1, 1), b3 + hstepB, voffB); PG8_STAGE(PG8_SA(1, 0), a3, voffA);
            PG8_WAIT_V(8); PG8_WAIT_L(0); PG8_BAR; PG8_MMA(1, 0, At, B0); PG8_MMA(1, 1, At, B1); PG8_BAR; PG8_SCHED;
        }
        if constexpr (ALIGN_EPI) { if (wr == 0) PG8_BAR; }
        E(acc, cur, wr, wc, fr, fq);
        if (!has_next) break;
#pragma unroll
        for (int a = 0; a < 2; ++a)
#pragma unroll
            for (int b = 0; b < 2; ++b)
#pragma unroll
                for (int m = 0; m < 4; ++m)
#pragma unroll
                    for (int n = 0; n < 2; ++n) acc[a][b][m][n] = (f32x4){0.f, 0.f, 0.f, 0.f};
        cur = nxt; cA = nA; cB = nB; ++ui;
        if constexpr (ALIGN_EPI) { if (wr == 1) PG8_BAR; }
    }
    PG8_WAIT_V(0);
    if constexpr (!ALIGN_EPI) { if (wr == 0) PG8_BAR; }
    PG8_BAR;
#undef PG8_SA
#undef PG8_SB
#undef PG8_STAGE
#undef PG8_LDA
#undef PG8_LDB
#undef PG8_MMA
#undef PG8_WAIT_V
#undef PG8_WAIT_L
#undef PG8_BAR
#undef PG8_SCHED
}
}
using pg8::bf16x8;
constexpr int NWAVES = 8;
constexpr int D = 1024, NB = 8, SEQ = 2048, NMETA = 16, NS = 128;
constexpr int RT = 16640;
constexpr int SEQP = 2064, R_SAMP = 16512;
__device__ __forceinline__ int seq_of(int r) { return (int)__umulhi((unsigned)r, 2080903u); }
constexpr int HD = 512;
constexpr int INC = 2560, DFF = 2816, UPC = 5632;
constexpr float EPS = 1e-6f;
constexpr size_t OFF_YP = 0, OFF_YS = 16777216, OFF_S5RP = 16908288, OFF_S5IP = 16924672, OFF_HGP = 16941056, OFF_CVP = 17465344,
                 OFF_S5RS = 17510400, OFF_S5IS = 17772544, OFF_HGS = 18034688, OFF_CVS = 26423296, OUT_TOTAL = 27144192;
constexpr size_t KiB = 1024, MiB = 1u << 20;
constexpr size_t WS_CTL = 0, CTL_ZERO_BYTES = 64 * KiB;
constexpr int CW_BAR = 4096;
constexpr int SST = 16;
constexpr size_t WS_SS2 = 249 * MiB, WS_SS3 = 250 * MiB + 512 * KiB, WS_HSS = 252 * MiB, STAT_BYTES = (size_t)RT * SST * 4;
constexpr size_t WS_WIN = 2 * MiB, WS_WGLU = 7 * MiB, WS_WOUT = 7 * MiB + 512 * KiB, WS_WUP = 9 * MiB + 512 * KiB, WS_WDN = 20 * MiB + 512 * KiB;
constexpr size_t WS_S5W1 = 26 * MiB, WS_S5W2 = 32 * MiB, WS_S5F = 34 * MiB;
constexpr size_t S5F_A1 = 0, S5F_A16 = 16 * KiB, S5F_BB = 64 * KiB, S5F_LB = 384 * KiB;
constexpr size_t WS_H1META = 35 * MiB;
constexpr size_t WS_XN = 36 * MiB;
constexpr size_t ROWS512_BF16 = (size_t)RT * 512 * 2;
constexpr size_t WS_U = 68 * MiB + 512 * KiB, WS_Q = WS_U + ROWS512_BF16, WS_V = WS_Q + ROWS512_BF16, WS_G = WS_V + ROWS512_BF16, WS_LF = WS_G + ROWS512_BF16,
                 WS_Y5 = WS_LF + 2 * ROWS512_BF16, WS_OH = WS_Y5 + ROWS512_BF16, WS_MIX = WS_OH + ROWS512_BF16, WS_ZEND = WS_MIX + 2 * ROWS512_BF16;
constexpr size_t WS_GATED = WS_U;
constexpr size_t WS_END = 256 * MiB;
static_assert(WS_ZEND <= WS_END && WS_GATED + (size_t)RT * DFF * 2 <= WS_MIX && WS_XN + (size_t)RT * D * 2 <= WS_U, "d_ws map");
static_assert((CW_BAR + 3456) * 4 <= (int)CTL_ZERO_BYTES && WS_SS2 + STAT_BYTES <= WS_SS3 && WS_SS3 + STAT_BYTES <= WS_HSS && WS_HSS + STAT_BYTES <= WS_END, "ctl / stat map");

constexpr int LDS_BYTES = 163840;
constexpr int RING_OFF = 0, XCH_OFF = 131072, MISC_OFF = 163840 - 256;

#define GAS __attribute__((address_space(1)))
#define LAS __attribute__((address_space(3)))
typedef unsigned short bf16;
typedef unsigned v4u __attribute__((ext_vector_type(4)));
typedef unsigned v2u __attribute__((ext_vector_type(2)));
typedef float f32x4 __attribute__((ext_vector_type(4)));
typedef short bf16x8 __attribute__((ext_vector_type(8)));
typedef GAS unsigned gu32;
#define RLX_AGENT __ATOMIC_RELAXED, __HIP_MEMORY_SCOPE_AGENT
#define LDS_WAIT() asm volatile("s_waitcnt lgkmcnt(0)" ::: "memory")
#define VM_WAIT() asm volatile("s_waitcnt vmcnt(0)" ::: "memory")
__device__ __forceinline__ unsigned f2bf(float f) { unsigned u = __builtin_bit_cast(unsigned, f); return (u + 0x7fffu + ((u >> 16) & 1u)) >> 16; }
__device__ __forceinline__ unsigned pk2(float lo, float hi) { return f2bf(lo) | (f2bf(hi) << 16); }
__device__ __forceinline__ float bf2f(unsigned short b) { return __builtin_bit_cast(float, (unsigned)b << 16); }
__device__ __forceinline__ float bflo(unsigned w) { return __builtin_bit_cast(float, w << 16); }
__device__ __forceinline__ float bfhi(unsigned w) { return __builtin_bit_cast(float, w & 0xffff0000u); }
__device__ __forceinline__ float sigmoidf_(float x) { return __builtin_amdgcn_rcpf(1.0f + __expf(-x)); }
__device__ __forceinline__ float siluf_(float x) { return x * sigmoidf_(x); }
__device__ __forceinline__ float gelu_tanh(float y) { const float uu = 1.5957691216057308f * (y + 0.044715f * y * y * y); return y * sigmoidf_(uu); }
__device__ __forceinline__ float ld_agent(const float* p) { return __builtin_bit_cast(float, __hip_atomic_load((const unsigned*)p, RLX_AGENT)); }
__device__ __forceinline__ void atomic_addf(float* p, float v) { (void)__hip_atomic_fetch_add(p, v, RLX_AGENT); }
__device__ __forceinline__ f32x4 mfma16(bf16x8 a, bf16x8 b, f32x4 c) { return __builtin_amdgcn_mfma_f32_16x16x32_bf16(a, b, c, 0, 0, 0); }
__device__ __forceinline__ float wave_sum(float v) {
#pragma unroll
    for (int o = 1; o < 64; o <<= 1) v += __shfl_xor(v, o);
    return v;
}

#define XB_TMO      128
#define XB_XCNT(j)  (256  + 64 * (j))
#define XB_XSUB(j)  (1280 + 64 * (j))
#define XB_XGEN(j)  (2304 + 64 * (j))
#define XB_TOP      3328
#define XB_TOPGEN   3392
#define XCD_BAR_WORDS 3456
#define XB_SPIN_CAP (1u << 18)
__device__ __forceinline__ unsigned xb_ld(unsigned* p)              { return __hip_atomic_load(p, __ATOMIC_RELAXED, __HIP_MEMORY_SCOPE_AGENT); }
__device__ __forceinline__ unsigned xb_add(unsigned* p, unsigned v) { return __hip_atomic_fetch_add(p, v, __ATOMIC_RELAXED, __HIP_MEMORY_SCOPE_AGENT); }
__device__ __forceinline__ unsigned xb_xcc_id() { return (unsigned)__builtin_amdgcn_s_getreg((3 << 11) | 20) & 0xFu; }
#define XB_SPIN(cond, bar) do { unsigned _sp = 0; while (cond) { __builtin_amdgcn_s_sleep(1); \
    if ((++_sp & 255u) == 0u) { if (xb_ld(&(bar)[XB_TMO])) break; if (_sp > XB_SPIN_CAP) { atomicAdd(&(bar)[XB_TMO], 1u); break; } } } } while (0)
struct XcdBarrier { unsigned* bar; unsigned x; volatile LAS unsigned* st; };
__device__ __forceinline__ XcdBarrier xcd_barrier_post(unsigned* bar, volatile LAS unsigned* st) {
    XcdBarrier b; b.bar = bar; b.x = xb_xcc_id(); b.st = st;
    if (threadIdx.x == 0) (void)xb_add(&bar[XB_XCNT(b.x)], 1u);
    return b;
}
__device__ __forceinline__ void xcd_barrier_complete(unsigned* bar, unsigned x, unsigned& nloc, unsigned& nx) {
    const unsigned G = gridDim.x * gridDim.y * gridDim.z;
    unsigned sum, cnt, mine, sp = 0u;
    for (;;) {
        sum = 0u; cnt = 0u; mine = 0u;
#pragma unroll
        for (unsigned j = 0; j < 16; ++j) { const unsigned c = xb_ld(&bar[XB_XCNT(j)]); sum += c; cnt += (c > 0u) ? 1u : 0u; mine = (j == x) ? c : mine; }
        if (sum == G) break;
        __builtin_amdgcn_s_sleep(1);
        if ((++sp & 255u) == 0u) { if (xb_ld(&bar[XB_TMO])) break; if (sp > XB_SPIN_CAP) { atomicAdd(&bar[XB_TMO], 1u); break; } }
    }
    nloc = mine > 0u ? mine : 1u; nx = cnt > 0u ? cnt : 1u;
}
__device__ __forceinline__ void xcd_barrier(const XcdBarrier& b) {
    asm volatile("s_waitcnt vmcnt(0)" ::: "memory");
    __syncthreads();
    if (threadIdx.x == 0) {
        unsigned* bar = b.bar;
        __builtin_amdgcn_s_waitcnt(0);
        unsigned nloc = b.st[0], nx = b.st[1];
        if (nloc == 0u) { xcd_barrier_complete(bar, b.x, nloc, nx); b.st[0] = nloc; b.st[1] = nx; }
        const unsigned old = xb_add(&bar[XB_XSUB(b.x)], 1u);
        const unsigned gen = old / nloc;
        if (old + 1u == (gen + 1u) * nloc) {
            __builtin_amdgcn_fence(__ATOMIC_RELEASE, "agent");
            asm volatile("s_waitcnt vmcnt(0)" ::: "memory");
            const unsigned og = xb_add(&bar[XB_TOP], 1u);
            const unsigned tg = og / nx;
            if (og + 1u == (tg + 1u) * nx) xb_add(&bar[XB_TOPGEN], 1u);
            else XB_SPIN(xb_ld(&bar[XB_TOPGEN]) == tg, bar);
            __builtin_amdgcn_fence(__ATOMIC_ACQUIRE, "agent");
            xb_add(&bar[XB_XGEN(b.x)], 1u);
            asm volatile("s_waitcnt vmcnt(0)" ::: "memory");
        } else {
            XB_SPIN(xb_ld(&bar[XB_XGEN(b.x)]) == gen, bar);
            __builtin_amdgcn_fence(__ATOMIC_ACQUIRE, "agent");
            asm volatile("s_waitcnt vmcnt(0)" ::: "memory");
        }
    }
    __syncthreads();
}

struct Frame {
    LAS unsigned char* lds;
    volatile LAS unsigned* MISC;
    gu32* ctl;
    int tid, lane, wave;
    int vcu, G;
    unsigned char* ws; float* out;
    const float *x_prompt, *x_sample, *st_s5r, *st_s5i, *st_hg, *st_cv, *meta, *g_mix, *w_in, *lam_re, *lam_im, *log_dt, *b_re, *b_im, *c_re, *c_im, *s5_d,
                *w_glu, *b_glu, *hg_lb, *hg_ng, *w_out, *g_ffn, *w_up, *conv_w, *conv_b, *w_down, *g_final;
};
#define EPI_ARGS const f32x4 (&acc)[2][2][4][2], const pg8::Unit& u, int wr, int wc, int fr, int fq

__device__ __forceinline__ const float* h0_src(int row, const float* xp, const float* meta, const float* xs) {
    if (row >= R_SAMP) return xs + (size_t)(row - R_SAMP) * D;
    const int n = seq_of(row), s = row - n * SEQP;
    return s < NMETA ? meta + (size_t)s * D : xp + (size_t)(n * SEQ + s - NMETA) * D;
}
__device__ __forceinline__ float* h1_dst(int row, float* out, float* h1meta) {
    if (row >= R_SAMP) return out + OFF_YS + (size_t)(row - R_SAMP) * D;
    const int n = seq_of(row), s = row - n * SEQP;
    return s < NMETA ? h1meta + (size_t)(n * NMETA + s) * D : out + (size_t)(n * SEQ + s - NMETA) * D;
}
struct EpiIn {
    bf16 *U, *Q, *V, *G; float* LF; const float* lb;
    __device__ __forceinline__ void operator()(EPI_ARGS) const {
        const int seg = u.pn >> 1, cb = (u.pn & 1) * 256 + wc * 32 + 8 * fq, row0 = u.pm * 256 + wr * 64 + fr;
        bf16* dstb = seg == 0 ? U : (seg == 1 ? Q : (seg == 3 ? V : G));
#pragma unroll
        for (int ai = 0; ai < 2; ++ai)
#pragma unroll
            for (int m = 0; m < 4; ++m) { const size_t row = (size_t)(row0 + ai * 128 + m * 16);
#pragma unroll
                for (int bj = 0; bj < 2; ++bj) { const int col = cb + bj * 128; f32x4 v0 = acc[ai][bj][m][0], v1 = acc[ai][bj][m][1];
                    if (seg == 2) {
                        const f32x4 l0 = *(const f32x4*)(lb + col), l1 = *(const f32x4*)(lb + col + 4); f32x4 o0, o1;
#pragma unroll
                        for (int j = 0; j < 4; ++j) { o0[j] = __logf(l0[j] + (1.f - l0[j]) * sigmoidf_(v0[j])); o1[j] = __logf(l1[j] + (1.f - l1[j]) * sigmoidf_(v1[j])); }
                        *(f32x4*)(LF + row * HD + col) = o0; *(f32x4*)(LF + row * HD + col + 4) = o1;
                    } else {
                        if (seg == 4) {
#pragma unroll
                            for (int j = 0; j < 4; ++j) { v0[j] = siluf_(v0[j]); v1[j] = siluf_(v1[j]); } }
                        v4u w; w.x = pk2(v0[0], v0[1]); w.y = pk2(v0[2], v0[3]); w.z = pk2(v1[0], v1[1]); w.w = pk2(v1[2], v1[3]);
                        *(v4u*)(dstb + row * HD + col) = w;
                    } } }
    }
};
struct EpiGlu {
    const bf16* Y5; const float* bias; bf16* MIX;
    __device__ __forceinline__ void operator()(EPI_ARGS) const {
        const int col0 = u.pn * 256 + wc * 32 + 8 * fq, row0 = u.pm * 256 + wr * 64 + fr;
#pragma unroll
        for (int ai = 0; ai < 2; ++ai)
#pragma unroll
            for (int m = 0; m < 4; ++m) { const size_t row = (size_t)(row0 + ai * 128 + m * 16);
#pragma unroll
                for (int bj = 0; bj < 2; ++bj) { const int col = col0 + bj * 128; const f32x4 v0 = acc[ai][bj][m][0], v1 = acc[ai][bj][m][1];
                    const f32x4 b0 = *(const f32x4*)(bias + col), b1 = *(const f32x4*)(bias + col + 4);
                    const v4u y = *(const v4u*)(Y5 + row * HD + col);
                    v4u w;
                    w.x = pk2(bflo(y.x) * sigmoidf_(v0[0] + b0[0]), bfhi(y.x) * sigmoidf_(v0[1] + b0[1]));
                    w.y = pk2(bflo(y.y) * sigmoidf_(v0[2] + b0[2]), bfhi(y.y) * sigmoidf_(v0[3] + b0[3]));
                    w.z = pk2(bflo(y.z) * sigmoidf_(v1[0] + b1[0]), bfhi(y.z) * sigmoidf_(v1[1] + b1[1]));
                    w.w = pk2(bflo(y.w) * sigmoidf_(v1[2] + b1[2]), bfhi(y.w) * sigmoidf_(v1[3] + b1[3]));
                    *(v4u*)(MIX + row * D + col) = w; } }
    }
};
struct EpiOut {
    const float *xp, *meta, *xs; bf16* H1B; float* ss;
    __device__ __forceinline__ void operator()(EPI_ARGS) const {
        const int col0 = u.pn * 256 + wc * 32 + 8 * fq, row0 = u.pm * 256 + wr * 64 + fr;
#pragma unroll
        for (int ai = 0; ai < 2; ++ai)
#pragma unroll
            for (int m = 0; m < 4; ++m) { const int row = row0 + ai * 128 + m * 16;
                const float* src = h0_src(row, xp, meta, xs);
                float s = 0.f;
#pragma unroll
                for (int bj = 0; bj < 2; ++bj) { const int col = col0 + bj * 128;
                    const f32x4 h0 = *(const f32x4*)(src + col) + acc[ai][bj][m][0], h1 = *(const f32x4*)(src + col + 4) + acc[ai][bj][m][1];
                    v4u w; w.x = pk2(h0[0], h0[1]); w.y = pk2(h0[2], h0[3]); w.z = pk2(h1[0], h1[1]); w.w = pk2(h1[2], h1[3]);
                    *(v4u*)(H1B + (size_t)row * D + col) = w;
                    s += (h0[0] * h0[0] + h0[1] * h0[1]) + (h0[2] * h0[2] + h0[3] * h0[3]) + (h1[0] * h1[0] + h1[1] * h1[1]) + (h1[2] * h1[2] + h1[3] * h1[3]); }
                s += __shfl_xor(s, 16); s += __shfl_xor(s, 32);
                if (fq == 0 && ss) atomic_addf(ss + (size_t)row * SST, s); }
    }
};
struct EpiUpGate {
    const float* ss; bf16* GATED; float* out; const float *conv_w, *conv_b, *st_cv; LAS float* xch;
    __device__ __forceinline__ void operator()(EPI_ARGS) const {
        const int lane = fq * 16 + fr, cl = wc * 32 + 8 * fq, col = u.pn * 128 + cl;
        const int rbase = u.pm * 254 - 2 + wr * 64 + fr;
        float rstd[2][4];
#pragma unroll
        for (int ai = 0; ai < 2; ++ai)
#pragma unroll
            for (int m = 0; m < 4; ++m) { int row = rbase + ai * 128 + m * 16; row = row < 0 ? 0 : (row >= RT ? RT - 1 : row); rstd[ai][m] = __builtin_amdgcn_rsqf(ld_agent(ss + (size_t)row * SST) * (1.0f / D) + EPS); }
        if (fr >= 14) {
#pragma unroll
            for (int ai = 0; ai < 2; ++ai)
#pragma unroll
                for (int n = 0; n < 2; ++n) *(LAS f32x4*)(xch + ((ai * 2 + wr) * 2 + (fr - 14)) * 128 + cl + 4 * n) = acc[ai][0][3][n] * rstd[ai][3];
        }
        asm volatile("s_waitcnt lgkmcnt(0)" ::: "memory"); __builtin_amdgcn_s_barrier(); asm volatile("" ::: "memory");
        const int src1 = ((lane & 48) | ((fr - 1) & 15)) << 2, src2 = ((lane & 48) | ((fr - 2) & 15)) << 2;
#pragma unroll
        for (int n = 0; n < 2; ++n) {
            const int cn = col + 4 * n;
            const f32x4 cb = *(const f32x4*)(conv_b + cn), w0 = *(const f32x4*)(conv_w + cn), w1 = *(const f32x4*)(conv_w + DFF + cn), w2 = *(const f32x4*)(conv_w + 2 * DFF + cn);
#pragma unroll
            for (int ai = 0; ai < 2; ++ai) {
                int pb = ai * 2 + wr - 1; pb = pb < 0 ? 0 : pb;
                f32x4 r1p = *(const LAS f32x4*)(xch + (pb * 2 + 1) * 128 + cl + 4 * n), r2p = *(const LAS f32x4*)(xch + (pb * 2 + (fr & 1)) * 128 + cl + 4 * n);
#pragma unroll
                for (int m = 0; m < 4; ++m) {
                    const int i = ai * 128 + wr * 64 + m * 16 + fr, row = rbase + ai * 128 + m * 16;
                    const f32x4 a = acc[ai][0][m][n] * rstd[ai][m], v = acc[ai][1][m][n] * rstd[ai][m];
                    f32x4 c1, c2;
#pragma unroll
                    for (int j = 0; j < 4; ++j) { c1[j] = __shfl(a[j], src1 >> 2); c2[j] = __shfl(a[j], src2 >> 2); }
                    f32x4 p1 = fr == 0 ? r1p : c1, p2 = fr < 2 ? r2p : c2;
                    r1p = c1; r2p = c2;
                    if (i >= 2 && row < RT) {
                        float* cv = nullptr;
                        if (row >= R_SAMP) { const int sm = row - R_SAMP; const float* st = st_cv + (size_t)(sm * 2) * DFF + cn;
                            p2 = *(const f32x4*)st; p1 = *(const f32x4*)(st + DFF); *(f32x4*)(out + OFF_CVS + (size_t)(sm * 2) * DFF + cn) = p1;
                            cv = out + OFF_CVS + (size_t)(sm * 2 + 1) * DFF + cn;
                        } else { const int nn = seq_of(row), sq = row - nn * SEQP;
                            if (sq == 0) p1 = (f32x4){0.f, 0.f, 0.f, 0.f};
                            if (sq <= 1) p2 = (f32x4){0.f, 0.f, 0.f, 0.f};
                            if (sq >= SEQP - 2) cv = out + OFF_CVP + (size_t)(nn * 2 + sq - (SEQP - 2)) * DFF + cn; }
                        if (cv) *(f32x4*)cv = a;
                        float o[4];
#pragma unroll
                        for (int j = 0; j < 4; ++j) { const float cc = cb[j] + w0[j] * p2[j] + w1[j] * p1[j] + w2[j] * a[j]; o[j] = siluf_(cc) * v[j]; }
                        *(v2u*)(GATED + (size_t)row * DFF + cn) = (v2u){pk2(o[0], o[1]), pk2(o[2], o[3])}; }
                }
            }
        }
    }
};
__device__ __forceinline__ float* y_dst(int row, float* out) {
    if (row >= R_SAMP) return out + OFF_YS + (size_t)(row - R_SAMP) * D;
    const int n = seq_of(row), s = row - n * SEQP;
    return s < NMETA ? nullptr : out + (size_t)(n * SEQ + s - NMETA) * D;
}
struct EpiDown {
    const bf16* H1B; float* out; float* ss; float* dry;
    __device__ __forceinline__ void operator()(EPI_ARGS) const {
        const int col0 = u.pn * 256 + wc * 32 + 8 * fq, row0 = u.pm * 256 + wr * 64 + fr;
#pragma unroll
        for (int ai = 0; ai < 2; ++ai)
#pragma unroll
            for (int m = 0; m < 4; ++m) { const int row = row0 + ai * 128 + m * 16;
                float* dst = y_dst(row, out);
                float s = 0.f;
#pragma unroll
                for (int bj = 0; bj < 2; ++bj) { const int col = col0 + bj * 128;
                    const v4u hb = *(const v4u*)(H1B + (size_t)row * D + col);
                    const f32x4 h0 = (f32x4){bflo(hb.x), bfhi(hb.x), bflo(hb.y), bfhi(hb.y)} + acc[ai][bj][m][0], h1 = (f32x4){bflo(hb.z), bfhi(hb.z), bflo(hb.w), bfhi(hb.w)} + acc[ai][bj][m][1];
                    float* wp = dry ? dry + (((size_t)row * D + col) & 0x7FFFF8u) : dst + col;
                    if (dst) { *(f32x4*)(wp) = h0; *(f32x4*)(wp + 4) = h1; }
                    s += (h0[0] * h0[0] + h0[1] * h0[1]) + (h0[2] * h0[2] + h0[3] * h0[3]) + (h1[0] * h1[0] + h1[1] * h1[1]) + (h1[2] * h1[2] + h1[3] * h1[3]); }
                s += __shfl_xor(s, 16); s += __shfl_xor(s, 32);
                if (fq == 0 && !dry) atomic_addf(ss + (size_t)row * SST, s); }
    }
};
__device__ __forceinline__ void p0_transpose_item(const float* W, int K, int N, bf16* WT, const float* ksc, LAS float* scr, int item, int lane, bool upmap = false) {
    const int nblk = N / 64, kb = item / nblk, nb = item % nblk, k0 = 64 * kb, n0 = 64 * nb;
    const int d0 = !upmap ? n0 : (n0 < DFF ? 256 * (n0 >> 7) + (n0 & 127) : 256 * ((n0 - DFF) >> 7) + 128 + ((n0 - DFF) & 127));
    const int ks = lane >> 4, n4 = (lane & 15) * 4;
    f32x4 v[16]; float sc[16];
#pragma unroll
    for (int i = 0; i < 16; ++i) { const int kk = 4 * i + ks; v[i] = *(const GAS f32x4*)(W + (size_t)(k0 + kk) * N + n0 + n4); sc[i] = ksc ? ksc[k0 + kk] : 1.0f; }
#pragma unroll
    for (int i = 0; i < 16; ++i) { const int kk = 4 * i + ks; LAS float* d = scr + kk * 65 + n4; d[0] = v[i].x * sc[i]; d[1] = v[i].y * sc[i]; d[2] = v[i].z * sc[i]; d[3] = v[i].w * sc[i]; }
    LDS_WAIT(); asm volatile("" ::: "memory");
    const int c = lane & 7;
#pragma unroll
    for (int j = 0; j < 8; ++j) { const int n = (lane >> 3) + 8 * j; const LAS float* q = scr + (8 * c) * 65 + n;
        v4u o; o.x = pk2(q[0 * 65], q[1 * 65]); o.y = pk2(q[2 * 65], q[3 * 65]); o.z = pk2(q[4 * 65], q[5 * 65]); o.w = pk2(q[6 * 65], q[7 * 65]);
        *(GAS v4u*)(WT + (size_t)(d0 + n) * K + k0 + 8 * c) = o; }
    LDS_WAIT(); asm volatile("" ::: "memory");
}
template <int NR>
__device__ __forceinline__ void rms_rows_to_bf16(int lane, const float* const (&xrow)[NR], bf16* const (&orow)[NR]) {
    f32x4 v[NR][4]; float s[NR];
#pragma unroll
    for (int r = 0; r < NR; ++r) { const GAS f32x4* xr = (const GAS f32x4*)xrow[r] + lane;
#pragma unroll
        for (int j = 0; j < 4; ++j) v[r][j] = xr[64 * j]; }
#pragma unroll
    for (int r = 0; r < NR; ++r) { s[r] = 0.f;
#pragma unroll
        for (int j = 0; j < 4; ++j) s[r] += (v[r][j].x * v[r][j].x + v[r][j].y * v[r][j].y) + (v[r][j].z * v[r][j].z + v[r][j].w * v[r][j].w); }
#pragma unroll
    for (int o = 1; o < 64; o <<= 1) {
#pragma unroll
        for (int r = 0; r < NR; ++r) s[r] += __shfl_xor(s[r], o); }
#pragma unroll
    for (int r = 0; r < NR; ++r) { const float rstd = 1.0f / sqrtf(s[r] * (1.f / D) + EPS);
        GAS unsigned long long* o8 = (GAS unsigned long long*)orow[r] + lane;
#pragma unroll
        for (int j = 0; j < 4; ++j) o8[64 * j] = (unsigned long long)pk2(v[r][j].x * rstd, v[r][j].y * rstd) | ((unsigned long long)pk2(v[r][j].z * rstd, v[r][j].w * rstd) << 32); }
}
__device__ __forceinline__ void s5_precompute_item(Frame& F, int item) {
    const int g = item >> 3, b = item & 7;
    LAS float* Ap = (LAS float*)F.lds;
    LAS float* Bb = Ap + 2176;
    LAS float* Cc = Bb + 2048;
    LAS float* Kt = Cc + 2048;
    const int tid = F.tid;
    float* A1 = (float*)(F.ws + WS_S5F + S5F_A1); float* A16 = (float*)(F.ws + WS_S5F + S5F_A16); float* BBf = (float*)(F.ws + WS_S5F + S5F_BB);
    const float dt = expf(F.log_dt[g]);
    for (int idx = tid; idx < 17 * 64; idx += 512) { const int j = idx >> 6, p = idx & 63; const float lr = F.lam_re[g * 64 + p], li = F.lam_im[g * 64 + p];
        const double TWO_PI = 6.283185307179586476925286766559;
        const float mag = expf(lr * dt * (float)j);
        double rev = ((double)li * (double)dt * (double)j) / TWO_PI; rev -= rint(rev);
        const float ang = (float)(rev * TWO_PI);
        Ap[idx * 2] = mag * cosf(ang); Ap[idx * 2 + 1] = mag * sinf(ang); }
    for (int idx = tid; idx < 1024; idx += 512) { const int co = idx >> 6, p = idx & 63; Cc[idx * 2] = F.c_re[(g * 16 + co) * 64 + p]; Cc[idx * 2 + 1] = F.c_im[(g * 16 + co) * 64 + p]; }
    __syncthreads();
    for (int idx = tid; idx < 1024; idx += 512) { const int p = idx >> 4, c = idx & 15; const float lr = F.lam_re[g * 64 + p], li = F.lam_im[g * 64 + p];
        const float ar = Ap[(64 + p) * 2], ai = Ap[(64 + p) * 2 + 1];
        const float nr = ar - 1.0f, den = lr * lr + li * li, cr = (nr * lr + ai * li) / den, ci = (ai * lr - nr * li) / den;
        const float bre = F.b_re[(g * 64 + p) * 16 + c], bim = F.b_im[(g * 64 + p) * 16 + c];
        const float xr = cr * bre - ci * bim, xi = cr * bim + ci * bre;
        Bb[idx * 2] = xr; Bb[idx * 2 + 1] = xi;
        if (b == 0) { BBf[((g * 64 + p) * 16 + c) * 2] = xr; BBf[((g * 64 + p) * 16 + c) * 2 + 1] = xi;
            if (c == 0) { A1[(g * 64 + p) * 2] = ar; A1[(g * 64 + p) * 2 + 1] = ai; A16[(g * 64 + p) * 2] = Ap[(16 * 64 + p) * 2]; A16[(g * 64 + p) * 2 + 1] = Ap[(16 * 64 + p) * 2 + 1]; } } }
    __syncthreads();
    { const int jl = tid >> 8, co = (tid >> 4) & 15, ci = tid & 15, j = 2 * b + jl; float kv = 0.f;
        for (int p = 0; p < 64; ++p) { const float cr = Cc[(co * 64 + p) * 2], cim = Cc[(co * 64 + p) * 2 + 1], ar = Ap[(j * 64 + p) * 2], ai = Ap[(j * 64 + p) * 2 + 1];
            const float car = cr * ar - cim * ai, cai = cr * ai + cim * ar; kv += car * Bb[(p * 16 + ci) * 2] - cai * Bb[(p * 16 + ci) * 2 + 1]; }
        if (j == 0 && co == ci) kv += F.s5_d[g * 16 + co];
        Kt[tid] = kv; }
    __syncthreads();
    bf16* W1 = (bf16*)(F.ws + WS_S5W1) + (size_t)g * 384 * 256; bf16* W2 = (bf16*)(F.ws + WS_S5W2) + (size_t)g * 256 * 128;
    for (int idx = tid; idx < 2 * 16 * 128; idx += 512) { const int jl = idx >> 11, d = (idx >> 7) & 15, co = (idx >> 3) & 15, cp = idx & 7, j = 2 * b + jl;
        if (d + j < 16) { const int s = d, t = d + j;
            *(unsigned*)(W1 + (size_t)(t * 16 + co) * 256 + s * 16 + 2 * cp) = pk2(Kt[jl * 256 + co * 16 + 2 * cp], Kt[jl * 256 + co * 16 + 2 * cp + 1]);
            if (j >= 1) *(unsigned*)(W1 + (size_t)(s * 16 + co) * 256 + t * 16 + 2 * cp) = 0u; } }
    for (int idx = tid; idx < 16 * 128; idx += 512) { const int pp = 16 * b + (idx >> 7), k = (idx & 127) * 2, s = k >> 4, ci = k & 15, p = pp & 63;
        const float ar = Ap[((15 - s) * 64 + p) * 2], ai = Ap[((15 - s) * 64 + p) * 2 + 1];
        const float b0r = Bb[(p * 16 + ci) * 2], b0i = Bb[(p * 16 + ci) * 2 + 1], b1r = Bb[(p * 16 + ci + 1) * 2], b1i = Bb[(p * 16 + ci + 1) * 2 + 1];
        const float v0 = pp < 64 ? ar * b0r - ai * b0i : ar * b0i + ai * b0r, v1 = pp < 64 ? ar * b1r - ai * b1i : ar * b1i + ai * b1r;
        *(unsigned*)(W1 + (size_t)(256 + pp) * 256 + k) = pk2(v0, v1); }
    for (int idx = tid; idx < 32 * 64; idx += 512) { const int n = 32 * b + (idx >> 6), kq = (idx & 63) * 2, t = n >> 4, co = n & 15; float v[2];
#pragma unroll
        for (int e = 0; e < 2; ++e) { const int pp = kq + e, p = pp & 63; const float cr = Cc[(co * 64 + p) * 2], cim = Cc[(co * 64 + p) * 2 + 1], ar = Ap[((t + 1) * 64 + p) * 2], ai = Ap[((t + 1) * 64 + p) * 2 + 1];
            v[e] = pp < 64 ? (cr * ar - cim * ai) : -(cr * ai + cim * ar); }
        *(unsigned*)(W2 + (size_t)n * 128 + kq) = pk2(v[0], v[1]); }
    __syncthreads();
}
__device__ __forceinline__ void p0_prologue(Frame& F) {
    { v4u* z = (v4u*)(F.ws + WS_SS2); const v4u zero = (v4u){0u, 0u, 0u, 0u};
      for (size_t i = (size_t)F.vcu * 512 + F.tid; i < (WS_HSS + STAT_BYTES - WS_SS2) / 16; i += (size_t)F.G * 512) z[i] = zero; }
    for (int it = F.vcu; it < 256; it += F.G) s5_precompute_item(F, it);
    if (F.vcu == 32 % F.G) {
        float* LB = (float*)(F.ws + WS_S5F + S5F_LB); const float a0 = F.hg_lb[F.tid], a1 = F.hg_lb[512 + F.tid], mx = fmaxf(a0, a1), e0 = expf(a0 - mx), e1 = expf(a1 - mx); LB[F.tid] = e0 / (e0 + e1); }
    LAS float* scr = (LAS float*)(F.lds + RING_OFF + F.wave * 16896);
    const int gw = F.vcu * NWAVES + F.wave, NGW = F.G * NWAVES;
    constexpr int I_IN = (D / 64) * (INC / 64), I_GLU = (HD / 64) * (HD / 64), I_OUT = (D / 64) * (D / 64), I_UP = (D / 64) * (UPC / 64), I_DN = (DFF / 64) * (D / 64);
    constexpr int NITEMS = I_IN + I_GLU + I_OUT + I_UP + I_DN;
    for (int it = gw; it < NITEMS; it += NGW) {
        int r = it;
        if (r < I_IN) { p0_transpose_item(F.w_in, D, INC, (bf16*)(F.ws + WS_WIN), F.g_mix, scr, r, F.lane); continue; } r -= I_IN;
        if (r < I_GLU) { p0_transpose_item(F.w_glu, HD, HD, (bf16*)(F.ws + WS_WGLU), nullptr, scr, r, F.lane); continue; } r -= I_GLU;
        if (r < I_OUT) { p0_transpose_item(F.w_out, D, D, (bf16*)(F.ws + WS_WOUT), nullptr, scr, r, F.lane); continue; } r -= I_OUT;
        if (r < I_UP) { p0_transpose_item(F.w_up, D, UPC, (bf16*)(F.ws + WS_WUP), F.g_ffn, scr, r, F.lane, true); continue; } r -= I_UP;
        p0_transpose_item(F.w_down, DFF, D, (bf16*)(F.ws + WS_WDN), nullptr, scr, r, F.lane);
    }
    bf16* XN = (bf16*)(F.ws + WS_XN);
    for (int m0 = gw * 4; m0 < RT; m0 += NGW * 4) {
        const float* src[4]; bf16* dst[4];
#pragma unroll
        for (int r = 0; r < 4; ++r) { const int m = m0 + r;
            src[r] = h0_src(m, F.x_prompt, F.meta, F.x_sample);
            dst[r] = XN + (size_t)m * D; }
        rms_rows_to_bf16<4>(F.lane, src, dst);
    }
}

__device__ __forceinline__ void s5_prompt_item(Frame& F, int item) {
    const int g = item & 31, n = item >> 5;
    LAS unsigned char* R1 = F.lds;
    LAS float* R2 = (LAS float*)(F.lds + 76032);
    int tid = F.tid; asm volatile("" : "+v"(tid));
    const int lane = tid & 63, w = F.wave, r = lane & 15, q = lane >> 4;
    const bf16* U = (const bf16*)(F.ws + WS_U);
#pragma unroll
    for (int i = 0; i < 9; ++i) { const int idx = tid + 512 * i, c = idx >> 5, pc = idx & 31, s = pc >> 1, half = pc & 1, cc = c < 128 ? c : 128;
        const int grow = SEQP * n + 16 * cc + s;
        const v4u val = *(const v4u*)(U + (size_t)grow * HD + 16 * g + 8 * half);
        *(LAS v4u*)(R1 + c * 528 + pc * 16) = val; }
    __syncthreads();
    const bf16* W1 = (const bf16*)(F.ws + WS_S5W1) + (size_t)g * 384 * 256; const bf16* W2 = (const bf16*)(F.ws + WS_S5W2) + (size_t)g * 256 * 128;
    f32x4 acc0[9], acc1[9], acc2[9];
#pragma unroll
    for (int mt = 0; mt < 9; ++mt) { acc0[mt] = (f32x4){0.f, 0.f, 0.f, 0.f}; acc1[mt] = acc0[mt]; acc2[mt] = acc0[mt]; }
#pragma unroll 1
    for (int kk = 0; kk < 8; ++kk) {
        const bool need0 = (2 * kk <= w);
        const bool need1 = (2 * kk <= w + 8);
        const bf16x8 b2 = *(const bf16x8*)(W1 + (size_t)(16 * (16 + w) + r) * 256 + 32 * kk + 8 * q);
        bf16x8 b0 = b2, b1 = b2;
        if (need0) b0 = *(const bf16x8*)(W1 + (size_t)(16 * w + r) * 256 + 32 * kk + 8 * q);
        if (need1) b1 = *(const bf16x8*)(W1 + (size_t)(16 * (w + 8) + r) * 256 + 32 * kk + 8 * q);
#pragma unroll
        for (int mt = 0; mt < 9; ++mt) { const bf16x8 a = *(const LAS bf16x8*)(R1 + (16 * mt + r) * 528 + (32 * kk + 8 * q) * 2);
            acc2[mt] = mfma16(a, b2, acc2[mt]);
            if (need0) acc0[mt] = mfma16(a, b0, acc0[mt]);
            if (need1) acc1[mt] = mfma16(a, b1, acc1[mt]); }
    }
#pragma unroll
    for (int mt = 0; mt < 9; ++mt)
#pragma unroll
        for (int i = 0; i < 4; ++i) R2[(16 * mt + 4 * q + i) * 132 + 16 * w + r] = acc2[mt][i];
    __syncthreads();
    if (w == 0) {
        const float* A16 = (const float*)(F.ws + WS_S5F + S5F_A16); const float ar = A16[(g * 64 + lane) * 2], ai = A16[(g * 64 + lane) * 2 + 1];
        float hr = 0.f, hi = 0.f;
        for (int c0 = 0; c0 < 136; c0 += 8) {
            float lr[8], li[8];
#pragma unroll
            for (int j = 0; j < 8; ++j) { lr[j] = R2[(c0 + j) * 132 + lane]; li[j] = R2[(c0 + j) * 132 + 64 + lane]; }
#pragma unroll
            for (int j = 0; j < 8; ++j) { const int c = c0 + j;
                if (c <= 128) {
                    *(LAS bf16*)(R1 + c * 272 + lane * 2) = (bf16)f2bf(hr); *(LAS bf16*)(R1 + c * 272 + 128 + lane * 2) = (bf16)f2bf(hi);
                    const float nr = ar * hr - ai * hi + lr[j], ni = ar * hi + ai * hr + li[j]; hr = nr; hi = ni;
                } else { *(LAS bf16*)(R1 + c * 272 + lane * 2) = 0; *(LAS bf16*)(R1 + c * 272 + 128 + lane * 2) = 0; } }
        }
#pragma unroll
        for (int c = 136; c < 144; ++c) { *(LAS bf16*)(R1 + c * 272 + lane * 2) = 0; *(LAS bf16*)(R1 + c * 272 + 128 + lane * 2) = 0; }
        F.out[OFF_S5RP + (size_t)(n * 32 + g) * 64 + lane] = hr; F.out[OFF_S5IP + (size_t)(n * 32 + g) * 64 + lane] = hi;
    }
    __syncthreads();
#pragma unroll 1
    for (int kk = 0; kk < 4; ++kk) {
        const bf16x8 b0 = *(const bf16x8*)(W2 + (size_t)(16 * w + r) * 128 + 32 * kk + 8 * q), b1 = *(const bf16x8*)(W2 + (size_t)(16 * (w + 8) + r) * 128 + 32 * kk + 8 * q);
#pragma unroll
        for (int mt = 0; mt < 9; ++mt) { const bf16x8 a = *(const LAS bf16x8*)(R1 + (16 * mt + r) * 272 + (32 * kk + 8 * q) * 2);
            acc0[mt] = mfma16(a, b0, acc0[mt]); acc1[mt] = mfma16(a, b1, acc1[mt]); }
    }
    bf16* Y5 = (bf16*)(F.ws + WS_Y5);
#pragma unroll
    for (int mt = 0; mt < 9; ++mt)
#pragma unroll
        for (int i = 0; i < 4; ++i) { const int c = 16 * mt + 4 * q + i;
            if (c <= 128) { const int rb = SEQP * n + 16 * c;
                Y5[(size_t)(rb + w) * HD + 16 * g + r] = (bf16)f2bf(gelu_tanh(acc0[mt][i]));
                Y5[(size_t)(rb + w + 8) * HD + 16 * g + r] = (bf16)f2bf(gelu_tanh(acc1[mt][i])); } }
    __syncthreads();
}
__device__ __forceinline__ void s5_sample_item(Frame& F, int item) {
    const int g = item & 31, s = item >> 5, lane = F.lane, row = R_SAMP + s;
    const bf16* U = (const bf16*)(F.ws + WS_U); bf16* Y5 = (bf16*)(F.ws + WS_Y5);
    const float* A1 = (const float*)(F.ws + WS_S5F + S5F_A1); const float* BBf = (const float*)(F.ws + WS_S5F + S5F_BB);
    const v4u u0 = *(const v4u*)(U + (size_t)row * HD + 16 * g), u1 = *(const v4u*)(U + (size_t)row * HD + 16 * g + 8);
    float uu[16]; uu[0] = bflo(u0.x); uu[1] = bfhi(u0.x); uu[2] = bflo(u0.y); uu[3] = bfhi(u0.y); uu[4] = bflo(u0.z); uu[5] = bfhi(u0.z); uu[6] = bflo(u0.w); uu[7] = bfhi(u0.w);
    uu[8] = bflo(u1.x); uu[9] = bfhi(u1.x); uu[10] = bflo(u1.y); uu[11] = bfhi(u1.y); uu[12] = bflo(u1.z); uu[13] = bfhi(u1.z); uu[14] = bflo(u1.w); uu[15] = bfhi(u1.w);
    float xr = 0.f, xi = 0.f; const float* bb = BBf + (size_t)(g * 64 + lane) * 32;
#pragma unroll
    for (int c = 0; c < 16; ++c) { xr += bb[2 * c] * uu[c]; xi += bb[2 * c + 1] * uu[c]; }
    const float ar = A1[(g * 64 + lane) * 2], ai = A1[(g * 64 + lane) * 2 + 1];
    const float h0r = F.st_s5r[(size_t)(s * 32 + g) * 64 + lane], h0i = F.st_s5i[(size_t)(s * 32 + g) * 64 + lane];
    const float hr = ar * h0r - ai * h0i + xr, hi = ar * h0i + ai * h0r + xi;
    F.out[OFF_S5RS + (size_t)(s * 32 + g) * 64 + lane] = hr; F.out[OFF_S5IS + (size_t)(s * 32 + g) * 64 + lane] = hi;
    float yk = 0.f;
#pragma unroll
    for (int co = 0; co < 16; ++co) { const float part = hr * F.c_re[(g * 16 + co) * 64 + lane] - hi * F.c_im[(g * 16 + co) * 64 + lane]; const float tot = wave_sum(part); if (lane == co) yk = tot; }
    if (lane < 16) { float uc = 0.f;
#pragma unroll
        for (int c = 0; c < 16; ++c) uc = (lane == c) ? uu[c] : uc;
        const float y = yk + F.s5_d[g * 16 + lane] * uc; Y5[(size_t)row * HD + 16 * g + lane] = (bf16)f2bf(gelu_tanh(y)); }
}
#define HG_O_QD 0
#define HG_O_KD 17408
#define HG_O_KT 34816
#define HG_O_VT 53248
#define HG_O_ATT 55552
#define HG_O_ST 64768
#define HG_O_SEG 69120
#define HG_O_DEC 71168
constexpr size_t WS_HQD = WS_XN, WS_HATT = WS_XN + (size_t)1056 * 64 * 128 * 2, WS_HKT = WS_ZEND, WS_HDEC = WS_ZEND + (size_t)1056 * 128 * 64 * 2;
static_assert(WS_HATT + (size_t)1056 * 64 * 64 * 2 <= WS_U && WS_HDEC + (size_t)1056 * 128 * 4 <= WS_END, "hgrn operand buffers");
__device__ __forceinline__ void hgrn_pre_items(Frame& F) {
    LAS unsigned char* L = F.lds;
    int tid = F.tid; asm volatile("" : "+v"(tid));
    const int lane = tid & 63, w = F.wave, r = lane & 15, q = lane >> 4;
    const bf16* Qb = (const bf16*)(F.ws + WS_Q); const float* LF = (const float*)(F.ws + WS_LF);
    bf16* QDg = (bf16*)(F.ws + WS_HQD); bf16* ATTg = (bf16*)(F.ws + WS_HATT); bf16* KTg = (bf16*)(F.ws + WS_HKT); float* DECg = (float*)(F.ws + WS_HDEC);
    for (int i = tid; i < 9216 / 4; i += 512) ((LAS unsigned*)(L + HG_O_ATT))[i] = 0u;
    const int k = tid & 127, s4 = tid >> 7;
    float lf[16]; unsigned short qv[16];
#define HG_LOAD(item) do { const int c_ = (item) % 33, nh_ = (item) / 33, n_ = nh_ >> 2, h_ = nh_ & 3; \
        _Pragma("unroll") for (int i = 0; i < 16; ++i) { const int t = 16 * s4 + i; const int row = c_ == 0 ? (t < 16 ? SEQP * n_ + t : -1) : SEQP * n_ + 16 + 64 * (c_ - 1) + t; \
            if (row >= 0) { lf[i] = LF[(size_t)row * HD + 128 * h_ + k]; qv[i] = Qb[(size_t)row * HD + 128 * h_ + k]; } else { lf[i] = 0.f; qv[i] = 0; } } } while (0)
    int item = F.vcu;
    if (item < 1056) HG_LOAD(item);
    for (; item < 1056; item += F.G) {
        float bc[16]; float run = 0.f;
#pragma unroll
        for (int i = 0; i < 16; ++i) { run += lf[i]; bc[i] = run; }
        ((LAS float*)(L + HG_O_SEG))[s4 * 128 + k] = run;
        __syncthreads();
        float off = 0.f, bl = 0.f;
#pragma unroll
        for (int s = 0; s < 4; ++s) { const float v = ((LAS float*)(L + HG_O_SEG))[s * 128 + k]; bl += v; off += (s < s4) ? v : 0.f; }
        if (s4 == 0) DECg[(size_t)item * 128 + k] = __expf(bl);
        unsigned kp[8];
#pragma unroll
        for (int i = 0; i < 16; i += 2) { float kdl2[2];
#pragma unroll
            for (int e = 0; e < 2; ++e) { const int ii = i + e; const float b = off + bc[ii], f = __expf(lf[ii]), kk = 1.0f - f, eb = __expf(b), enb = __expf(-b);
                *(LAS bf16*)(L + HG_O_QD + (16 * s4 + ii) * 272 + k * 2) = (bf16)f2bf(bf2f(qv[ii]) * eb);
                *(LAS bf16*)(L + HG_O_KD + (16 * s4 + ii) * 272 + k * 2) = (bf16)f2bf(kk * enb);
                kdl2[e] = kk * __expf(bl - b); }
            kp[i >> 1] = pk2(kdl2[0], kdl2[1]); }
        *(v4u*)(KTg + ((size_t)item * 128 + k) * 64 + 16 * s4) = (v4u){kp[0], kp[1], kp[2], kp[3]};
        *(v4u*)(KTg + ((size_t)item * 128 + k) * 64 + 16 * s4 + 8) = (v4u){kp[4], kp[5], kp[6], kp[7]};
        __syncthreads();
        if (item + F.G < 1056) HG_LOAD(item + F.G);
#pragma unroll
        for (int j = 0; j < 2; ++j) { const int idx = tid + 512 * j, t = idx >> 4, pc = idx & 15; *(v4u*)(QDg + ((size_t)item * 64 + t) * 128 + pc * 8) = *(const LAS v4u*)(L + HG_O_QD + t * 272 + pc * 16); }
#pragma unroll
        for (int rep = 0; rep < 2; ++rep) { const int idx = w + 8 * rep;
            if (idx < 10) { const int ti = idx < 1 ? 0 : (idx < 3 ? 1 : (idx < 6 ? 2 : 3)), sj = idx - (ti * (ti + 1)) / 2;
                f32x4 at = (f32x4){0.f, 0.f, 0.f, 0.f};
#pragma unroll
                for (int kk = 0; kk < 4; ++kk) { const bf16x8 a = *(const LAS bf16x8*)(L + HG_O_QD + (16 * ti + r) * 272 + (32 * kk + 8 * q) * 2), b = *(const LAS bf16x8*)(L + HG_O_KD + (16 * sj + r) * 272 + (32 * kk + 8 * q) * 2); at = mfma16(a, b, at); }
#pragma unroll
                for (int i = 0; i < 4; ++i) { const int t = 16 * ti + 4 * q + i, s = 16 * sj + r; *(LAS bf16*)(L + HG_O_ATT + t * 144 + s * 2) = (bf16)f2bf(s <= t ? at[i] : 0.f); } } }
        __syncthreads();
        { const int t = tid >> 3, pc = tid & 7; *(v4u*)(ATTg + ((size_t)item * 64 + t) * 64 + pc * 8) = *(const LAS v4u*)(L + HG_O_ATT + t * 144 + pc * 16); }
    }
#undef HG_LOAD
    __syncthreads();
}
__device__ __forceinline__ void hgrn_seq_item(Frame& F, int item, bool atom = true) {
    const int vs = item & 7, h = (item >> 3) & 3, n = item >> 5;
    LAS unsigned char* L = F.lds;
    int tid = F.tid; asm volatile("" : "+v"(tid));
    const int lane = tid & 63, w = F.wave, r = lane & 15, q = lane >> 4;
    const bf16* Vb = (const bf16*)(F.ws + WS_V);
    const bf16* QDg = (const bf16*)(F.ws + WS_HQD); const bf16* ATTg = (const bf16*)(F.ws + WS_HATT); const bf16* KTg = (const bf16*)(F.ws + WS_HKT); const float* DECg = (const float*)(F.ws + WS_HDEC);
    bf16* OH = (bf16*)(F.ws + WS_OH); float* HSS = (float*)(F.ws + WS_HSS);
    for (int i = tid; i < 4352 / 4; i += 512) ((LAS unsigned*)(L + HG_O_ST))[i] = 0u;
    f32x4 Sreg = (f32x4){0.f, 0.f, 0.f, 0.f};
    const int tv = tid >> 3, pr = tid & 7;
    v4u pq[2], pk[2], pa; unsigned vv; float dc;
#define HG_LOAD(c) do { const size_t it_ = (size_t)((n * 4 + h) * 33 + (c)); \
        _Pragma("unroll") for (int j = 0; j < 2; ++j) { const int idx = tid + 512 * j; pq[j] = *(const v4u*)(QDg + it_ * 8192 + (size_t)idx * 8); pk[j] = *(const v4u*)(KTg + it_ * 8192 + (size_t)idx * 8); } \
        pa = *(const v4u*)(ATTg + it_ * 4096 + (size_t)tid * 8); dc = DECg[it_ * 128 + (tid & 127)]; \
        { const int row = (c) == 0 ? (tv < 16 ? SEQP * n + tv : -1) : SEQP * n + 16 + 64 * ((c) - 1) + tv; \
          vv = row >= 0 ? *(const unsigned*)(Vb + (size_t)row * HD + 128 * h + 16 * vs + 2 * pr) : 0u; } } while (0)
    HG_LOAD(0);
    for (int c = 0; c <= 32; ++c) {
#pragma unroll
        for (int j = 0; j < 2; ++j) { const int idx = tid + 512 * j;
            *(LAS v4u*)(L + HG_O_QD + (idx >> 4) * 272 + (idx & 15) * 16) = pq[j];
            *(LAS v4u*)(L + HG_O_KT + (idx >> 3) * 144 + (idx & 7) * 16) = pk[j]; }
        *(LAS v4u*)(L + HG_O_ATT + (tid >> 3) * 144 + (tid & 7) * 16) = pa;
        if (tid < 128) ((LAS float*)(L + HG_O_DEC))[tid] = dc;
        *(LAS bf16*)(L + HG_O_VT + (2 * pr) * 144 + tv * 2) = (bf16)(vv & 0xffffu); *(LAS bf16*)(L + HG_O_VT + (2 * pr + 1) * 144 + tv * 2) = (bf16)(vv >> 16);
        __syncthreads();
        if (c < 32) HG_LOAD(c + 1);
        f32x4 accS;
#pragma unroll
        for (int i = 0; i < 4; ++i) accS[i] = ((LAS float*)(L + HG_O_DEC))[16 * w + 4 * q + i] * Sreg[i];
#pragma unroll
        for (int kk = 0; kk < 2; ++kk) { const bf16x8 a = *(const LAS bf16x8*)(L + HG_O_KT + (16 * w + r) * 144 + (32 * kk + 8 * q) * 2), b = *(const LAS bf16x8*)(L + HG_O_VT + r * 144 + (32 * kk + 8 * q) * 2); accS = mfma16(a, b, accS); }
        if (w < 4) {
            f32x4 o = (f32x4){0.f, 0.f, 0.f, 0.f};
#pragma unroll
            for (int kk = 0; kk < 4; ++kk) { const bf16x8 a = *(const LAS bf16x8*)(L + HG_O_QD + (16 * w + r) * 272 + (32 * kk + 8 * q) * 2), b = *(const LAS bf16x8*)(L + HG_O_ST + r * 272 + (32 * kk + 8 * q) * 2); o = mfma16(a, b, o); }
#pragma unroll
            for (int kk = 0; kk < 2; ++kk) { const bf16x8 a = *(const LAS bf16x8*)(L + HG_O_ATT + (16 * w + r) * 144 + (32 * kk + 8 * q) * 2), b = *(const LAS bf16x8*)(L + HG_O_VT + r * 144 + (32 * kk + 8 * q) * 2); o = mfma16(a, b, o); }
#pragma unroll
            for (int i = 0; i < 4; ++i) { const int t = 16 * w + 4 * q + i; const int row = c == 0 ? (t < 16 ? SEQP * n + t : -1) : SEQP * n + 16 + 64 * (c - 1) + t;
                float ss = o[i] * o[i]; ss += __shfl_xor(ss, 1); ss += __shfl_xor(ss, 2); ss += __shfl_xor(ss, 4); ss += __shfl_xor(ss, 8);
                if (row >= 0) { OH[(size_t)row * HD + 128 * h + 16 * vs + r] = (bf16)f2bf(o[i]); if (r == 0 && atom) atomic_addf(HSS + (size_t)row * SST + h, ss); } } }
        __syncthreads();
        Sreg = accS;
        *(LAS v2u*)(L + HG_O_ST + r * 272 + (16 * w + 4 * q) * 2) = (v2u){pk2(Sreg[0], Sreg[1]), pk2(Sreg[2], Sreg[3])};
    }
#undef HG_LOAD
#pragma unroll
    for (int i = 0; i < 4; ++i) F.out[OFF_HGP + ((size_t)(n * 4 + h) * 128 + 16 * w + 4 * q + i) * 128 + 16 * vs + r] = Sreg[i];
    __syncthreads();
}
__device__ __forceinline__ void hgrn_sample_item(Frame& F, int item, bool atom = true) {
    const int h = item & 3, s = item >> 2, row = R_SAMP + s, tid = F.tid, vq = tid & 31, kg = tid >> 5;
    const bf16* Qb = (const bf16*)(F.ws + WS_Q); const bf16* Vb = (const bf16*)(F.ws + WS_V); const float* LF = (const float*)(F.ws + WS_LF);
    bf16* OH = (bf16*)(F.ws + WS_OH); float* HSS = (float*)(F.ws + WS_HSS);
    LAS float* red = (LAS float*)F.lds;
    const v2u vw = *(const v2u*)(Vb + (size_t)row * HD + 128 * h + 4 * vq);
    const f32x4 v4 = (f32x4){bflo(vw.x), bfhi(vw.x), bflo(vw.y), bfhi(vw.y)};
    f32x4 o4 = (f32x4){0.f, 0.f, 0.f, 0.f};
#pragma unroll
    for (int i = 0; i < 8; ++i) { const int k = 8 * kg + i; const float f = __expf(LF[(size_t)row * HD + 128 * h + k]), kk = 1.0f - f, qk = bf2f(Qb[(size_t)row * HD + 128 * h + k]);
        const size_t off = ((size_t)(s * 4 + h) * 128 + k) * 128 + 4 * vq;
        const f32x4 sn = *(const f32x4*)(F.st_hg + off) * f + v4 * kk;
        *(f32x4*)(F.out + OFF_HGS + off) = sn; o4 += sn * qk; }
    *(LAS f32x4*)(red + kg * 128 + 4 * vq) = o4;
    __syncthreads();
    if (tid < 128) { float o = 0.f;
#pragma unroll
        for (int j = 0; j < 16; ++j) o += red[j * 128 + tid];
        OH[(size_t)row * HD + 128 * h + tid] = (bf16)f2bf(o);
        const float ss = wave_sum(o * o); if (F.lane == 0 && atom) atomic_addf(HSS + (size_t)row * SST + h, ss); }
    __syncthreads();
}

constexpr int TAIL_ROW0 = 16384;
template <class Epi>
__device__ __forceinline__ void tail_gemm(Frame& F, const bf16* A, int lda, const bf16* Bt, int K, const Epi& E) {
    int tid = F.tid; asm volatile("" : "+v"(tid));
    const int lane = tid & 63, w = F.wave, r = lane & 15, q = lane >> 4;
    LAS float* red = (LAS float*)F.lds;
    const int kw = K >> 3, nks = kw >> 5;
    for (int su = F.vcu; su < 256; su += F.G) {
        const int rb = su >> 5, cb = su & 31;
        const bf16* Ap = A + (size_t)(TAIL_ROW0 + 32 * rb + r) * lda + w * kw + 8 * q;
        const bf16* Bp = Bt + (size_t)(32 * cb + r) * K + w * kw + 8 * q;
        f32x4 acc[2][2];
#pragma unroll
        for (int mi = 0; mi < 2; ++mi)
#pragma unroll
            for (int ni = 0; ni < 2; ++ni) acc[mi][ni] = (f32x4){0.f, 0.f, 0.f, 0.f};
#pragma unroll 4
        for (int kk = 0; kk < nks; ++kk) {
            const bf16x8 a0 = *(const bf16x8*)(Ap + 32 * kk), a1 = *(const bf16x8*)(Ap + (size_t)16 * lda + 32 * kk);
            const bf16x8 b0 = *(const bf16x8*)(Bp + 32 * kk), b1 = *(const bf16x8*)(Bp + (size_t)16 * K + 32 * kk);
            acc[0][0] = mfma16(a0, b0, acc[0][0]); acc[0][1] = mfma16(a0, b1, acc[0][1]); acc[1][0] = mfma16(a1, b0, acc[1][0]); acc[1][1] = mfma16(a1, b1, acc[1][1]);
        }
#pragma unroll
        for (int mi = 0; mi < 2; ++mi)
#pragma unroll
            for (int ni = 0; ni < 2; ++ni)
#pragma unroll
                for (int i = 0; i < 4; ++i) red[(w * 32 + 16 * mi + 4 * q + i) * 32 + 16 * ni + r] = acc[mi][ni][i];
        __syncthreads();
        { const int row = tid >> 4, col = (tid & 15) * 2; float v0 = 0.f, v1 = 0.f;
#pragma unroll
            for (int ww = 0; ww < 8; ++ww) { v0 += red[(ww * 32 + row) * 32 + col]; v1 += red[(ww * 32 + row) * 32 + col + 1]; }
            E(TAIL_ROW0 + 32 * rb + row, 32 * cb + col, v0, v1); }
        __syncthreads();
    }
}
struct TailOut {
    const float *xp, *meta, *xs; bf16* H1B; float* ss;
    __device__ __forceinline__ void operator()(int row, int col, float v0, float v1) const {
        const float* src = h0_src(row, xp, meta, xs);
        const float a = src[col] + v0, b = src[col + 1] + v1;
        *(unsigned*)(H1B + (size_t)row * D + col) = pk2(a, b);
        float q2 = a * a + b * b; q2 += __shfl_xor(q2, 1); q2 += __shfl_xor(q2, 2); q2 += __shfl_xor(q2, 4); q2 += __shfl_xor(q2, 8);
        if ((col & 31) == 0 && ss) atomic_addf(ss + (size_t)row * SST, q2);
    }
};
struct TailDown {
    const bf16* H1B; float* out; float* ss;
    __device__ __forceinline__ void operator()(int row, int col, float v0, float v1) const {
        float* dst = y_dst(row, out); const unsigned hb = *(const unsigned*)(H1B + (size_t)row * D + col);
        const float a = bflo(hb) + v0, b = bfhi(hb) + v1; if (dst) { dst[col] = a; dst[col + 1] = b; }
        float q2 = a * a + b * b; q2 += __shfl_xor(q2, 1); q2 += __shfl_xor(q2, 2); q2 += __shfl_xor(q2, 4); q2 += __shfl_xor(q2, 8);
        if ((col & 31) == 0) atomic_addf(ss + (size_t)row * SST, q2);
    }
};
__device__ __forceinline__ void hgrn_finalize(Frame& F) {
    const bf16* OH = (const bf16*)(F.ws + WS_OH); const bf16* G = (const bf16*)(F.ws + WS_G); const float* HSS = (const float*)(F.ws + WS_HSS); bf16* MIX = (bf16*)(F.ws + WS_MIX);
    const int gt = F.vcu * 512 + F.tid, NT = F.G * 512;
    for (int idx = gt; idx < RT * 64; idx += NT) { const int row = idx >> 6, c8 = (idx & 63) * 8;
        const float rstd = __builtin_amdgcn_rsqf(ld_agent(HSS + (size_t)row * SST + (c8 >> 7)) * (1.0f / 128.0f) + EPS);
        const v4u o = *(const v4u*)(OH + (size_t)row * HD + c8), gg = *(const v4u*)(G + (size_t)row * HD + c8);
        const f32x4 n0 = *(const f32x4*)(F.hg_ng + c8), n1 = *(const f32x4*)(F.hg_ng + c8 + 4);
        v4u w;
        w.x = pk2(bflo(o.x) * rstd * n0[0] * bflo(gg.x), bfhi(o.x) * rstd * n0[1] * bfhi(gg.x));
        w.y = pk2(bflo(o.y) * rstd * n0[2] * bflo(gg.y), bfhi(o.y) * rstd * n0[3] * bfhi(gg.y));
        w.z = pk2(bflo(o.z) * rstd * n1[0] * bflo(gg.z), bfhi(o.z) * rstd * n1[1] * bfhi(gg.z));
        w.w = pk2(bflo(o.w) * rstd * n1[2] * bflo(gg.w), bfhi(o.w) * rstd * n1[3] * bfhi(gg.w));
        *(v4u*)(MIX + (size_t)row * D + 512 + c8) = w; }
}
__device__ __forceinline__ void final_norm(Frame& F) {
    const float* SS3 = (const float*)(F.ws + WS_SS3);
    const int gw = F.vcu * NWAVES + F.wave, NGW = F.G * NWAVES;
    f32x4 gg[4];
#pragma unroll
    for (int j = 0; j < 4; ++j) gg[j] = *(const f32x4*)(F.g_final + 4 * F.lane + 256 * j);
    for (int i0 = gw * 4; i0 < NB * SEQ + NS; i0 += NGW * 4) {
        float* p[4]; float rs[4]; f32x4 v[4][4];
#pragma unroll
        for (int r = 0; r < 4; ++r) { const int i = i0 + r; const int row = i < NB * SEQ ? (i >> 11) * SEQP + NMETA + (i & 2047) : R_SAMP + (i - NB * SEQ);
            p[r] = i < NB * SEQ ? F.out + (size_t)i * D : F.out + OFF_YS + (size_t)(i - NB * SEQ) * D; rs[r] = ld_agent(SS3 + (size_t)row * SST);
#pragma unroll
            for (int j = 0; j < 4; ++j) v[r][j] = *(const f32x4*)(p[r] + 4 * F.lane + 256 * j); }
#pragma unroll
        for (int r = 0; r < 4; ++r) { const float rstd = __builtin_amdgcn_rsqf(rs[r] * (1.0f / D) + EPS);
#pragma unroll
            for (int j = 0; j < 4; ++j) *(f32x4*)(p[r] + 4 * F.lane + 256 * j) = v[r][j] * rstd * gg[j]; } }
}
#ifndef PROBE_DUP
#define PROBE_DUP 0x0f
#endif
#define PD(k) (((PROBE_DUP & 0x0f) == (k)) || ((PROBE_DUP & 0x1000) && (k) != 8))
#ifndef MK_N_LAUNCHES
#define MK_N_LAUNCHES 1
#endif
constexpr int N_LAUNCHES = MK_N_LAUNCHES;
constexpr int PER_PHASE = 9;
struct Args { const float* in[28]; float* out; unsigned char* ws; int ph_lo, ph_hi, li, pad; };
__global__ void __launch_bounds__(NWAVES * 64, 2) hymba_fwd(Args args) {
    extern __shared__ __attribute__((aligned(16))) unsigned char lds[];
    Frame F;
    F.lds = (LAS unsigned char*)lds;
    F.MISC = (volatile LAS unsigned*)(F.lds + MISC_OFF);
    F.tid = threadIdx.x; F.lane = F.tid & 63; F.wave = __builtin_amdgcn_readfirstlane(F.tid >> 6);
    F.G = gridDim.x; { const int bx = blockIdx.x; F.vcu = (F.G % 8 == 0) ? (bx % 8) * (F.G / 8) + bx / 8 : bx; }
    F.ws = args.ws; F.out = args.out; F.ctl = (gu32*)(args.ws + WS_CTL);
    F.x_prompt = args.in[0]; F.x_sample = args.in[1]; F.st_s5r = args.in[2]; F.st_s5i = args.in[3]; F.st_hg = args.in[4]; F.st_cv = args.in[5]; F.meta = args.in[6];
    F.g_mix = args.in[7]; F.w_in = args.in[8]; F.lam_re = args.in[9]; F.lam_im = args.in[10]; F.log_dt = args.in[11]; F.b_re = args.in[12]; F.b_im = args.in[13];
    F.c_re = args.in[14]; F.c_im = args.in[15]; F.s5_d = args.in[16]; F.w_glu = args.in[17]; F.b_glu = args.in[18]; F.hg_lb = args.in[19]; F.hg_ng = args.in[20];
    F.w_out = args.in[21]; F.g_ffn = args.in[22]; F.w_up = args.in[23]; F.conv_w = args.in[24]; F.conv_b = args.in[25]; F.w_down = args.in[26]; F.g_final = args.in[27];
    for (int u = F.tid; u < 64; u += NWAVES * 64) ((LAS unsigned*)(F.lds + MISC_OFF))[u] = 0u;
    __syncthreads();
    XcdBarrier bar; bar.bar = (unsigned*)(F.ctl + CW_BAR); bar.x = 0; bar.st = nullptr;
    if (N_LAUNCHES != PER_PHASE) bar = xcd_barrier_post((unsigned*)(F.ctl + CW_BAR), F.MISC + 8);
#define GRID_BAR() do { if (N_LAUNCHES != PER_PHASE) xcd_barrier(bar); } while (0)
#define GRID_BAR2() xcd_barrier(bar)
    static_assert(N_LAUNCHES == 1, "this build keeps a grid barrier inside phase 2: one launch only");
    const int lo = args.ph_lo, hi = args.ph_hi;
#ifndef P2_MASK
#define P2_MASK 15
#endif
#ifndef PH_MASK
#define PH_MASK 0x1ff
#endif
#define IN(k) (((PH_MASK >> (k)) & 1) && lo <= (k) && (k) < hi)
#define BOTH(k) (IN(k) && IN((k) + 1))
    const int gw = F.vcu * NWAVES + F.wave, NGW = F.G * NWAVES;
    bf16* XN = (bf16*)(F.ws + WS_XN);

#if PD(0)
    if (IN(0)) { p0_prologue(F); __syncthreads(); }
#endif
    if (IN(0)) { p0_prologue(F); if (BOTH(0)) GRID_BAR(); }
    if (IN(1)) {
        pg8::Gemm g{XN, (const bf16*)(F.ws + WS_WIN), RT, INC, D, D, 256}; pg8::StaticOrder S; S.init(RT, INC, F.G, (int)blockIdx.x);
        EpiIn E{(bf16*)(F.ws + WS_U), (bf16*)(F.ws + WS_Q), (bf16*)(F.ws + WS_V), (bf16*)(F.ws + WS_G), (float*)(F.ws + WS_LF), (const float*)(F.ws + WS_S5F + S5F_LB)};
#if PD(1)
        pg8::gemm_phase<EpiIn, true>(F.lds + RING_OFF, g, S, E);
#endif
        pg8::gemm_phase<EpiIn, true>(F.lds + RING_OFF, g, S, E);
        if (BOTH(1)) GRID_BAR();
    }
#if PD(2)
    if (IN(2)) {
        if (PROBE_DUP & 0x1010) for (int it = F.vcu; it < NB * 32; it += F.G) s5_prompt_item(F, it);
        if (PROBE_DUP & 0x1020) hgrn_pre_items(F);
        if (PROBE_DUP & 0x1040) for (int it = gw; it < NS * 32; it += NGW) s5_sample_item(F, it);
        if (PROBE_DUP & 0x1080) for (int it = F.vcu; it < NS * 4; it += F.G) hgrn_sample_item(F, it, false);
    }
#endif
    if (IN(2)) {
        for (int it = F.vcu; it < NB * 32; it += F.G) s5_prompt_item(F, it);
        hgrn_pre_items(F);
        for (int it = gw; it < NS * 32; it += NGW) s5_sample_item(F, it);
        for (int it = F.vcu; it < NS * 4; it += F.G) hgrn_sample_item(F, it);
        GRID_BAR2();
#if PD(2)
        if (PROBE_DUP & 0x1100) for (int it = F.vcu; it < NB * 4 * 8; it += F.G) hgrn_seq_item(F, it, false);
#endif
        for (int it = F.vcu; it < NB * 4 * 8; it += F.G) hgrn_seq_item(F, it);
        if (BOTH(2)) GRID_BAR();
    }
    if (IN(3)) {
        hgrn_finalize(F);
        pg8::Gemm g{(const bf16*)(F.ws + WS_Y5), (const bf16*)(F.ws + WS_WGLU), RT, HD, HD, HD, 256}; pg8::StaticOrder S; S.init(RT, HD, F.G, (int)blockIdx.x);
        EpiGlu E{(const bf16*)(F.ws + WS_Y5), F.b_glu, (bf16*)(F.ws + WS_MIX)};
#if PD(3)
        hgrn_finalize(F);
        pg8::gemm_phase<EpiGlu, true>(F.lds + RING_OFF, g, S, E);
#endif
        pg8::gemm_phase<EpiGlu, true>(F.lds + RING_OFF, g, S, E);
        if (BOTH(3)) GRID_BAR();
    }
    if (IN(4)) {
        pg8::Gemm g{(const bf16*)(F.ws + WS_MIX), (const bf16*)(F.ws + WS_WOUT), TAIL_ROW0, D, D, D, 256}; pg8::StaticOrder S; S.init(TAIL_ROW0, D, F.G, (int)blockIdx.x);
        EpiOut E{F.x_prompt, F.meta, F.x_sample, XN, (float*)(F.ws + WS_SS2)};
#if PD(4)
        { EpiOut E2 = E; E2.ss = nullptr; pg8::gemm_phase<EpiOut, true>(F.lds + RING_OFF, g, S, E2); }
#endif
        pg8::gemm_phase<EpiOut, true>(F.lds + RING_OFF, g, S, E);
        { TailOut T{F.x_prompt, F.meta, F.x_sample, XN, (float*)(F.ws + WS_SS2)};
#if PD(6)
          { TailOut T2 = T; T2.ss = nullptr; tail_gemm(F, (const bf16*)(F.ws + WS_MIX), D, (const bf16*)(F.ws + WS_WOUT), D, T2); }
#endif
          tail_gemm(F, (const bf16*)(F.ws + WS_MIX), D, (const bf16*)(F.ws + WS_WOUT), D, T); }
        if (BOTH(4)) GRID_BAR();
    }
    if (IN(5)) {
        pg8::Gemm g{XN - 2 * D, (const bf16*)(F.ws + WS_WUP), 66 * 256, UPC, D, D, 254}; pg8::StaticOrder S; S.init(66 * 256, UPC, F.G, (int)blockIdx.x);
        EpiUpGate E{(const float*)(F.ws + WS_SS2), (bf16*)(F.ws + WS_GATED), F.out, F.conv_w, F.conv_b, F.st_cv, (LAS float*)(F.lds + XCH_OFF)};
        pg8::gemm_phase<EpiUpGate, true>(F.lds + RING_OFF, g, S, E);
        if (BOTH(5)) GRID_BAR();
    }
    if (IN(6)) { }
    if (IN(7)) {
        pg8::Gemm g{(const bf16*)(F.ws + WS_GATED), (const bf16*)(F.ws + WS_WDN), TAIL_ROW0, D, DFF, DFF, 256}; pg8::StaticOrder S; S.init(TAIL_ROW0, D, F.G, (int)blockIdx.x);
        EpiDown E{XN, F.out, (float*)(F.ws + WS_SS3), nullptr};
#if PD(7)
        { EpiDown E2 = E; E2.dry = (float*)(F.ws + WS_XN); pg8::gemm_phase<EpiDown, true>(F.lds + RING_OFF, g, S, E2); }
#endif
#if PD(8)
        for (int i = 0; i < 8; ++i) GRID_BAR();
#endif
        pg8::gemm_phase<EpiDown, true>(F.lds + RING_OFF, g, S, E);
        { TailDown T{XN, F.out, (float*)(F.ws + WS_SS3)}; tail_gemm(F, (const bf16*)(F.ws + WS_GATED), DFF, (const bf16*)(F.ws + WS_WDN), DFF, T); }
        if (BOTH(7)) GRID_BAR();
    }
    if (IN(8)) final_norm(F);
#undef IN
#undef BOTH
#undef GRID_BAR
}

extern "C" void kernel_launch(void* const* d_in, const int* in_sizes, int n_in, void* d_out, int out_size, void* d_ws, size_t ws_size, hipStream_t stream) {
    static int grid = 0;
    if (grid == 0) {
        if (n_in != 28 || out_size != (int)OUT_TOTAL || ws_size < WS_END) { fprintf(stderr, "kernel_launch: unexpected problem (n_in %d, out %d, ws %zu); nothing launched\n", n_in, out_size, ws_size); grid = -1; return; }
        int dev = 0, cus = 0, per_cu = 0;
        if (hipGetDevice(&dev) != hipSuccess || hipDeviceGetAttribute(&cus, hipDeviceAttributeMultiprocessorCount, dev) != hipSuccess) { fprintf(stderr, "kernel_launch: device query failed\n"); grid = -1; return; }
        if (hipFuncSetAttribute((const void*)hymba_fwd, hipFuncAttributeMaxDynamicSharedMemorySize, LDS_BYTES) != hipSuccess) { fprintf(stderr, "kernel_launch: hipFuncSetAttribute failed\n"); grid = -1; return; }
        if (hipOccupancyMaxActiveBlocksPerMultiprocessor(&per_cu, (const void*)hymba_fwd, NWAVES * 64, LDS_BYTES) != hipSuccess || per_cu < 1)
            fprintf(stderr, "kernel_launch: note: occupancy query reports %d workgroups per CU\n", per_cu);
        (void)hipGetLastError();
        grid = cus;
    }
    if (grid < 0) return;
    if (hipMemsetAsync((char*)d_ws + WS_CTL, 0, CTL_ZERO_BYTES, stream) != hipSuccess) { fprintf(stderr, "kernel_launch: hipMemsetAsync failed\n"); return; }
    Args a{};
    for (int i = 0; i < 28; ++i) a.in[i] = (const float*)d_in[i];
    a.out = (float*)d_out; a.ws = (unsigned char*)d_ws; a.pad = 0;
    for (int li = 0; li < N_LAUNCHES * (PD(10) ? 2 : 1); ++li) {
        if (li > 0 && PD(10)) (void)hipMemsetAsync((char*)d_ws + WS_CTL, 0, CTL_ZERO_BYTES, stream);
        a.ph_lo = (N_LAUNCHES == PER_PHASE) ? li : 0; a.ph_hi = (N_LAUNCHES == PER_PHASE) ? li + 1 : PER_PHASE; a.li = li;
        hipLaunchKernelGGL(hymba_fwd, dim3(grid), dim3(NWAVES * 64), LDS_BYTES, stream, a);
        const hipError_t le = hipPeekAtLastError();
        if (le != hipSuccess) { fprintf(stderr, "kernel_launch: launch %d failed: %s\n", li, hipGetErrorName(le)); break; }
    }
}
```

```cpp
#include <hip/hip_runtime.h>
#include <cstdio>
#include <cstdint>
#define MK_N_LAUNCHES 1
namespace pg8 {
#define PG8_LAS __attribute__((address_space(3)))
typedef unsigned short bf16_t;
typedef short bf16x8 __attribute__((ext_vector_type(8)));
typedef float f32x4 __attribute__((ext_vector_type(4)));
typedef unsigned u32x4 __attribute__((ext_vector_type(4)));
typedef unsigned u32x2 __attribute__((ext_vector_type(2)));
constexpr int BM = 256, BK = 64, HALF = 128, HTB = HALF * BK * 2  , STAGE_BYTES = 8 * HTB, NXCD = 8, WGM = 8;

__host__ __device__ __forceinline__ int lds_byte(int r, int c) { const int st = (r >> 4) * 2 + (c >> 5), rr = r & 15, cc = c & 31, ob = rr * 64 + cc * 2; return st * 1024 + (ob ^ (((ob >> 9) & 1) << 5)); }
__host__ __device__ __forceinline__ void stage_rc(int b, int& R, int& C) { const int st = b / 1024, sb = b % 1024, swz = sb ^ (((sb >> 9) & 1) << 5); R = (st >> 1) * 16 + swz / 64; C = (st & 1) * 32 + (swz % 64) / 2; }
__host__ __device__ __forceinline__ int perm32(int rho) { const int n = rho >> 4, i = rho & 15; return 8 * (i >> 2) + 4 * n + (i & 3); }

struct Unit { int pm, pn; };
struct Gemm { const bf16_t* A; const bf16_t* Bt; int M, N, K, lda, a_tile_rows; };

struct StaticOrder {
    int nM, nN, nwg, G, c;
    __host__ __device__ void init(int M, int N, int G_, int c_) { nM = M / BM; nN = N / BM; nwg = nM * nN; G = G_; c = c_; }
    __host__ __device__ bool next(int i, Unit& u) const {
        const long L = (long)i * G + c; if (L >= nwg) return false;
        int wgid = (int)L; { const int q = nwg / NXCD, r = nwg % NXCD, xcd = wgid % NXCD, off = wgid / NXCD; wgid = (xcd < r ? xcd * (q + 1) : r * (q + 1) + (xcd - r) * q) + off; }
        const int nig = WGM * nN, gid = wgid / nig, fm = gid * WGM, gsz = (nM - fm) < WGM ? (nM - fm) : WGM;
        u.pm = fm + ((wgid % nig) % gsz); u.pn = (wgid % nig) / gsz; return true;
    }
};

__device__ __forceinline__ unsigned cvt_pk_bf16(float lo, float hi) { unsigned r; asm volatile("v_cvt_pk_bf16_f32 %0, %1, %2" : "=v"(r) : "v"(lo), "v"(hi)); return r; }

template <class Epi, bool ALIGN_EPI, int EPI_REP = 1>
__device__ __forceinline__ void gemm_phase(PG8_LAS unsigned char* lds, const Gemm g, const StaticOrder& S, const Epi& E) {
    int tid = threadIdx.x; asm volatile("" : "+v"(tid));
    const int wid = __builtin_amdgcn_readfirstlane(tid >> 6), lane = tid & 63, wr = wid >> 2, wc = wid & 3, fr = lane & 15, fq = lane >> 4;
    const int K = g.K, nt = K / BK, lda = g.lda;
    unsigned voffA[2], voffB[2];
#pragma unroll
    for (int i = 0; i < 2; ++i) { int R, C; stage_rc(tid * 16 + i * 8192, R, C); const int Rb = (R & ~31) + perm32(R & 31);
        voffA[i] = (unsigned)(R * lda + C) * 2u; voffB[i] = (unsigned)(Rb * K + C) * 2u; }
    const size_t kstep = (size_t)(BK * 2);
    const size_t hstepA = (size_t)HALF * lda * 2, hstepB = (size_t)HALF * K * 2;
    const size_t tstepA = (size_t)g.a_tile_rows * lda * 2, tstepB = 2 * hstepB;
    const unsigned ldsw = (unsigned)wid * 1024u;
    const int aoff = lds_byte(wr * 64 + fr, fq * 8), boff = lds_byte(wc * 32 + fr, fq * 8);
#define PG8_SA(b, h) (((b) * 2 + (h)) * HTB)
#define PG8_SB(b, h) ((4 + (b) * 2 + (h)) * HTB)
#define PG8_STAGE(bufoff, gbase, voff) do { _Pragma("unroll") for (int _i = 0; _i < 2; ++_i) \
        __builtin_amdgcn_global_load_lds((const unsigned*)((const char*)(gbase) + (voff)[_i]), (PG8_LAS unsigned*)(lds + (bufoff) + ldsw + _i * 8192), 16, 0, 0); } while (0)
#define PG8_LDA(dst, b, h) do { _Pragma("unroll") for (int m = 0; m < 4; ++m) _Pragma("unroll") for (int k = 0; k < 2; ++k) dst[m][k] = *(const PG8_LAS bf16x8*)(lds + PG8_SA(b, h) + aoff + m * 2048 + k * 1024); } while (0)
#define PG8_LDB(dst, b, h) do { _Pragma("unroll") for (int n = 0; n < 2; ++n) _Pragma("unroll") for (int k = 0; k < 2; ++k) dst[n][k] = *(const PG8_LAS bf16x8*)(lds + PG8_SB(b, h) + boff + n * 2048 + k * 1024); } while (0)
#define PG8_MMA(ai, bj, At, Bt) do { __builtin_amdgcn_s_setprio(1); _Pragma("unroll") for (int m = 0; m < 4; ++m) _Pragma("unroll") for (int n = 0; n < 2; ++n) _Pragma("unroll") for (int k = 0; k < 2; ++k) \
        acc[ai][bj][m][n] = __builtin_amdgcn_mfma_f32_16x16x32_bf16(Bt[n][k], At[m][k], acc[ai][bj][m][n], 0, 0, 0); __builtin_amdgcn_s_setprio(0); } while (0)
#define PG8_WAIT_V(n) asm volatile("s_waitcnt vmcnt(" #n ")" ::: "memory")
#define PG8_WAIT_L(n) asm volatile("s_waitcnt lgkmcnt(" #n ")" ::: "memory")
#define PG8_BAR __builtin_amdgcn_s_barrier()
#define PG8_SCHED __builtin_amdgcn_sched_barrier(0)
    Unit cur, nxt; int ui = 0;
    if (!S.next(0, cur)) return;
    f32x4 acc[2][2][4][2];
#pragma unroll
    for (int a = 0; a < 2; ++a)
#pragma unroll
        for (int b = 0; b < 2; ++b)
#pragma unroll
            for (int m = 0; m < 4; ++m)
#pragma unroll
                for (int n = 0; n < 2; ++n) acc[a][b][m][n] = (f32x4){0.f, 0.f, 0.f, 0.f};
    bf16x8 At[4][2], B0[2][2], B1[2][2];
    const char* cA = (const char*)g.A + (size_t)cur.pm * tstepA; const char* cB = (const char*)g.Bt + (size_t)cur.pn * tstepB;
    PG8_STAGE(PG8_SB(0, 0), cB, voffB); PG8_STAGE(PG8_SB(0, 1), cB + hstepB, voffB); PG8_STAGE(PG8_SA(0, 0), cA, voffA); PG8_STAGE(PG8_SA(0, 1), cA + hstepA, voffA);
    if (wr == 1) PG8_BAR;
    PG8_WAIT_V(2); PG8_BAR;
    PG8_STAGE(PG8_SB(1, 0), cB + kstep, voffB); PG8_STAGE(PG8_SA(1, 0), cA + kstep, voffA); PG8_STAGE(PG8_SB(1, 1), cB + hstepB + kstep, voffB);
    PG8_WAIT_V(6); PG8_BAR;
    for (;;) {
        const bool has_next = S.next(ui + 1, nxt);
        const char* nA = has_next ? (const char*)g.A + (size_t)nxt.pm * tstepA : cA; const char* nB = has_next ? (const char*)g.Bt + (size_t)nxt.pn * tstepB : cB;
        for (int t = 0; t < nt; t += 2) {
            const bool last = (t == nt - 2);
            const char* a1 = cA + (size_t)(t + 1) * kstep;
            const char* a2 = last ? nA : cA + (size_t)(t + 2) * kstep; const char* b2 = last ? nB : cB + (size_t)(t + 2) * kstep;
            const char* a3 = a2 + kstep; const char* b3 = b2 + kstep;
            PG8_LDB(B0, 0, 0); PG8_LDB(B1, 0, 1); PG8_SCHED; PG8_LDA(At, 0, 0); PG8_STAGE(PG8_SA(1, 1), a1 + hstepA, voffA);
            PG8_WAIT_V(8); PG8_WAIT_L(0); PG8_BAR; PG8_MMA(0, 0, At, B0); PG8_MMA(0, 1, At, B1); PG8_BAR; PG8_SCHED;
            PG8_LDA(At, 0, 1); PG8_STAGE(PG8_SB(0, 0), b2, voffB); PG8_STAGE(PG8_SB(0, 1), b2 + hstepB, voffB); PG8_STAGE(PG8_SA(0, 0), a2, voffA);
            PG8_WAIT_V(8); PG8_WAIT_L(0); PG8_BAR; PG8_MMA(1, 0, At, B0); PG8_MMA(1, 1, At, B1); PG8_BAR; PG8_SCHED;
            PG8_LDB(B0, 1, 0); PG8_LDB(B1, 1, 1); PG8_SCHED; PG8_LDA(At, 1, 0); PG8_STAGE(PG8_SA(0, 1), a2 + hstepA, voffA);
            PG8_WAIT_V(8); PG8_WAIT_L(0); PG8_BAR; PG8_MMA(0, 0, At, B0); PG8_MMA(0, 1, At, B1); PG8_BAR; PG8_SCHED;
            PG8_LDA(At, 1, 1); PG8_STAGE(PG8_SB(1, 0), b3, voffB); PG8_STAGE(PG8_SB(1, 1), b3 + hstepB, voffB); PG8_STAGE(PG8_SA(1, 0), a3, voffA);
            PG8_WAIT_V(8); PG8_WAIT_L(0); PG8_BAR; PG8_MMA(1, 0, At, B0); PG8_MMA(1, 1, At, B1); PG8_BAR; PG8_SCHED;
        }
        if constexpr (ALIGN_EPI) { if (wr == 0) PG8_BAR; }
        E(acc, cur, wr, wc, fr, fq);
        if (!has_next) break;
#pragma unroll
        for (int a = 0; a < 2; ++a)
#pragma unroll
            for (int b = 0; b < 2; ++b)
#pragma unroll
                for (int m = 0; m < 4; ++m)
#pragma unroll
                    for (int n = 0; n < 2; ++n) acc[a][b][m][n] = (f32x4){0.f, 0.f, 0.f, 0.f};
        cur = nxt; cA = nA; cB = nB; ++ui;
        if constexpr (ALIGN_EPI) { if (wr == 1) PG8_BAR; }
    }
    PG8_WAIT_V(0);
    if constexpr (!ALIGN_EPI) { if (wr == 0) PG8_BAR; }
    PG8_BAR;
#undef PG8_SA
#undef PG8_SB
#undef PG8_STAGE
#undef PG8_LDA
#undef PG8_LDB
#undef PG8_MMA
#undef PG8_WAIT_V
#undef PG8_WAIT_L
#undef PG8_BAR
#undef PG8_SCHED
}
}
using pg8::bf16x8;
constexpr int NWAVES = 8;
constexpr int D = 1024, NB = 8, SEQ = 2048, NMETA = 16, NS = 128;
constexpr int RT = 16640;
constexpr int SEQP = 2064, R_SAMP = 16512;
__device__ __forceinline__ int seq_of(int r) { return (int)__umulhi((unsigned)r, 2080903u); }
constexpr int HD = 512;
constexpr int INC = 2560, DFF = 2816, UPC = 5632;
constexpr float EPS = 1e-6f;
constexpr size_t OFF_YP = 0, OFF_YS = 16777216, OFF_S5RP = 16908288, OFF_S5IP = 16924672, OFF_HGP = 16941056, OFF_CVP = 17465344,
                 OFF_S5RS = 17510400, OFF_S5IS = 17772544, OFF_HGS = 18034688, OFF_CVS = 26423296, OUT_TOTAL = 27144192;
constexpr size_t KiB = 1024, MiB = 1u << 20;
constexpr size_t WS_CTL = 0, CTL_ZERO_BYTES = 64 * KiB;
constexpr int CW_BAR = 4096;
constexpr int SST = 16;
constexpr size_t WS_SS2 = 249 * MiB, WS_SS3 = 250 * MiB + 512 * KiB, WS_HSS = 252 * MiB, STAT_BYTES = (size_t)RT * SST * 4;
constexpr size_t WS_WIN = 2 * MiB, WS_WGLU = 7 * MiB, WS_WOUT = 7 * MiB + 512 * KiB, WS_WUP = 9 * MiB + 512 * KiB, WS_WDN = 20 * MiB + 512 * KiB;
constexpr size_t WS_S5W1 = 26 * MiB, WS_S5W2 = 32 * MiB, WS_S5F = 34 * MiB;
constexpr size_t S5F_A1 = 0, S5F_A16 = 16 * KiB, S5F_BB = 64 * KiB, S5F_LB = 384 * KiB;
constexpr size_t WS_H1META = 35 * MiB;
constexpr size_t WS_XN = 36 * MiB;
constexpr size_t ROWS512_BF16 = (size_t)RT * 512 * 2;
constexpr size_t WS_U = 68 * MiB + 512 * KiB, WS_Q = WS_U + ROWS512_BF16, WS_V = WS_Q + ROWS512_BF16, WS_G = WS_V + ROWS512_BF16, WS_LF = WS_G + ROWS512_BF16,
                 WS_Y5 = WS_LF + 2 * ROWS512_BF16, WS_OH = WS_Y5 + ROWS512_BF16, WS_MIX = WS_OH + ROWS512_BF16, WS_ZEND = WS_MIX + 2 * ROWS512_BF16;
constexpr size_t WS_GATED = WS_U;
constexpr size_t WS_END = 256 * MiB;
static_assert(WS_ZEND <= WS_END && WS_GATED + (size_t)RT * DFF * 2 <= WS_MIX && WS_XN + (size_t)RT * D * 2 <= WS_U, "d_ws map");
static_assert((CW_BAR + 3456) * 4 <= (int)CTL_ZERO_BYTES && WS_SS2 + STAT_BYTES <= WS_SS3 && WS_SS3 + STAT_BYTES <= WS_HSS && WS_HSS + STAT_BYTES <= WS_END, "ctl / stat map");

constexpr int LDS_BYTES = 163840;
constexpr int RING_OFF = 0, XCH_OFF = 131072, MISC_OFF = 163840 - 256;

#define GAS __attribute__((address_space(1)))
#define LAS __attribute__((address_space(3)))
typedef unsigned short bf16;
typedef unsigned v4u __attribute__((ext_vector_type(4)));
typedef unsigned v2u __attribute__((ext_vector_type(2)));
typedef float f32x4 __attribute__((ext_vector_type(4)));
typedef short bf16x8 __attribute__((ext_vector_type(8)));
typedef GAS unsigned gu32;
#define RLX_AGENT __ATOMIC_RELAXED, __HIP_MEMORY_SCOPE_AGENT
#define LDS_WAIT() asm volatile("s_waitcnt lgkmcnt(0)" ::: "memory")
#define VM_WAIT() asm volatile("s_waitcnt vmcnt(0)" ::: "memory")
__device__ __forceinline__ unsigned f2bf(float f) { unsigned u = __builtin_bit_cast(unsigned, f); return (u + 0x7fffu + ((u >> 16) & 1u)) >> 16; }
typedef float f32x2_t __attribute__((ext_vector_type(2)));
typedef __bf16 bf16x2_t __attribute__((ext_vector_type(2)));
__device__ __forceinline__ unsigned pk2(float lo, float hi) { const f32x2_t v = {lo, hi}; const bf16x2_t b = __builtin_convertvector(v, bf16x2_t); return __builtin_bit_cast(unsigned, b); }
__device__ __forceinline__ float bf2f(unsigned short b) { return __builtin_bit_cast(float, (unsigned)b << 16); }
__device__ __forceinline__ float bflo(unsigned w) { return __builtin_bit_cast(float, w << 16); }
__device__ __forceinline__ float bfhi(unsigned w) { return __builtin_bit_cast(float, w & 0xffff0000u); }
__device__ __forceinline__ float sigmoidf_(float x) { return __builtin_amdgcn_rcpf(1.0f + __expf(-x)); }
__device__ __forceinline__ float siluf_(float x) { return x * sigmoidf_(x); }
__device__ __forceinline__ float gelu_tanh(float y) { const float uu = 1.5957691216057308f * (y + 0.044715f * y * y * y); return y * sigmoidf_(uu); }
__device__ __forceinline__ float ld_agent(const float* p) { return __builtin_bit_cast(float, __hip_atomic_load((const unsigned*)p, RLX_AGENT)); }
__device__ __forceinline__ void atomic_addf(float* p, float v) { (void)__hip_atomic_fetch_add(p, v, RLX_AGENT); }
__device__ __forceinline__ f32x4 mfma16(bf16x8 a, bf16x8 b, f32x4 c) { return __builtin_amdgcn_mfma_f32_16x16x32_bf16(a, b, c, 0, 0, 0); }
__device__ __forceinline__ float wave_sum(float v) {
#pragma unroll
    for (int o = 1; o < 64; o <<= 1) v += __shfl_xor(v, o);
    return v;
}

#define XB_TMO      128
#define XB_XCNT(j)  (256  + 64 * (j))
#define XB_XSUB(j)  (1280 + 64 * (j))
#define XB_XGEN(j)  (2304 + 64 * (j))
#define XB_TOP      3328
#define XB_TOPGEN   3392
#define XCD_BAR_WORDS 3456
#define XB_SPIN_CAP (1u << 18)
__device__ __forceinline__ unsigned xb_ld(unsigned* p)              { return __hip_atomic_load(p, __ATOMIC_RELAXED, __HIP_MEMORY_SCOPE_AGENT); }
__device__ __forceinline__ unsigned xb_add(unsigned* p, unsigned v) { return __hip_atomic_fetch_add(p, v, __ATOMIC_RELAXED, __HIP_MEMORY_SCOPE_AGENT); }
__device__ __forceinline__ unsigned xb_xcc_id() { return (unsigned)__builtin_amdgcn_s_getreg((3 << 11) | 20) & 0xFu; }
#define XB_SPIN(cond, bar) do { unsigned _sp = 0; while (cond) { __builtin_amdgcn_s_sleep(1); \
    if ((++_sp & 255u) == 0u) { if (xb_ld(&(bar)[XB_TMO])) break; if (_sp > XB_SPIN_CAP) { atomicAdd(&(bar)[XB_TMO], 1u); break; } } } } while (0)
struct XcdBarrier { unsigned* bar; unsigned x; volatile LAS unsigned* st; };
__device__ __forceinline__ XcdBarrier xcd_barrier_post(unsigned* bar, volatile LAS unsigned* st) {
    XcdBarrier b; b.bar = bar; b.x = xb_xcc_id(); b.st = st;
    if (threadIdx.x == 0) (void)xb_add(&bar[XB_XCNT(b.x)], 1u);
    return b;
}
__device__ __forceinline__ void xcd_barrier_complete(unsigned* bar, unsigned x, unsigned& nloc, unsigned& nx) {
    const unsigned G = gridDim.x * gridDim.y * gridDim.z;
    unsigned sum, cnt, mine, sp = 0u;
    for (;;) {
        sum = 0u; cnt = 0u; mine = 0u;
#pragma unroll
        for (unsigned j = 0; j < 16; ++j) { const unsigned c = xb_ld(&bar[XB_XCNT(j)]); sum += c; cnt += (c > 0u) ? 1u : 0u; mine = (j == x) ? c : mine; }
        if (sum == G) break;
        __builtin_amdgcn_s_sleep(1);
        if ((++sp & 255u) == 0u) { if (xb_ld(&bar[XB_TMO])) break; if (sp > XB_SPIN_CAP) { atomicAdd(&bar[XB_TMO], 1u); break; } }
    }
    nloc = mine > 0u ? mine : 1u; nx = cnt > 0u ? cnt : 1u;
}
__device__ __forceinline__ void xcd_barrier(const XcdBarrier& b) {
    asm volatile("s_waitcnt vmcnt(0)" ::: "memory");
    __syncthreads();
    if (threadIdx.x == 0) {
        unsigned* bar = b.bar;
        __builtin_amdgcn_s_waitcnt(0);
        unsigned nloc = b.st[0], nx = b.st[1];
        if (nloc == 0u) { xcd_barrier_complete(bar, b.x, nloc, nx); b.st[0] = nloc; b.st[1] = nx; }
        const unsigned old = xb_add(&bar[XB_XSUB(b.x)], 1u);
        const unsigned gen = old / nloc;
        if (old + 1u == (gen + 1u) * nloc) {
            __builtin_amdgcn_fence(__ATOMIC_RELEASE, "agent");
            asm volatile("s_waitcnt vmcnt(0)" ::: "memory");
            const unsigned og = xb_add(&bar[XB_TOP], 1u);
            const unsigned tg = og / nx;
            if (og + 1u == (tg + 1u) * nx) xb_add(&bar[XB_TOPGEN], 1u);
            else XB_SPIN(xb_ld(&bar[XB_TOPGEN]) == tg, bar);
            __builtin_amdgcn_fence(__ATOMIC_ACQUIRE, "agent");
            xb_add(&bar[XB_XGEN(b.x)], 1u);
            asm volatile("s_waitcnt vmcnt(0)" ::: "memory");
        } else {
            XB_SPIN(xb_ld(&bar[XB_XGEN(b.x)]) == gen, bar);
            __builtin_amdgcn_fence(__ATOMIC_ACQUIRE, "agent");
            asm volatile("s_waitcnt vmcnt(0)" ::: "memory");
        }
    }
    __syncthreads();
}

struct Frame {
    LAS unsigned char* lds;
    volatile LAS unsigned* MISC;
    gu32* ctl;
    int tid, lane, wave;
    int vcu, G;
    unsigned char* ws; float* out;
    const float *x_prompt, *x_sample, *st_s5r, *st_s5i, *st_hg, *st_cv, *meta, *g_mix, *w_in, *lam_re, *lam_im, *log_dt, *b_re, *b_im, *c_re, *c_im, *s5_d,
                *w_glu, *b_glu, *hg_lb, *hg_ng, *w_out, *g_ffn, *w_up, *conv_w, *conv_b, *w_down, *g_final;
};
#define EPI_ARGS const f32x4 (&acc)[2][2][4][2], const pg8::Unit& u, int wr, int wc, int fr, int fq

__device__ __forceinline__ const float* h0_src(int row, const float* xp, const float* meta, const float* xs) {
    if (row >= R_SAMP) return xs + (size_t)(row - R_SAMP) * D;
    const int n = seq_of(row), s = row - n * SEQP;
    return s < NMETA ? meta + (size_t)s * D : xp + (size_t)(n * SEQ + s - NMETA) * D;
}
__device__ __forceinline__ float* h1_dst(int row, float* out, float* h1meta) {
    if (row >= R_SAMP) return out + OFF_YS + (size_t)(row - R_SAMP) * D;
    const int n = seq_of(row), s = row - n * SEQP;
    return s < NMETA ? h1meta + (size_t)(n * NMETA + s) * D : out + (size_t)(n * SEQ + s - NMETA) * D;
}
struct EpiIn {
    bf16 *U, *Q, *V, *G; float* LF; const float* lb;
    __device__ __forceinline__ void operator()(EPI_ARGS) const {
        const int seg = u.pn >> 1, cb = (u.pn & 1) * 256 + wc * 32 + 8 * fq, row0 = u.pm * 256 + wr * 64 + fr;
        bf16* dstb = seg == 0 ? U : (seg == 1 ? Q : (seg == 3 ? V : G));
#pragma unroll
        for (int ai = 0; ai < 2; ++ai)
#pragma unroll
            for (int m = 0; m < 4; ++m) { const size_t row = (size_t)(row0 + ai * 128 + m * 16);
#pragma unroll
                for (int bj = 0; bj < 2; ++bj) { const int col = cb + bj * 128; f32x4 v0 = acc[ai][bj][m][0], v1 = acc[ai][bj][m][1];
                    if (seg == 2) {
                        const f32x4 l0 = *(const f32x4*)(lb + col), l1 = *(const f32x4*)(lb + col + 4); f32x4 o0, o1;
#pragma unroll
                        for (int j = 0; j < 4; ++j) { o0[j] = __logf(l0[j] + (1.f - l0[j]) * sigmoidf_(v0[j])); o1[j] = __logf(l1[j] + (1.f - l1[j]) * sigmoidf_(v1[j])); }
                        *(f32x4*)(LF + row * HD + col) = o0; *(f32x4*)(LF + row * HD + col + 4) = o1;
                    } else {
                        if (seg == 4) {
#pragma unroll
                            for (int j = 0; j < 4; ++j) { v0[j] = siluf_(v0[j]); v1[j] = siluf_(v1[j]); } }
                        v4u w; w.x = pk2(v0[0], v0[1]); w.y = pk2(v0[2], v0[3]); w.z = pk2(v1[0], v1[1]); w.w = pk2(v1[2], v1[3]);
                        *(v4u*)(dstb + row * HD + col) = w;
                    } } }
    }
};
struct EpiGlu {
    const bf16* Y5; const float* bias; bf16* MIX;
    __device__ __forceinline__ void operator()(EPI_ARGS) const {
        const int col0 = u.pn * 256 + wc * 32 + 8 * fq, row0 = u.pm * 256 + wr * 64 + fr;
#pragma unroll
        for (int ai = 0; ai < 2; ++ai)
#pragma unroll
            for (int m = 0; m < 4; ++m) { const size_t row = (size_t)(row0 + ai * 128 + m * 16);
#pragma unroll
                for (int bj = 0; bj < 2; ++bj) { const int col = col0 + bj * 128; const f32x4 v0 = acc[ai][bj][m][0], v1 = acc[ai][bj][m][1];
                    const f32x4 b0 = *(const f32x4*)(bias + col), b1 = *(const f32x4*)(bias + col + 4);
                    const v4u y = *(const v4u*)(Y5 + row * HD + col);
                    v4u w;
                    w.x = pk2(bflo(y.x) * sigmoidf_(v0[0] + b0[0]), bfhi(y.x) * sigmoidf_(v0[1] + b0[1]));
                    w.y = pk2(bflo(y.y) * sigmoidf_(v0[2] + b0[2]), bfhi(y.y) * sigmoidf_(v0[3] + b0[3]));
                    w.z = pk2(bflo(y.z) * sigmoidf_(v1[0] + b1[0]), bfhi(y.z) * sigmoidf_(v1[1] + b1[1]));
                    w.w = pk2(bflo(y.w) * sigmoidf_(v1[2] + b1[2]), bfhi(y.w) * sigmoidf_(v1[3] + b1[3]));
                    *(v4u*)(MIX + row * D + col) = w; } }
    }
};
struct EpiOut {
    const float *xp, *meta, *xs; bf16* H1B; float* ss;
    __device__ __forceinline__ void operator()(EPI_ARGS) const {
        const int col0 = u.pn * 256 + wc * 32 + 8 * fq, row0 = u.pm * 256 + wr * 64 + fr;
#pragma unroll
        for (int ai = 0; ai < 2; ++ai)
#pragma unroll
            for (int m = 0; m < 4; ++m) { const int row = row0 + ai * 128 + m * 16;
                const float* src = h0_src(row, xp, meta, xs);
                float s = 0.f;
#pragma unroll
                for (int bj = 0; bj < 2; ++bj) { const int col = col0 + bj * 128;
                    const f32x4 h0 = *(const f32x4*)(src + col) + acc[ai][bj][m][0], h1 = *(const f32x4*)(src + col + 4) + acc[ai][bj][m][1];
                    v4u w; w.x = pk2(h0[0], h0[1]); w.y = pk2(h0[2], h0[3]); w.z = pk2(h1[0], h1[1]); w.w = pk2(h1[2], h1[3]);
                    *(v4u*)(H1B + (size_t)row * D + col) = w;
                    s += (h0[0] * h0[0] + h0[1] * h0[1]) + (h0[2] * h0[2] + h0[3] * h0[3]) + (h1[0] * h1[0] + h1[1] * h1[1]) + (h1[2] * h1[2] + h1[3] * h1[3]); }
                s += __shfl_xor(s, 16); s += __shfl_xor(s, 32);
                if (fq == 0 && ss) atomic_addf(ss + (size_t)row * SST, s); }
    }
};
struct EpiUpGate {
    const float* ss; bf16* GATED; float* out; const float *conv_w, *conv_b, *st_cv; LAS float* xch;
    __device__ __forceinline__ void body(EPI_ARGS, const float (&rstd)[2][4], const bool SPECIAL) const {
        const int lane = fq * 16 + fr, cl = wc * 32 + 8 * fq, col = u.pn * 128 + cl;
        const int rbase = u.pm * 254 - 2 + wr * 64 + fr;
        const int src1 = (lane & 48) | ((fr - 1) & 15), src2 = (lane & 48) | ((fr - 2) & 15);
        bf16* gp = GATED + (size_t)rbase * DFF + col;
#pragma unroll
        for (int n = 0; n < 2; ++n) {
            const int cn = col + 4 * n;
            const f32x4 cb = *(const f32x4*)(conv_b + cn), w0 = *(const f32x4*)(conv_w + cn), w1 = *(const f32x4*)(conv_w + DFF + cn), w2 = *(const f32x4*)(conv_w + 2 * DFF + cn);
#pragma unroll
            for (int ai = 0; ai < 2; ++ai) {
                int pb = ai * 2 + wr - 1; pb = pb < 0 ? 0 : pb;
                f32x4 r1p = *(const LAS f32x4*)(xch + (pb * 2 + 1) * 128 + cl + 4 * n), r2p = *(const LAS f32x4*)(xch + (pb * 2 + (fr & 1)) * 128 + cl + 4 * n);
#pragma unroll
                for (int m = 0; m < 4; ++m) {
                    const f32x4 a = acc[ai][0][m][n] * rstd[ai][m], v = acc[ai][1][m][n] * rstd[ai][m];
                    f32x4 c1, c2;
#pragma unroll
                    for (int j = 0; j < 4; ++j) { c1[j] = __shfl(a[j], src1); c2[j] = __shfl(a[j], src2); }
                    f32x4 p1 = fr == 0 ? r1p : c1, p2 = fr < 2 ? r2p : c2;
                    r1p = c1; r2p = c2;
                    bool valid = true;
                    if (ai == 0 && m == 0) valid = (wr * 64 + fr) >= 2;
                    if (SPECIAL) {
                        const int row = rbase + ai * 128 + m * 16; valid = valid && row < RT;
                        if (valid) {
                            float* cv = nullptr;
                            if (row >= R_SAMP) { const int sm = row - R_SAMP; const float* st = st_cv + (size_t)(sm * 2) * DFF + cn;
                                p2 = *(const f32x4*)st; p1 = *(const f32x4*)(st + DFF); *(f32x4*)(out + OFF_CVS + (size_t)(sm * 2) * DFF + cn) = p1;
                                cv = out + OFF_CVS + (size_t)(sm * 2 + 1) * DFF + cn;
                            } else { const int nn = seq_of(row), sq = row - nn * SEQP;
                                if (sq == 0) p1 = (f32x4){0.f, 0.f, 0.f, 0.f};
                                if (sq <= 1) p2 = (f32x4){0.f, 0.f, 0.f, 0.f};
                                if (sq >= SEQP - 2) cv = out + OFF_CVP + (size_t)(nn * 2 + sq - (SEQP - 2)) * DFF + cn; }
                            if (cv) *(f32x4*)cv = a;
                        }
                    }
                    if (valid) {
                        float o[4];
#pragma unroll
                        for (int j = 0; j < 4; ++j) { const float cc = cb[j] + w0[j] * p2[j] + w1[j] * p1[j] + w2[j] * a[j]; o[j] = siluf_(cc) * v[j]; }
                        *(v2u*)(gp + (ai * 128 + m * 16) * DFF + 4 * n) = (v2u){pk2(o[0], o[1]), pk2(o[2], o[3])}; }
                }
            }
        }
    }
    __device__ __forceinline__ void operator()(EPI_ARGS) const {
        const int cl = wc * 32 + 8 * fq;
        const int rbase = u.pm * 254 - 2 + wr * 64 + fr;
        float rstd[2][4];
#pragma unroll
        for (int ai = 0; ai < 2; ++ai)
#pragma unroll
            for (int m = 0; m < 4; ++m) { int row = rbase + ai * 128 + m * 16; row = row < 0 ? 0 : (row >= RT ? RT - 1 : row); rstd[ai][m] = __builtin_amdgcn_rsqf(ld_agent(ss + (size_t)row * SST) * (1.0f / D) + EPS); }
        if (fr >= 14) {
#pragma unroll
            for (int ai = 0; ai < 2; ++ai)
#pragma unroll
                for (int n = 0; n < 2; ++n) *(LAS f32x4*)(xch + ((ai * 2 + wr) * 2 + (fr - 14)) * 128 + cl + 4 * n) = acc[ai][0][3][n] * rstd[ai][3];
        }
        asm volatile("s_waitcnt lgkmcnt(0)" ::: "memory"); __builtin_amdgcn_s_barrier(); asm volatile("" ::: "memory");
        const int r0 = u.pm * 254 - 2, rl = r0 + 255;
        const bool special = r0 < 0 || rl >= R_SAMP || seq_of(r0 < 0 ? 0 : r0) != seq_of(rl) || (rl - seq_of(rl) * SEQP) >= SEQP - 2;
        body(acc, u, wr, wc, fr, fq, rstd, special);
    }
};
__device__ __forceinline__ float* y_dst(int row, float* out) {
    if (row >= R_SAMP) return out + OFF_YS + (size_t)(row - R_SAMP) * D;
    const int n = seq_of(row), s = row - n * SEQP;
    return s < NMETA ? nullptr : out + (size_t)(n * SEQ + s - NMETA) * D;
}
struct EpiDown {
    const bf16* H1B; float* out; float* ss; float* dry;
    __device__ __forceinline__ void operator()(EPI_ARGS) const {
        const int col0 = u.pn * 256 + wc * 32 + 8 * fq, row0 = u.pm * 256 + wr * 64 + fr;
#pragma unroll
        for (int ai = 0; ai < 2; ++ai)
#pragma unroll
            for (int m = 0; m < 4; ++m) { const int row = row0 + ai * 128 + m * 16;
                float* dst = y_dst(row, out);
                float s = 0.f;
#pragma unroll
                for (int bj = 0; bj < 2; ++bj) { const int col = col0 + bj * 128;
                    const v4u hb = *(const v4u*)(H1B + (size_t)row * D + col);
                    const f32x4 h0 = (f32x4){bflo(hb.x), bfhi(hb.x), bflo(hb.y), bfhi(hb.y)} + acc[ai][bj][m][0], h1 = (f32x4){bflo(hb.z), bfhi(hb.z), bflo(hb.w), bfhi(hb.w)} + acc[ai][bj][m][1];
                    float* wp = dry ? dry + (((size_t)row * D + col) & 0x7FFFF8u) : dst + col;
                    if (dst) { *(f32x4*)(wp) = h0; *(f32x4*)(wp + 4) = h1; }
                    s += (h0[0] * h0[0] + h0[1] * h0[1]) + (h0[2] * h0[2] + h0[3] * h0[3]) + (h1[0] * h1[0] + h1[1] * h1[1]) + (h1[2] * h1[2] + h1[3] * h1[3]); }
                s += __shfl_xor(s, 16); s += __shfl_xor(s, 32);
                if (fq == 0 && !dry) atomic_addf(ss + (size_t)row * SST, s); }
    }
};
__device__ __forceinline__ void p0_transpose_item(const float* W, int K, int N, bf16* WT, const float* ksc, LAS float* scr, int item, int lane, bool upmap = false) {
    const int nblk = N / 64, kb = item / nblk, nb = item % nblk, k0 = 64 * kb, n0 = 64 * nb;
    const int d0 = !upmap ? n0 : (n0 < DFF ? 256 * (n0 >> 7) + (n0 & 127) : 256 * ((n0 - DFF) >> 7) + 128 + ((n0 - DFF) & 127));
    const int ks = lane >> 4, n4 = (lane & 15) * 4;
    f32x4 v[16]; float sc[16];
#pragma unroll
    for (int i = 0; i < 16; ++i) { const int kk = 4 * i + ks; v[i] = *(const GAS f32x4*)(W + (size_t)(k0 + kk) * N + n0 + n4); sc[i] = ksc ? ksc[k0 + kk] : 1.0f; }
#pragma unroll
    for (int i = 0; i < 16; ++i) { const int kk = 4 * i + ks; LAS float* d = scr + kk * 65 + n4; d[0] = v[i].x * sc[i]; d[1] = v[i].y * sc[i]; d[2] = v[i].z * sc[i]; d[3] = v[i].w * sc[i]; }
    LDS_WAIT(); asm volatile("" ::: "memory");
    const int c = lane & 7;
#pragma unroll
    for (int j = 0; j < 8; ++j) { const int n = (lane >> 3) + 8 * j; const LAS float* q = scr + (8 * c) * 65 + n;
        v4u o; o.x = pk2(q[0 * 65], q[1 * 65]); o.y = pk2(q[2 * 65], q[3 * 65]); o.z = pk2(q[4 * 65], q[5 * 65]); o.w = pk2(q[6 * 65], q[7 * 65]);
        *(GAS v4u*)(WT + (size_t)(d0 + n) * K + k0 + 8 * c) = o; }
    LDS_WAIT(); asm volatile("" ::: "memory");
}
template <int NR>
__device__ __forceinline__ void rms_rows_to_bf16(int lane, const float* const (&xrow)[NR], bf16* const (&orow)[NR]) {
    f32x4 v[NR][4]; float s[NR];
#pragma unroll
    for (int r = 0; r < NR; ++r) { const GAS f32x4* xr = (const GAS f32x4*)xrow[r] + lane;
#pragma unroll
        for (int j = 0; j < 4; ++j) v[r][j] = xr[64 * j]; }
#pragma unroll
    for (int r = 0; r < NR; ++r) { s[r] = 0.f;
#pragma unroll
        for (int j = 0; j < 4; ++j) s[r] += (v[r][j].x * v[r][j].x + v[r][j].y * v[r][j].y) + (v[r][j].z * v[r][j].z + v[r][j].w * v[r][j].w); }
#pragma unroll
    for (int o = 1; o < 64; o <<= 1) {
#pragma unroll
        for (int r = 0; r < NR; ++r) s[r] += __shfl_xor(s[r], o); }
#pragma unroll
    for (int r = 0; r < NR; ++r) { const float rstd = 1.0f / sqrtf(s[r] * (1.f / D) + EPS);
        GAS unsigned long long* o8 = (GAS unsigned long long*)orow[r] + lane;
#pragma unroll
        for (int j = 0; j < 4; ++j) o8[64 * j] = (unsigned long long)pk2(v[r][j].x * rstd, v[r][j].y * rstd) | ((unsigned long long)pk2(v[r][j].z * rstd, v[r][j].w * rstd) << 32); }
}
__device__ __forceinline__ void s5_precompute_item(Frame& F, int item) {
    const int g = item >> 3, b = item & 7;
    LAS float* Ap = (LAS float*)F.lds;
    LAS float* Bb = Ap + 2176;
    LAS float* Cc = Bb + 2048;
    LAS float* Kt = Cc + 2048;
    const int tid = F.tid;
    float* A1 = (float*)(F.ws + WS_S5F + S5F_A1); float* A16 = (float*)(F.ws + WS_S5F + S5F_A16); float* BBf = (float*)(F.ws + WS_S5F + S5F_BB);
    const float dt = expf(F.log_dt[g]);
    for (int idx = tid; idx < 17 * 64; idx += 512) { const int j = idx >> 6, p = idx & 63; const float lr = F.lam_re[g * 64 + p], li = F.lam_im[g * 64 + p];
        const double TWO_PI = 6.283185307179586476925286766559;
        const float mag = expf(lr * dt * (float)j);
        double rev = ((double)li * (double)dt * (double)j) / TWO_PI; rev -= rint(rev);
        const float ang = (float)(rev * TWO_PI);
        Ap[idx * 2] = mag * cosf(ang); Ap[idx * 2 + 1] = mag * sinf(ang); }
    for (int idx = tid; idx < 1024; idx += 512) { const int co = idx >> 6, p = idx & 63; Cc[idx * 2] = F.c_re[(g * 16 + co) * 64 + p]; Cc[idx * 2 + 1] = F.c_im[(g * 16 + co) * 64 + p]; }
    __syncthreads();
    for (int idx = tid; idx < 1024; idx += 512) { const int p = idx >> 4, c = idx & 15; const float lr = F.lam_re[g * 64 + p], li = F.lam_im[g * 64 + p];
        const float ar = Ap[(64 + p) * 2], ai = Ap[(64 + p) * 2 + 1];
        const float nr = ar - 1.0f, den = lr * lr + li * li, cr = (nr * lr + ai * li) / den, ci = (ai * lr - nr * li) / den;
        const float bre = F.b_re[(g * 64 + p) * 16 + c], bim = F.b_im[(g * 64 + p) * 16 + c];
        const float xr = cr * bre - ci * bim, xi = cr * bim + ci * bre;
        Bb[idx * 2] = xr; Bb[idx * 2 + 1] = xi;
        if (b == 0) { BBf[((g * 64 + p) * 16 + c) * 2] = xr; BBf[((g * 64 + p) * 16 + c) * 2 + 1] = xi;
            if (c == 0) { A1[(g * 64 + p) * 2] = ar; A1[(g * 64 + p) * 2 + 1] = ai; A16[(g * 64 + p) * 2] = Ap[(16 * 64 + p) * 2]; A16[(g * 64 + p) * 2 + 1] = Ap[(16 * 64 + p) * 2 + 1]; } } }
    __syncthreads();
    { const int jl = tid >> 8, co = (tid >> 4) & 15, ci = tid & 15, j = 2 * b + jl; float kv = 0.f;
        for (int p = 0; p < 64; ++p) { const float cr = Cc[(co * 64 + p) * 2], cim = Cc[(co * 64 + p) * 2 + 1], ar = Ap[(j * 64 + p) * 2], ai = Ap[(j * 64 + p) * 2 + 1];
            const float car = cr * ar - cim * ai, cai = cr * ai + cim * ar; kv += car * Bb[(p * 16 + ci) * 2] - cai * Bb[(p * 16 + ci) * 2 + 1]; }
        if (j == 0 && co == ci) kv += F.s5_d[g * 16 + co];
        Kt[tid] = kv; }
    __syncthreads();
    bf16* W1 = (bf16*)(F.ws + WS_S5W1) + (size_t)g * 384 * 256; bf16* W2 = (bf16*)(F.ws + WS_S5W2) + (size_t)g * 256 * 128;
    for (int idx = tid; idx < 2 * 16 * 128; idx += 512) { const int jl = idx >> 11, d = (idx >> 7) & 15, co = (idx >> 3) & 15, cp = idx & 7, j = 2 * b + jl;
        if (d + j < 16) { const int s = d, t = d + j;
            *(unsigned*)(W1 + (size_t)(t * 16 + co) * 256 + s * 16 + 2 * cp) = pk2(Kt[jl * 256 + co * 16 + 2 * cp], Kt[jl * 256 + co * 16 + 2 * cp + 1]);
            if (j >= 1) *(unsigned*)(W1 + (size_t)(s * 16 + co) * 256 + t * 16 + 2 * cp) = 0u; } }
    for (int idx = tid; idx < 16 * 128; idx += 512) { const int pp = 16 * b + (idx >> 7), k = (idx & 127) * 2, s = k >> 4, ci = k & 15, p = pp & 63;
        const float ar = Ap[((15 - s) * 64 + p) * 2], ai = Ap[((15 - s) * 64 + p) * 2 + 1];
        const float b0r = Bb[(p * 16 + ci) * 2], b0i = Bb[(p * 16 + ci) * 2 + 1], b1r = Bb[(p * 16 + ci + 1) * 2], b1i = Bb[(p * 16 + ci + 1) * 2 + 1];
        const float v0 = pp < 64 ? ar * b0r - ai * b0i : ar * b0i + ai * b0r, v1 = pp < 64 ? ar * b1r - ai * b1i : ar * b1i + ai * b1r;
        *(unsigned*)(W1 + (size_t)(256 + pp) * 256 + k) = pk2(v0, v1); }
    for (int idx = tid; idx < 32 * 64; idx += 512) { const int n = 32 * b + (idx >> 6), kq = (idx & 63) * 2, t = n >> 4, co = n & 15; float v[2];
#pragma unroll
        for (int e = 0; e < 2; ++e) { const int pp = kq + e, p = pp & 63; const float cr = Cc[(co * 64 + p) * 2], cim = Cc[(co * 64 + p) * 2 + 1], ar = Ap[((t + 1) * 64 + p) * 2], ai = Ap[((t + 1) * 64 + p) * 2 + 1];
            v[e] = pp < 64 ? (cr * ar - cim * ai) : -(cr * ai + cim * ar); }
        *(unsigned*)(W2 + (size_t)n * 128 + kq) = pk2(v[0], v[1]); }
    __syncthreads();
}
__device__ __forceinline__ void p0_prologue(Frame& F) {
    { v4u* z = (v4u*)(F.ws + WS_SS2); const v4u zero = (v4u){0u, 0u, 0u, 0u};
      for (size_t i = (size_t)F.vcu * 512 + F.tid; i < (WS_HSS + STAT_BYTES - WS_SS2) / 16; i += (size_t)F.G * 512) z[i] = zero; }
    for (int it = F.vcu; it < 256; it += F.G) s5_precompute_item(F, it);
    if (F.vcu == 32 % F.G) {
        float* LB = (float*)(F.ws + WS_S5F + S5F_LB); const float a0 = F.hg_lb[F.tid], a1 = F.hg_lb[512 + F.tid], mx = fmaxf(a0, a1), e0 = expf(a0 - mx), e1 = expf(a1 - mx); LB[F.tid] = e0 / (e0 + e1); }
    LAS float* scr = (LAS float*)(F.lds + RING_OFF + F.wave * 16896);
    const int gw = F.vcu * NWAVES + F.wave, NGW = F.G * NWAVES;
    constexpr int I_IN = (D / 64) * (INC / 64), I_GLU = (HD / 64) * (HD / 64), I_OUT = (D / 64) * (D / 64), I_UP = (D / 64) * (UPC / 64), I_DN = (DFF / 64) * (D / 64);
    constexpr int NITEMS = I_IN + I_GLU + I_OUT + I_UP + I_DN;
    for (int it = gw; it < NITEMS; it += NGW) {
        int r = it;
        if (r < I_IN) { p0_transpose_item(F.w_in, D, INC, (bf16*)(F.ws + WS_WIN), F.g_mix, scr, r, F.lane); continue; } r -= I_IN;
        if (r < I_GLU) { p0_transpose_item(F.w_glu, HD, HD, (bf16*)(F.ws + WS_WGLU), nullptr, scr, r, F.lane); continue; } r -= I_GLU;
        if (r < I_OUT) { p0_transpose_item(F.w_out, D, D, (bf16*)(F.ws + WS_WOUT), nullptr, scr, r, F.lane); continue; } r -= I_OUT;
        if (r < I_UP) { p0_transpose_item(F.w_up, D, UPC, (bf16*)(F.ws + WS_WUP), F.g_ffn, scr, r, F.lane, true); continue; } r -= I_UP;
        p0_transpose_item(F.w_down, DFF, D, (bf16*)(F.ws + WS_WDN), nullptr, scr, r, F.lane);
    }
    bf16* XN = (bf16*)(F.ws + WS_XN);
    for (int m0 = gw * 4; m0 < RT; m0 += NGW * 4) {
        const float* src[4]; bf16* dst[4];
#pragma unroll
        for (int r = 0; r < 4; ++r) { const int m = m0 + r;
            src[r] = h0_src(m, F.x_prompt, F.meta, F.x_sample);
            dst[r] = XN + (size_t)m * D; }
        rms_rows_to_bf16<4>(F.lane, src, dst);
    }
}

__device__ __forceinline__ void s5_prompt_item(Frame& F, int item) {
    const int g = item & 31, n = item >> 5;
    LAS unsigned char* R1 = F.lds;
    LAS float* R2 = (LAS float*)(F.lds + 76032);
    int tid = F.tid; asm volatile("" : "+v"(tid));
    const int lane = tid & 63, w = F.wave, r = lane & 15, q = lane >> 4;
    const bf16* U = (const bf16*)(F.ws + WS_U);
#pragma unroll
    for (int i = 0; i < 9; ++i) { const int idx = tid + 512 * i, c = idx >> 5, pc = idx & 31, s = pc >> 1, half = pc & 1, cc = c < 128 ? c : 128;
        const int grow = SEQP * n + 16 * cc + s;
        const v4u val = *(const v4u*)(U + (size_t)grow * HD + 16 * g + 8 * half);
        *(LAS v4u*)(R1 + c * 528 + pc * 16) = val; }
    __syncthreads();
    const bf16* W1 = (const bf16*)(F.ws + WS_S5W1) + (size_t)g * 384 * 256; const bf16* W2 = (const bf16*)(F.ws + WS_S5W2) + (size_t)g * 256 * 128;
    f32x4 acc0[9], acc1[9], acc2[9];
#pragma unroll
    for (int mt = 0; mt < 9; ++mt) { acc0[mt] = (f32x4){0.f, 0.f, 0.f, 0.f}; acc1[mt] = acc0[mt]; acc2[mt] = acc0[mt]; }
#pragma unroll 1
    for (int kk = 0; kk < 8; ++kk) {
        const bool need0 = (2 * kk <= w);
        const bool need1 = (2 * kk <= w + 8);
        const bf16x8 b2 = *(const bf16x8*)(W1 + (size_t)(16 * (16 + w) + r) * 256 + 32 * kk + 8 * q);
        bf16x8 b0 = b2, b1 = b2;
        if (need0) b0 = *(const bf16x8*)(W1 + (size_t)(16 * w + r) * 256 + 32 * kk + 8 * q);
        if (need1) b1 = *(const bf16x8*)(W1 + (size_t)(16 * (w + 8) + r) * 256 + 32 * kk + 8 * q);
#pragma unroll
        for (int mt = 0; mt < 9; ++mt) { const bf16x8 a = *(const LAS bf16x8*)(R1 + (16 * mt + r) * 528 + (32 * kk + 8 * q) * 2);
            acc2[mt] = mfma16(a, b2, acc2[mt]);
            if (need0) acc0[mt] = mfma16(a, b0, acc0[mt]);
            if (need1) acc1[mt] = mfma16(a, b1, acc1[mt]); }
    }
#pragma unroll
    for (int mt = 0; mt < 9; ++mt)
#pragma unroll
        for (int i = 0; i < 4; ++i) R2[(16 * mt + 4 * q + i) * 132 + 16 * w + r] = acc2[mt][i];
    __syncthreads();
    if (w == 0) {
        const float* A16 = (const float*)(F.ws + WS_S5F + S5F_A16); const float ar = A16[(g * 64 + lane) * 2], ai = A16[(g * 64 + lane) * 2 + 1];
        float hr = 0.f, hi = 0.f;
        for (int c0 = 0; c0 < 136; c0 += 8) {
            float lr[8], li[8];
#pragma unroll
            for (int j = 0; j < 8; ++j) { lr[j] = R2[(c0 + j) * 132 + lane]; li[j] = R2[(c0 + j) * 132 + 64 + lane]; }
#pragma unroll
            for (int j = 0; j < 8; ++j) { const int c = c0 + j;
                if (c <= 128) {
                    *(LAS bf16*)(R1 + c * 272 + lane * 2) = (bf16)f2bf(hr); *(LAS bf16*)(R1 + c * 272 + 128 + lane * 2) = (bf16)f2bf(hi);
                    const float nr = ar * hr - ai * hi + lr[j], ni = ar * hi + ai * hr + li[j]; hr = nr; hi = ni;
                } else { *(LAS bf16*)(R1 + c * 272 + lane * 2) = 0; *(LAS bf16*)(R1 + c * 272 + 128 + lane * 2) = 0; } }
        }
#pragma unroll
        for (int c = 136; c < 144; ++c) { *(LAS bf16*)(R1 + c * 272 + lane * 2) = 0; *(LAS bf16*)(R1 + c * 272 + 128 + lane * 2) = 0; }
        F.out[OFF_S5RP + (size_t)(n * 32 + g) * 64 + lane] = hr; F.out[OFF_S5IP + (size_t)(n * 32 + g) * 64 + lane] = hi;
    }
    __syncthreads();
#pragma unroll 1
    for (int kk = 0; kk < 4; ++kk) {
        const bf16x8 b0 = *(const bf16x8*)(W2 + (size_t)(16 * w + r) * 128 + 32 * kk + 8 * q), b1 = *(const bf16x8*)(W2 + (size_t)(16 * (w + 8) + r) * 128 + 32 * kk + 8 * q);
#pragma unroll
        for (int mt = 0; mt < 9; ++mt) { const bf16x8 a = *(const LAS bf16x8*)(R1 + (16 * mt + r) * 272 + (32 * kk + 8 * q) * 2);
            acc0[mt] = mfma16(a, b0, acc0[mt]); acc1[mt] = mfma16(a, b1, acc1[mt]); }
    }
    bf16* Y5 = (bf16*)(F.ws + WS_Y5);
#pragma unroll
    for (int mt = 0; mt < 9; ++mt)
#pragma unroll
        for (int i = 0; i < 4; ++i) { const int c = 16 * mt + 4 * q + i;
            if (c <= 128) { const int rb = SEQP * n + 16 * c;
                Y5[(size_t)(rb + w) * HD + 16 * g + r] = (bf16)f2bf(gelu_tanh(acc0[mt][i]));
                Y5[(size_t)(rb + w + 8) * HD + 16 * g + r] = (bf16)f2bf(gelu_tanh(acc1[mt][i])); } }
    __syncthreads();
}
__device__ __forceinline__ void s5_sample_item(Frame& F, int item) {
    const int g = item & 31, s = item >> 5, lane = F.lane, row = R_SAMP + s;
    const bf16* U = (const bf16*)(F.ws + WS_U); bf16* Y5 = (bf16*)(F.ws + WS_Y5);
    const float* A1 = (const float*)(F.ws + WS_S5F + S5F_A1); const float* BBf = (const float*)(F.ws + WS_S5F + S5F_BB);
    const v4u u0 = *(const v4u*)(U + (size_t)row * HD + 16 * g), u1 = *(const v4u*)(U + (size_t)row * HD + 16 * g + 8);
    float uu[16]; uu[0] = bflo(u0.x); uu[1] = bfhi(u0.x); uu[2] = bflo(u0.y); uu[3] = bfhi(u0.y); uu[4] = bflo(u0.z); uu[5] = bfhi(u0.z); uu[6] = bflo(u0.w); uu[7] = bfhi(u0.w);
    uu[8] = bflo(u1.x); uu[9] = bfhi(u1.x); uu[10] = bflo(u1.y); uu[11] = bfhi(u1.y); uu[12] = bflo(u1.z); uu[13] = bfhi(u1.z); uu[14] = bflo(u1.w); uu[15] = bfhi(u1.w);
    float xr = 0.f, xi = 0.f; const float* bb = BBf + (size_t)(g * 64 + lane) * 32;
#pragma unroll
    for (int c = 0; c < 16; ++c) { xr += bb[2 * c] * uu[c]; xi += bb[2 * c + 1] * uu[c]; }
    const float ar = A1[(g * 64 + lane) * 2], ai = A1[(g * 64 + lane) * 2 + 1];
    const float h0r = F.st_s5r[(size_t)(s * 32 + g) * 64 + lane], h0i = F.st_s5i[(size_t)(s * 32 + g) * 64 + lane];
    const float hr = ar * h0r - ai * h0i + xr, hi = ar * h0i + ai * h0r + xi;
    F.out[OFF_S5RS + (size_t)(s * 32 + g) * 64 + lane] = hr; F.out[OFF_S5IS + (size_t)(s * 32 + g) * 64 + lane] = hi;
    float yk = 0.f;
#pragma unroll
    for (int co = 0; co < 16; ++co) { const float part = hr * F.c_re[(g * 16 + co) * 64 + lane] - hi * F.c_im[(g * 16 + co) * 64 + lane]; const float tot = wave_sum(part); if (lane == co) yk = tot; }
    if (lane < 16) { float uc = 0.f;
#pragma unroll
        for (int c = 0; c < 16; ++c) uc = (lane == c) ? uu[c] : uc;
        const float y = yk + F.s5_d[g * 16 + lane] * uc; Y5[(size_t)row * HD + 16 * g + lane] = (bf16)f2bf(gelu_tanh(y)); }
}
#define HG_O_QD 0
#define HG_O_KD 17408
#define HG_O_KT 34816
#define HG_O_VT 53248
#define HG_O_ATT 55552
#define HG_O_ST 64768
#define HG_O_SEG 69120
#define HG_O_DEC 71168
constexpr size_t WS_HQD = WS_XN, WS_HATT = WS_XN + (size_t)1056 * 64 * 128 * 2, WS_HKT = WS_ZEND, WS_HDEC = WS_ZEND + (size_t)1056 * 128 * 64 * 2;
static_assert(WS_HATT + (size_t)1056 * 64 * 64 * 2 <= WS_U && WS_HDEC + (size_t)1056 * 128 * 4 <= WS_END, "hgrn operand buffers");
__device__ __forceinline__ void hgrn_pre_items(Frame& F) {
    LAS unsigned char* L = F.lds;
    int tid = F.tid; asm volatile("" : "+v"(tid));
    const int lane = tid & 63, w = F.wave, r = lane & 15, q = lane >> 4;
    const bf16* Qb = (const bf16*)(F.ws + WS_Q); const float* LF = (const float*)(F.ws + WS_LF);
    bf16* QDg = (bf16*)(F.ws + WS_HQD); bf16* ATTg = (bf16*)(F.ws + WS_HATT); bf16* KTg = (bf16*)(F.ws + WS_HKT); float* DECg = (float*)(F.ws + WS_HDEC);
    for (int i = tid; i < 9216 / 4; i += 512) ((LAS unsigned*)(L + HG_O_ATT))[i] = 0u;
    const int k = tid & 127, s4 = tid >> 7;
    float lf[16]; unsigned short qv[16];
#define HG_LOAD(item) do { const int c_ = (item) % 33, nh_ = (item) / 33, n_ = nh_ >> 2, h_ = nh_ & 3; \
        _Pragma("unroll") for (int i = 0; i < 16; ++i) { const int t = 16 * s4 + i; const int row = c_ == 0 ? (t < 16 ? SEQP * n_ + t : -1) : SEQP * n_ + 16 + 64 * (c_ - 1) + t; \
            if (row >= 0) { lf[i] = LF[(size_t)row * HD + 128 * h_ + k]; qv[i] = Qb[(size_t)row * HD + 128 * h_ + k]; } else { lf[i] = 0.f; qv[i] = 0; } } } while (0)
    int item = F.vcu;
    if (item < 1056) HG_LOAD(item);
    for (; item < 1056; item += F.G) {
        float bc[16]; float run = 0.f;
#pragma unroll
        for (int i = 0; i < 16; ++i) { run += lf[i]; bc[i] = run; }
        ((LAS float*)(L + HG_O_SEG))[s4 * 128 + k] = run;
        __syncthreads();
        float off = 0.f, bl = 0.f;
#pragma unroll
        for (int s = 0; s < 4; ++s) { const float v = ((LAS float*)(L + HG_O_SEG))[s * 128 + k]; bl += v; off += (s < s4) ? v : 0.f; }
        if (s4 == 0) DECg[(size_t)item * 128 + k] = __expf(bl);
        unsigned kp[8];
#pragma unroll
        for (int i = 0; i < 16; i += 2) { float kdl2[2];
#pragma unroll
            for (int e = 0; e < 2; ++e) { const int ii = i + e; const float b = off + bc[ii], f = __expf(lf[ii]), kk = 1.0f - f, eb = __expf(b), enb = __expf(-b);
                *(LAS bf16*)(L + HG_O_QD + (16 * s4 + ii) * 272 + k * 2) = (bf16)f2bf(bf2f(qv[ii]) * eb);
                *(LAS bf16*)(L + HG_O_KD + (16 * s4 + ii) * 272 + k * 2) = (bf16)f2bf(kk * enb);
                kdl2[e] = kk * __expf(bl - b); }
            kp[i >> 1] = pk2(kdl2[0], kdl2[1]); }
        *(v4u*)(KTg + ((size_t)item * 128 + k) * 64 + 16 * s4) = (v4u){kp[0], kp[1], kp[2], kp[3]};
        *(v4u*)(KTg + ((size_t)item * 128 + k) * 64 + 16 * s4 + 8) = (v4u){kp[4], kp[5], kp[6], kp[7]};
        __syncthreads();
        if (item + F.G < 1056) HG_LOAD(item + F.G);
#pragma unroll
        for (int j = 0; j < 2; ++j) { const int idx = tid + 512 * j, t = idx >> 4, pc = idx & 15; *(v4u*)(QDg + ((size_t)item * 64 + t) * 128 + pc * 8) = *(const LAS v4u*)(L + HG_O_QD + t * 272 + pc * 16); }
#pragma unroll
        for (int rep = 0; rep < 2; ++rep) { const int idx = w + 8 * rep;
            if (idx < 10) { const int ti = idx < 1 ? 0 : (idx < 3 ? 1 : (idx < 6 ? 2 : 3)), sj = idx - (ti * (ti + 1)) / 2;
                f32x4 at = (f32x4){0.f, 0.f, 0.f, 0.f};
#pragma unroll
                for (int kk = 0; kk < 4; ++kk) { const bf16x8 a = *(const LAS bf16x8*)(L + HG_O_QD + (16 * ti + r) * 272 + (32 * kk + 8 * q) * 2), b = *(const LAS bf16x8*)(L + HG_O_KD + (16 * sj + r) * 272 + (32 * kk + 8 * q) * 2); at = mfma16(a, b, at); }
#pragma unroll
                for (int i = 0; i < 4; ++i) { const int t = 16 * ti + 4 * q + i, s = 16 * sj + r; *(LAS bf16*)(L + HG_O_ATT + t * 144 + s * 2) = (bf16)f2bf(s <= t ? at[i] : 0.f); } } }
        __syncthreads();
        { const int t = tid >> 3, pc = tid & 7; *(v4u*)(ATTg + ((size_t)item * 64 + t) * 64 + pc * 8) = *(const LAS v4u*)(L + HG_O_ATT + t * 144 + pc * 16); }
    }
#undef HG_LOAD
    __syncthreads();
}
__device__ __forceinline__ void hgrn_seq_item(Frame& F, int item, bool atom = true) {
    const int vs = item & 7, h = (item >> 3) & 3, n = item >> 5;
    LAS unsigned char* L = F.lds;
    int tid = F.tid; asm volatile("" : "+v"(tid));
    const int lane = tid & 63, w = F.wave, r = lane & 15, q = lane >> 4;
    const bf16* Vb = (const bf16*)(F.ws + WS_V);
    const bf16* QDg = (const bf16*)(F.ws + WS_HQD); const bf16* ATTg = (const bf16*)(F.ws + WS_HATT); const bf16* KTg = (const bf16*)(F.ws + WS_HKT); const float* DECg = (const float*)(F.ws + WS_HDEC);
    bf16* OH = (bf16*)(F.ws + WS_OH); float* HSS = (float*)(F.ws + WS_HSS);
    for (int i = tid; i < 4352 / 4; i += 512) ((LAS unsigned*)(L + HG_O_ST))[i] = 0u;
    f32x4 Sreg = (f32x4){0.f, 0.f, 0.f, 0.f};
    const int tv = tid >> 3, pr = tid & 7;
    struct OpSet { v4u pq[2], pk[2], pa; unsigned vv; float dc; };
    OpSet s0, s1, s2;
#define HG_LOAD(S, c) do { const size_t it_ = (size_t)((n * 4 + h) * 33 + (c)); \
        _Pragma("unroll") for (int j = 0; j < 2; ++j) { const int idx = tid + 512 * j; S.pq[j] = *(const v4u*)(QDg + it_ * 8192 + (size_t)idx * 8); S.pk[j] = *(const v4u*)(KTg + it_ * 8192 + (size_t)idx * 8); } \
        S.pa = *(const v4u*)(ATTg + it_ * 4096 + (size_t)tid * 8); S.dc = DECg[it_ * 128 + (tid & 127)]; \
        { const int row = (c) == 0 ? (tv < 16 ? SEQP * n + tv : -1) : SEQP * n + 16 + 64 * ((c) - 1) + tv; \
          S.vv = row >= 0 ? *(const unsigned*)(Vb + (size_t)row * HD + 128 * h + 16 * vs + 2 * pr) : 0u; } } while (0)
#define HG_STEP(S, c) do { \
        _Pragma("unroll") for (int j = 0; j < 2; ++j) { const int idx = tid + 512 * j; \
            *(LAS v4u*)(L + HG_O_QD + (idx >> 4) * 272 + (idx & 15) * 16) = S.pq[j]; \
            *(LAS v4u*)(L + HG_O_KT + (idx >> 3) * 144 + (idx & 7) * 16) = S.pk[j]; } \
        *(LAS v4u*)(L + HG_O_ATT + (tid >> 3) * 144 + (tid & 7) * 16) = S.pa; \
        if (tid < 128) ((LAS float*)(L + HG_O_DEC))[tid] = S.dc; \
        *(LAS bf16*)(L + HG_O_VT + (2 * pr) * 144 + tv * 2) = (bf16)(S.vv & 0xffffu); *(LAS bf16*)(L + HG_O_VT + (2 * pr + 1) * 144 + tv * 2) = (bf16)(S.vv >> 16); \
        __syncthreads(); \
        if ((c) + 3 <= 32) HG_LOAD(S, (c) + 3); \
        f32x4 accS; \
        _Pragma("unroll") for (int i = 0; i < 4; ++i) accS[i] = ((LAS float*)(L + HG_O_DEC))[16 * w + 4 * q + i] * Sreg[i]; \
        _Pragma("unroll") for (int kk = 0; kk < 2; ++kk) { const bf16x8 a = *(const LAS bf16x8*)(L + HG_O_KT + (16 * w + r) * 144 + (32 * kk + 8 * q) * 2), b = *(const LAS bf16x8*)(L + HG_O_VT + r * 144 + (32 * kk + 8 * q) * 2); accS = mfma16(a, b, accS); } \
        if (w < 4) { \
            f32x4 o = (f32x4){0.f, 0.f, 0.f, 0.f}; \
            _Pragma("unroll") for (int kk = 0; kk < 4; ++kk) { const bf16x8 a = *(const LAS bf16x8*)(L + HG_O_QD + (16 * w + r) * 272 + (32 * kk + 8 * q) * 2), b = *(const LAS bf16x8*)(L + HG_O_ST + r * 272 + (32 * kk + 8 * q) * 2); o = mfma16(a, b, o); } \
            _Pragma("unroll") for (int kk = 0; kk < 2; ++kk) { const bf16x8 a = *(const LAS bf16x8*)(L + HG_O_ATT + (16 * w + r) * 144 + (32 * kk + 8 * q) * 2), b = *(const LAS bf16x8*)(L + HG_O_VT + r * 144 + (32 * kk + 8 * q) * 2); o = mfma16(a, b, o); } \
            _Pragma("unroll") for (int i = 0; i < 4; ++i) { const int t = 16 * w + 4 * q + i; const int row = (c) == 0 ? (t < 16 ? SEQP * n + t : -1) : SEQP * n + 16 + 64 * ((c) - 1) + t; \
                float ss = o[i] * o[i]; ss += __shfl_xor(ss, 1); ss += __shfl_xor(ss, 2); ss += __shfl_xor(ss, 4); ss += __shfl_xor(ss, 8); \
                if (row >= 0) { OH[(size_t)row * HD + 128 * h + 16 * vs + r] = (bf16)f2bf(o[i]); if (r == 0 && atom) atomic_addf(HSS + (size_t)row * SST + h, ss); } } } \
        __syncthreads(); \
        Sreg = accS; \
        *(LAS v2u*)(L + HG_O_ST + r * 272 + (16 * w + 4 * q) * 2) = (v2u){pk2(Sreg[0], Sreg[1]), pk2(Sreg[2], Sreg[3])}; } while (0)
    HG_LOAD(s0, 0); HG_LOAD(s1, 1); HG_LOAD(s2, 2);
#pragma unroll 1
    for (int c = 0; c <= 30; c += 3) { HG_STEP(s0, c); HG_STEP(s1, c + 1); HG_STEP(s2, c + 2); }
#undef HG_STEP
#undef HG_LOAD
#pragma unroll
    for (int i = 0; i < 4; ++i) F.out[OFF_HGP + ((size_t)(n * 4 + h) * 128 + 16 * w + 4 * q + i) * 128 + 16 * vs + r] = Sreg[i];
    __syncthreads();
}
__device__ __forceinline__ void hgrn_sample_item(Frame& F, int item, bool atom = true) {
    const int h = item & 3, s = item >> 2, row = R_SAMP + s, tid = F.tid, vq = tid & 31, kg = tid >> 5;
    const bf16* Qb = (const bf16*)(F.ws + WS_Q); const bf16* Vb = (const bf16*)(F.ws + WS_V); const float* LF = (const float*)(F.ws + WS_LF);
    bf16* OH = (bf16*)(F.ws + WS_OH); float* HSS = (float*)(F.ws + WS_HSS);
    LAS float* red = (LAS float*)F.lds;
    const v2u vw = *(const v2u*)(Vb + (size_t)row * HD + 128 * h + 4 * vq);
    const f32x4 v4 = (f32x4){bflo(vw.x), bfhi(vw.x), bflo(vw.y), bfhi(vw.y)};
    f32x4 o4 = (f32x4){0.f, 0.f, 0.f, 0.f};
#pragma unroll
    for (int i = 0; i < 8; ++i) { const int k = 8 * kg + i; const float f = __expf(LF[(size_t)row * HD + 128 * h + k]), kk = 1.0f - f, qk = bf2f(Qb[(size_t)row * HD + 128 * h + k]);
        const size_t off = ((size_t)(s * 4 + h) * 128 + k) * 128 + 4 * vq;
        const f32x4 sn = *(const f32x4*)(F.st_hg + off) * f + v4 * kk;
        *(f32x4*)(F.out + OFF_HGS + off) = sn; o4 += sn * qk; }
    *(LAS f32x4*)(red + kg * 128 + 4 * vq) = o4;
    __syncthreads();
    if (tid < 128) { float o = 0.f;
#pragma unroll
        for (int j = 0; j < 16; ++j) o += red[j * 128 + tid];
        OH[(size_t)row * HD + 128 * h + tid] = (bf16)f2bf(o);
        const float ss = wave_sum(o * o); if (F.lane == 0 && atom) atomic_addf(HSS + (size_t)row * SST + h, ss); }
    __syncthreads();
}

constexpr int TAIL_ROW0 = 16384;
template <class Epi>
__device__ __forceinline__ void tail_gemm(Frame& F, const bf16* A, int lda, const bf16* Bt, int K, const Epi& E) {
    int tid = F.tid; asm volatile("" : "+v"(tid));
    const int lane = tid & 63, w = F.wave, r = lane & 15, q = lane >> 4;
    LAS float* red = (LAS float*)F.lds;
    const int kw = K >> 3, nks = kw >> 5;
    for (int su = F.vcu; su < 256; su += F.G) {
        const int rb = su >> 5, cb = su & 31;
        const bf16* Ap = A + (size_t)(TAIL_ROW0 + 32 * rb + r) * lda + w * kw + 8 * q;
        const bf16* Bp = Bt + (size_t)(32 * cb + r) * K + w * kw + 8 * q;
        f32x4 acc[2][2];
#pragma unroll
        for (int mi = 0; mi < 2; ++mi)
#pragma unroll
            for (int ni = 0; ni < 2; ++ni) acc[mi][ni] = (f32x4){0.f, 0.f, 0.f, 0.f};
#pragma unroll 4
        for (int kk = 0; kk < nks; ++kk) {
            const bf16x8 a0 = *(const bf16x8*)(Ap + 32 * kk), a1 = *(const bf16x8*)(Ap + (size_t)16 * lda + 32 * kk);
            const bf16x8 b0 = *(const bf16x8*)(Bp + 32 * kk), b1 = *(const bf16x8*)(Bp + (size_t)16 * K + 32 * kk);
            acc[0][0] = mfma16(a0, b0, acc[0][0]); acc[0][1] = mfma16(a0, b1, acc[0][1]); acc[1][0] = mfma16(a1, b0, acc[1][0]); acc[1][1] = mfma16(a1, b1, acc[1][1]);
        }
#pragma unroll
        for (int mi = 0; mi < 2; ++mi)
#pragma unroll
            for (int ni = 0; ni < 2; ++ni)
#pragma unroll
                for (int i = 0; i < 4; ++i) red[(w * 32 + 16 * mi + 4 * q + i) * 32 + 16 * ni + r] = acc[mi][ni][i];
        __syncthreads();
        { const int row = tid >> 4, col = (tid & 15) * 2; float v0 = 0.f, v1 = 0.f;
#pragma unroll
            for (int ww = 0; ww < 8; ++ww) { v0 += red[(ww * 32 + row) * 32 + col]; v1 += red[(ww * 32 + row) * 32 + col + 1]; }
            E(TAIL_ROW0 + 32 * rb + row, 32 * cb + col, v0, v1); }
        __syncthreads();
    }
}
struct TailOut {
    const float *xp, *meta, *xs; bf16* H1B; float* ss;
    __device__ __forceinline__ void operator()(int row, int col, float v0, float v1) const {
        const float* src = h0_src(row, xp, meta, xs);
        const float a = src[col] + v0, b = src[col + 1] + v1;
        *(unsigned*)(H1B + (size_t)row * D + col) = pk2(a, b);
        float q2 = a * a + b * b; q2 += __shfl_xor(q2, 1); q2 += __shfl_xor(q2, 2); q2 += __shfl_xor(q2, 4); q2 += __shfl_xor(q2, 8);
        if ((col & 31) == 0 && ss) atomic_addf(ss + (size_t)row * SST, q2);
    }
};
struct TailDown {
    const bf16* H1B; float* out; float* ss;
    __device__ __forceinline__ void operator()(int row, int col, float v0, float v1) const {
        float* dst = y_dst(row, out); const unsigned hb = *(const unsigned*)(H1B + (size_t)row * D + col);
        const float a = bflo(hb) + v0, b = bfhi(hb) + v1; if (dst) { dst[col] = a; dst[col + 1] = b; }
        float q2 = a * a + b * b; q2 += __shfl_xor(q2, 1); q2 += __shfl_xor(q2, 2); q2 += __shfl_xor(q2, 4); q2 += __shfl_xor(q2, 8);
        if ((col & 31) == 0) atomic_addf(ss + (size_t)row * SST, q2);
    }
};
__device__ __forceinline__ void hgrn_finalize(Frame& F, int part, int nparts) {
    const bf16* OH = (const bf16*)(F.ws + WS_OH); const bf16* G = (const bf16*)(F.ws + WS_G); const float* HSS = (const float*)(F.ws + WS_HSS); bf16* MIX = (bf16*)(F.ws + WS_MIX);
    const int gt = part * 512 + F.tid, NT = nparts * 512;
    for (int idx0 = gt; idx0 < RT * 64; idx0 += 4 * NT) {
        v4u o[4], gg[4]; float hs[4];
#pragma unroll
        for (int e = 0; e < 4; ++e) { const int idx = idx0 + e * NT; if (idx < RT * 64) { const int row = idx >> 6, c8 = (idx & 63) * 8;
            hs[e] = ld_agent(HSS + (size_t)row * SST + (c8 >> 7)); o[e] = *(const v4u*)(OH + (size_t)row * HD + c8); gg[e] = *(const v4u*)(G + (size_t)row * HD + c8); } }
#pragma unroll
        for (int e = 0; e < 4; ++e) { const int idx = idx0 + e * NT; if (idx < RT * 64) { const int row = idx >> 6, c8 = (idx & 63) * 8;
            const float rstd = __builtin_amdgcn_rsqf(hs[e] * (1.0f / 128.0f) + EPS);
            const f32x4 n0 = *(const f32x4*)(F.hg_ng + c8), n1 = *(const f32x4*)(F.hg_ng + c8 + 4);
            v4u w;
            w.x = pk2(bflo(o[e].x) * rstd * n0[0] * bflo(gg[e].x), bfhi(o[e].x) * rstd * n0[1] * bfhi(gg[e].x));
            w.y = pk2(bflo(o[e].y) * rstd * n0[2] * bflo(gg[e].y), bfhi(o[e].y) * rstd * n0[3] * bfhi(gg[e].y));
            w.z = pk2(bflo(o[e].z) * rstd * n1[0] * bflo(gg[e].z), bfhi(o[e].z) * rstd * n1[1] * bfhi(gg[e].z));
            w.w = pk2(bflo(o[e].w) * rstd * n1[2] * bflo(gg[e].w), bfhi(o[e].w) * rstd * n1[3] * bfhi(gg[e].w));
            *(v4u*)(MIX + (size_t)row * D + 512 + c8) = w; } }
    }
}
__device__ __forceinline__ void final_norm(Frame& F) {
    const float* SS3 = (const float*)(F.ws + WS_SS3);
    const int gw = F.vcu * NWAVES + F.wave, NGW = F.G * NWAVES;
    f32x4 gg[4];
#pragma unroll
    for (int j = 0; j < 4; ++j) gg[j] = *(const f32x4*)(F.g_final + 4 * F.lane + 256 * j);
    for (int i0 = gw * 4; i0 < NB * SEQ + NS; i0 += NGW * 4) {
        float* p[4]; float rs[4]; f32x4 v[4][4];
#pragma unroll
        for (int r = 0; r < 4; ++r) { const int i = i0 + r; const int row = i < NB * SEQ ? (i >> 11) * SEQP + NMETA + (i & 2047) : R_SAMP + (i - NB * SEQ);
            p[r] = i < NB * SEQ ? F.out + (size_t)i * D : F.out + OFF_YS + (size_t)(i - NB * SEQ) * D; rs[r] = ld_agent(SS3 + (size_t)row * SST);
#pragma unroll
            for (int j = 0; j < 4; ++j) v[r][j] = *(const f32x4*)(p[r] + 4 * F.lane + 256 * j); }
#pragma unroll
        for (int r = 0; r < 4; ++r) { const float rstd = __builtin_amdgcn_rsqf(rs[r] * (1.0f / D) + EPS);
#pragma unroll
            for (int j = 0; j < 4; ++j) *(f32x4*)(p[r] + 4 * F.lane + 256 * j) = v[r][j] * rstd * gg[j]; } }
}
#ifndef PROBE_DUP
#define PROBE_DUP 0x0f
#endif
#define PD(k) (((PROBE_DUP & 0x0f) == (k)) || ((PROBE_DUP & 0x1000) && (k) != 8))
#ifndef MK_N_LAUNCHES
#define MK_N_LAUNCHES 1
#endif
constexpr int N_LAUNCHES = MK_N_LAUNCHES;
constexpr int PER_PHASE = 9;
struct Args { const float* in[28]; float* out; unsigned char* ws; int ph_lo, ph_hi, li, pad; };
__global__ void __launch_bounds__(NWAVES * 64, 2) hymba_fwd(Args args) {
    extern __shared__ __attribute__((aligned(16))) unsigned char lds[];
    Frame F;
    F.lds = (LAS unsigned char*)lds;
    F.MISC = (volatile LAS unsigned*)(F.lds + MISC_OFF);
    F.tid = threadIdx.x; F.lane = F.tid & 63; F.wave = __builtin_amdgcn_readfirstlane(F.tid >> 6);
    F.G = gridDim.x; { const int bx = blockIdx.x; F.vcu = (F.G % 8 == 0) ? (bx % 8) * (F.G / 8) + bx / 8 : bx; }
    F.ws = args.ws; F.out = args.out; F.ctl = (gu32*)(args.ws + WS_CTL);
    F.x_prompt = args.in[0]; F.x_sample = args.in[1]; F.st_s5r = args.in[2]; F.st_s5i = args.in[3]; F.st_hg = args.in[4]; F.st_cv = args.in[5]; F.meta = args.in[6];
    F.g_mix = args.in[7]; F.w_in = args.in[8]; F.lam_re = args.in[9]; F.lam_im = args.in[10]; F.log_dt = args.in[11]; F.b_re = args.in[12]; F.b_im = args.in[13];
    F.c_re = args.in[14]; F.c_im = args.in[15]; F.s5_d = args.in[16]; F.w_glu = args.in[17]; F.b_glu = args.in[18]; F.hg_lb = args.in[19]; F.hg_ng = args.in[20];
    F.w_out = args.in[21]; F.g_ffn = args.in[22]; F.w_up = args.in[23]; F.conv_w = args.in[24]; F.conv_b = args.in[25]; F.w_down = args.in[26]; F.g_final = args.in[27];
    for (int u = F.tid; u < 64; u += NWAVES * 64) ((LAS unsigned*)(F.lds + MISC_OFF))[u] = 0u;
    __syncthreads();
    XcdBarrier bar; bar.bar = (unsigned*)(F.ctl + CW_BAR); bar.x = 0; bar.st = nullptr;
    if (N_LAUNCHES != PER_PHASE) bar = xcd_barrier_post((unsigned*)(F.ctl + CW_BAR), F.MISC + 8);
#ifdef TPROBE
    unsigned long long ta0_ = 0, ta1_ = 0, tb0_ = 0, tb1_ = 0;
#define TSTAMP(k) do { const unsigned long long t_ = __builtin_amdgcn_s_memrealtime(); if ((k) == TPA) ta0_ = t_; if ((k) == TPA + 1) ta1_ = t_; if ((k) == TPB) tb0_ = t_; if ((k) == TPB + 1) tb1_ = t_; } while (0)
#else
#define TSTAMP(k) do { } while (0)
#endif
#define GRID_BAR(k) do { if (N_LAUNCHES != PER_PHASE) xcd_barrier(bar); TSTAMP(k); } while (0)
#define GRID_BAR2(k) do { xcd_barrier(bar); TSTAMP(k); } while (0)
    static_assert(N_LAUNCHES == 1, "this build keeps a grid barrier inside phase 2: one launch only");
    const int lo = args.ph_lo, hi = args.ph_hi;
    TSTAMP(0);
#ifndef P2_MASK
#define P2_MASK 15
#endif
#ifndef PH_MASK
#define PH_MASK 0x1ff
#endif
#define IN(k) (((PH_MASK >> (k)) & 1) && lo <= (k) && (k) < hi)
#define BOTH(k) (IN(k) && IN((k) + 1))
    const int gw = F.vcu * NWAVES + F.wave, NGW = F.G * NWAVES;
    bf16* XN = (bf16*)(F.ws + WS_XN);

#if PD(0)
    if (IN(0)) { p0_prologue(F); __syncthreads(); }
#endif
    if (IN(0)) { p0_prologue(F); if (BOTH(0)) GRID_BAR(1); }
    if (IN(1)) {
        pg8::Gemm g{XN, (const bf16*)(F.ws + WS_WIN), RT, INC, D, D, 256}; pg8::StaticOrder S; S.init(RT, INC, F.G, (int)blockIdx.x);
        EpiIn E{(bf16*)(F.ws + WS_U), (bf16*)(F.ws + WS_Q), (bf16*)(F.ws + WS_V), (bf16*)(F.ws + WS_G), (float*)(F.ws + WS_LF), (const float*)(F.ws + WS_S5F + S5F_LB)};
#if PD(1)
        pg8::gemm_phase<EpiIn, true>(F.lds + RING_OFF, g, S, E);
#endif
        pg8::gemm_phase<EpiIn, true>(F.lds + RING_OFF, g, S, E);
        if (BOTH(1)) GRID_BAR(2);
    }
#if PD(2)
    if (IN(2)) {
        if (PROBE_DUP & 0x1010) for (int it = F.vcu; it < NB * 32; it += F.G) s5_prompt_item(F, it);
        if (PROBE_DUP & 0x1020) hgrn_pre_items(F);
        if (PROBE_DUP & 0x1040) for (int it = gw; it < NS * 32; it += NGW) s5_sample_item(F, it);
        if (PROBE_DUP & 0x1080) for (int it = F.vcu; it < NS * 4; it += F.G) hgrn_sample_item(F, it, false);
    }
#endif
    if (IN(2)) {
        for (int it = F.vcu; it < NB * 32; it += F.G) s5_prompt_item(F, it);
        hgrn_pre_items(F);
        for (int it = gw; it < NS * 32; it += NGW) s5_sample_item(F, it);
        for (int it = F.vcu; it < NS * 4; it += F.G) hgrn_sample_item(F, it);
        GRID_BAR2(3);
#if PD(2)
        if (PROBE_DUP & 0x1100) for (int it = F.vcu; it < NB * 4 * 8; it += F.G) hgrn_seq_item(F, it, false);
#endif
        for (int it = F.vcu; it < NB * 4 * 8; it += F.G) hgrn_seq_item(F, it);
        if (BOTH(2)) GRID_BAR(4);
    }
    if (IN(3)) {
        constexpr int GLU_UNITS = (RT / 256) * (HD / 256);
        if (F.G > GLU_UNITS + 32) { if ((int)blockIdx.x >= GLU_UNITS) hgrn_finalize(F, (int)blockIdx.x - GLU_UNITS, F.G - GLU_UNITS); }
        else hgrn_finalize(F, (int)blockIdx.x, F.G);
        pg8::Gemm g{(const bf16*)(F.ws + WS_Y5), (const bf16*)(F.ws + WS_WGLU), RT, HD, HD, HD, 256}; pg8::StaticOrder S; S.init(RT, HD, F.G, (int)blockIdx.x);
        EpiGlu E{(const bf16*)(F.ws + WS_Y5), F.b_glu, (bf16*)(F.ws + WS_MIX)};
        pg8::gemm_phase<EpiGlu, true>(F.lds + RING_OFF, g, S, E);
        if (BOTH(3)) GRID_BAR(5);
    }
    if (IN(4)) {
        pg8::Gemm g{(const bf16*)(F.ws + WS_MIX), (const bf16*)(F.ws + WS_WOUT), TAIL_ROW0, D, D, D, 256}; pg8::StaticOrder S; S.init(TAIL_ROW0, D, F.G, (int)blockIdx.x);
        EpiOut E{F.x_prompt, F.meta, F.x_sample, XN, (float*)(F.ws + WS_SS2)};
#if PD(4)
        { EpiOut E2 = E; E2.ss = nullptr; pg8::gemm_phase<EpiOut, true>(F.lds + RING_OFF, g, S, E2); }
#endif
        pg8::gemm_phase<EpiOut, true>(F.lds + RING_OFF, g, S, E);
        { TailOut T{F.x_prompt, F.meta, F.x_sample, XN, (float*)(F.ws + WS_SS2)};
#if PD(6)
          { TailOut T2 = T; T2.ss = nullptr; tail_gemm(F, (const bf16*)(F.ws + WS_MIX), D, (const bf16*)(F.ws + WS_WOUT), D, T2); }
#endif
          tail_gemm(F, (const bf16*)(F.ws + WS_MIX), D, (const bf16*)(F.ws + WS_WOUT), D, T); }
        if (BOTH(4)) GRID_BAR(6);
    }
    if (IN(5)) {
        pg8::Gemm g{XN - 2 * D, (const bf16*)(F.ws + WS_WUP), 66 * 256, UPC, D, D, 254}; pg8::StaticOrder S; S.init(66 * 256, UPC, F.G, (int)blockIdx.x);
        EpiUpGate E{(const float*)(F.ws + WS_SS2), (bf16*)(F.ws + WS_GATED), F.out, F.conv_w, F.conv_b, F.st_cv, (LAS float*)(F.lds + XCH_OFF)};
        pg8::gemm_phase<EpiUpGate, true>(F.lds + RING_OFF, g, S, E);
        if (BOTH(5)) GRID_BAR(7);
    }
    if (IN(6)) { }
    if (IN(7)) {
        pg8::Gemm g{(const bf16*)(F.ws + WS_GATED), (const bf16*)(F.ws + WS_WDN), TAIL_ROW0, D, DFF, DFF, 256}; pg8::StaticOrder S; S.init(TAIL_ROW0, D, F.G, (int)blockIdx.x);
        EpiDown E{XN, F.out, (float*)(F.ws + WS_SS3), nullptr};
#if PD(7)
        { EpiDown E2 = E; E2.dry = (float*)(F.ws + WS_XN); pg8::gemm_phase<EpiDown, true>(F.lds + RING_OFF, g, S, E2); }
#endif
#if PD(8)
        for (int i = 0; i < 8; ++i) GRID_BAR(99);
#endif
        pg8::gemm_phase<EpiDown, true>(F.lds + RING_OFF, g, S, E);
        { TailDown T{XN, F.out, (float*)(F.ws + WS_SS3)}; tail_gemm(F, (const bf16*)(F.ws + WS_GATED), DFF, (const bf16*)(F.ws + WS_WDN), DFF, T); }
        if (BOTH(7)) GRID_BAR(8);
    }
    if (IN(8)) final_norm(F);
#ifdef TPROBE
    GRID_BAR(9);
    { const float da = (float)(ta1_ - ta0_) * 0.01f, db = (float)(tb1_ - tb0_) * 0.0001f;
      if (blockIdx.x == 0 && F.tid == 0) F.out[0] = da;
      for (int i = blockIdx.x * 512 + F.tid; i < NS * D; i += F.G * 512) F.out[OFF_YS + i] += db; }
#endif
#undef IN
#undef BOTH
#undef GRID_BAR
}

extern "C" void kernel_launch(void* const* d_in, const int* in_sizes, int n_in, void* d_out, int out_size, void* d_ws, size_t ws_size, hipStream_t stream) {
    static int grid = 0;
    if (grid == 0) {
        if (n_in != 28 || out_size != (int)OUT_TOTAL || ws_size < WS_END) { fprintf(stderr, "kernel_launch: unexpected problem (n_in %d, out %d, ws %zu); nothing launched\n", n_in, out_size, ws_size); grid = -1; return; }
        int dev = 0, cus = 0, per_cu = 0;
        if (hipGetDevice(&dev) != hipSuccess || hipDeviceGetAttribute(&cus, hipDeviceAttributeMultiprocessorCount, dev) != hipSuccess) { fprintf(stderr, "kernel_launch: device query failed\n"); grid = -1; return; }
        if (hipFuncSetAttribute((const void*)hymba_fwd, hipFuncAttributeMaxDynamicSharedMemorySize, LDS_BYTES) != hipSuccess) { fprintf(stderr, "kernel_launch: hipFuncSetAttribute failed\n"); grid = -1; return; }
        if (hipOccupancyMaxActiveBlocksPerMultiprocessor(&per_cu, (const void*)hymba_fwd, NWAVES * 64, LDS_BYTES) != hipSuccess || per_cu < 1)
            fprintf(stderr, "kernel_launch: note: occupancy query reports %d workgroups per CU\n", per_cu);
        (void)hipGetLastError();
        grid = cus;
    }
    if (grid < 0) return;
    if (hipMemsetAsync((char*)d_ws + WS_CTL, 0, CTL_ZERO_BYTES, stream) != hipSuccess) { fprintf(stderr, "kernel_launch: hipMemsetAsync failed\n"); return; }
    Args a{};
    for (int i = 0; i < 28; ++i) a.in[i] = (const float*)d_in[i];
    a.out = (float*)d_out; a.ws = (unsigned char*)d_ws; a.pad = 0;
    for (int li = 0; li < N_LAUNCHES * (PD(10) ? 2 : 1); ++li) {
        if (li > 0 && PD(10)) (void)hipMemsetAsync((char*)d_ws + WS_CTL, 0, CTL_ZERO_BYTES, stream);
        a.ph_lo = (N_LAUNCHES == PER_PHASE) ? li : 0; a.ph_hi = (N_LAUNCHES == PER_PHASE) ? li + 1 : PER_PHASE; a.li = li;
        hipLaunchKernelGGL(hymba_fwd, dim3(grid), dim3(NWAVES * 64), LDS_BYTES, stream, a);
        const hipError_t le = hipPeekAtLastError();
        if (le != hipSuccess) { fprintf(stderr, "kernel_launch: launch %d failed: %s\n", li, hipGetErrorName(le)); break; }
    }
}
```
